# Optimizing an MI355X kernel written in HIP

```python
import math
import numpy as np
import jax
import jax.numpy as jnp
from jax import lax

D_MODEL = 1024
BATCH = 2
SEQ = 8192
DEPTH = 4

N_A_LAYERS = DEPTH // 2
N_B_LAYERS = DEPTH - N_A_LAYERS

NSA_HEADS = 16
NSA_KV_HEADS = 4
NSA_GROUP = NSA_HEADS // NSA_KV_HEADS
HEAD_DIM = 64
CMP_BLOCK = 32
CMP_STRIDE = 16
SEL_BLOCK = 64
SEL_TOP_N = 16
WINDOW = 512
PHI_HIDDEN = 256
NSA_Q_W = NSA_HEADS * HEAD_DIM
NSA_KV_W = NSA_KV_HEADS * HEAD_DIM
NSA_IN_W = NSA_Q_W + 6 * NSA_KV_W + 3 * NSA_HEADS

DIFF_HEADS = 8
DIFF_QK_DIM = 64
DIFF_V_DIM = 128
DIFF_Q_W = DIFF_HEADS * 2 * DIFF_QK_DIM
DIFF_V_W = DIFF_HEADS * DIFF_V_DIM

ROT_DIM = HEAD_DIM // 4
ROPE_THETA = 500000.0

FFN_DIM = 2752
CONV_WIDTH = 3

Q_BLOCK = 128
EPS = 1e-6
NEG = -1e30
FORCE = 1e4

kernel_name = "yoco_nsa_diffattn_convglu_trunk"


def rmsnorm(x, g):
    xf = x.astype(jnp.float32)
    y = xf * lax.rsqrt(jnp.mean(xf * xf, axis=-1, keepdims=True) + EPS)
    return (y * g.astype(jnp.float32)).astype(x.dtype)


def partial_rope(x, pos):
    half = ROT_DIM // 2
    inv = ROPE_THETA ** (-jnp.arange(half, dtype=jnp.float32) / half)
    ang = pos.astype(jnp.float32)[:, None] * inv[None, :]
    cos = jnp.cos(ang)[None, :, None, :].astype(x.dtype)
    sin = jnp.sin(ang)[None, :, None, :].astype(x.dtype)
    x1 = x[..., :half]
    x2 = x[..., half:ROT_DIM]
    return jnp.concatenate([x1 * cos - x2 * sin, x2 * cos + x1 * sin, x[..., ROT_DIM:]], axis=-1)


def masked_softmax(s, mask, axis=-1):
    s = jnp.where(mask, s.astype(jnp.float32), NEG)
    p = jax.nn.softmax(s, axis=axis)
    return jnp.where(mask, p, 0.0)


def compress(kv, pe, w1, b1, w2):
    B, S, Hk, d = kv.shape
    ch = kv.reshape(B, S // CMP_STRIDE, CMP_STRIDE, Hk, d)
    blocks = jnp.concatenate([ch[:, :-1], ch[:, 1:]], axis=2)
    blocks = blocks + pe[None, None, :, None, :]
    nc = blocks.shape[1]
    flat = blocks.transpose(0, 1, 3, 2, 4).reshape(B, nc, Hk, CMP_BLOCK * d)
    hid = jax.nn.gelu(flat @ w1 + b1)
    return hid @ w2


def nsa_mixer(h, w_in, w_out, phi_pe, phi_w1, phi_b1, phi_w2):
    B, S, _ = h.shape
    Hk, G, hd = NSA_KV_HEADS, NSA_GROUP, HEAD_DIM
    proj = h @ w_in
    q = proj[..., :NSA_Q_W].reshape(B, S, NSA_HEADS, hd)
    kv6 = proj[..., NSA_Q_W:NSA_Q_W + 6 * NSA_KV_W].reshape(B, S, 6, Hk, hd)
    kc, vc, ks, vs, kw, vw = (kv6[:, :, i] for i in range(6))
    gates = jax.nn.sigmoid(proj[..., NSA_Q_W + 6 * NSA_KV_W:].astype(jnp.float32)).astype(h.dtype)
    gates = gates.reshape(B, S, NSA_HEADS, 3)

    pos = jnp.arange(S)
    qr = partial_rope(q, pos)
    ks = partial_rope(ks, pos)
    kw = partial_rope(kw, pos)

    k_cmp = compress(kc, phi_pe[0], phi_w1[0], phi_b1[0], phi_w2[0])
    v_cmp = compress(vc, phi_pe[1], phi_w1[1], phi_b1[1], phi_w2[1])
    n_cmp = S // CMP_STRIDE - 1
    n_sel = S // SEL_BLOCK
    top_n = min(SEL_TOP_N, n_sel)
    cmp_end = jnp.arange(n_cmp) * CMP_STRIDE + CMP_BLOCK - 1
    ci = np.arange(n_cmp)[:, None]
    sj = np.arange(n_sel)[None, :]
    overlap = jnp.asarray(((ci * CMP_STRIDE < (sj + 1) * SEL_BLOCK)
                           & (ci * CMP_STRIDE + CMP_BLOCK > sj * SEL_BLOCK)).astype(np.float32))

    ks_blocks = ks.reshape(B, n_sel, SEL_BLOCK, Hk, hd).transpose(0, 3, 1, 2, 4)
    vs_blocks = vs.reshape(B, n_sel, SEL_BLOCK, Hk, hd).transpose(0, 3, 1, 2, 4)
    kw_pad = jnp.pad(kw, ((0, 0), (WINDOW, 0), (0, 0), (0, 0)))
    vw_pad = jnp.pad(vw, ((0, 0), (WINDOW, 0), (0, 0), (0, 0)))
    scale = HEAD_DIM ** -0.5
    b_ix = jnp.arange(B)[:, None, None, None]
    h_ix = jnp.arange(Hk)[None, None, :, None]
    blk = jnp.arange(n_sel)

    def block_fn(i):
        qs = i * Q_BLOCK
        t = qs + jnp.arange(Q_BLOCK)
        qb = lax.dynamic_slice_in_dim(q, qs, Q_BLOCK, axis=1).reshape(B, Q_BLOCK, Hk, G, hd)
        qrb = lax.dynamic_slice_in_dim(qr, qs, Q_BLOCK, axis=1).reshape(B, Q_BLOCK, Hk, G, hd)
        gb = lax.dynamic_slice_in_dim(gates, qs, Q_BLOCK, axis=1).reshape(B, Q_BLOCK, Hk, G, 3)

        s_c = jnp.einsum('bqkgd,bckd->bqkgc', qb, k_cmp) * scale
        m_c = cmp_end[None, :] <= t[:, None]
        p_c = masked_softmax(s_c, m_c[None, :, None, None, :])
        o_c = jnp.einsum('bqkgc,bckd->bqkgd', p_c.astype(v_cmp.dtype), v_cmp)

        imp = jnp.einsum('bqkgc,cn->bqkn', p_c, overlap)
        cur = t // SEL_BLOCK
        valid = blk[None, :] <= cur[:, None]
        forced = (blk[None, :] == 0) | (blk[None, :] == cur[:, None]) | (blk[None, :] == cur[:, None] - 1)
        imp = jnp.where(valid[None, :, None, :],
                        jnp.where(forced[None, :, None, :], FORCE, imp), NEG)
        _, idx = lax.top_k(imp, top_n)

        k_sel = ks_blocks[b_ix, h_ix, idx]
        v_sel = vs_blocks[b_ix, h_ix, idx]
        s_s = jnp.einsum('bqkgd,bqknjd->bqkgnj', qrb, k_sel) * scale
        tok = idx[..., None] * SEL_BLOCK + jnp.arange(SEL_BLOCK)
        m_s = tok <= t[None, :, None, None, None]
        p_s = masked_softmax(s_s, m_s[:, :, :, None], axis=(-2, -1))
        o_s = jnp.einsum('bqkgnj,bqknjd->bqkgd', p_s.astype(v_sel.dtype), v_sel)

        kwb = lax.dynamic_slice_in_dim(kw_pad, qs, Q_BLOCK + WINDOW, axis=1)
        vwb = lax.dynamic_slice_in_dim(vw_pad, qs, Q_BLOCK + WINDOW, axis=1)
        kpos = qs - WINDOW + jnp.arange(Q_BLOCK + WINDOW)
        m_w = (kpos[None, :] <= t[:, None]) & (kpos[None, :] > t[:, None] - WINDOW) & (kpos[None, :] >= 0)
        s_w = jnp.einsum('bqkgd,bwkd->bqkgw', qrb, kwb) * scale
        p_w = masked_softmax(s_w, m_w[None, :, None, None, :])
        o_w = jnp.einsum('bqkgw,bwkd->bqkgd', p_w.astype(vwb.dtype), vwb)

        o = gb[..., 0:1] * o_c + gb[..., 1:2] * o_s + gb[..., 2:3] * o_w
        return o.reshape(B, Q_BLOCK, NSA_Q_W)

    out = lax.map(block_fn, jnp.arange(S // Q_BLOCK))
    out = out.transpose(1, 0, 2, 3).reshape(B, S, NSA_Q_W)
    return out @ w_out


def shared_kv(x, kv_norm_g, kv_w):
    B, S, _ = x.shape
    hkv = rmsnorm(x, kv_norm_g)
    kv = hkv @ kv_w
    k = kv[..., :DIFF_Q_W].reshape(B, S, DIFF_HEADS * 2, DIFF_QK_DIM)
    k = partial_rope(k, jnp.arange(S)).reshape(B, S, DIFF_HEADS, 2, DIFF_QK_DIM)
    v = kv[..., DIFF_Q_W:].reshape(B, S, DIFF_HEADS, DIFF_V_DIM)
    return k, v


def diff_mixer(h, w_q, lam_vec, subln_g, w_out, k, v, lam_init):
    B, S, _ = h.shape
    q = (h @ w_q).reshape(B, S, DIFF_HEADS * 2, DIFF_QK_DIM)
    q = partial_rope(q, jnp.arange(S)).reshape(B, S, DIFF_HEADS, 2, DIFF_QK_DIM)
    lv = lam_vec.astype(jnp.float32)
    lam = jnp.exp(jnp.sum(lv[0] * lv[1])) - jnp.exp(jnp.sum(lv[2] * lv[3])) + lam_init
    scale = DIFF_QK_DIM ** -0.5
    kpos = jnp.arange(S)

    def block_fn(i):
        qs = i * Q_BLOCK
        t = qs + jnp.arange(Q_BLOCK)
        qb = lax.dynamic_slice_in_dim(q, qs, Q_BLOCK, axis=1)
        s = jnp.einsum('bqhcd,bkhcd->bhcqk', qb, k) * scale
        mask = kpos[None, :] <= t[:, None]
        p = masked_softmax(s, mask[None, None, None])
        a = p[:, :, 0] - lam * p[:, :, 1]
        return jnp.einsum('bhqk,bkhd->bqhd', a.astype(v.dtype), v)

    o = lax.map(block_fn, jnp.arange(S // Q_BLOCK))
    o = jnp.moveaxis(o, 0, 1).reshape(B, S, DIFF_HEADS, DIFF_V_DIM)
    o = rmsnorm(o, subln_g) * (1.0 - lam_init)
    return o.reshape(B, S, DIFF_V_W) @ w_out


def conv_glu_ffn(h, w_in, conv_w, conv_b, w_out):
    S = h.shape[1]
    u = h @ w_in
    up = jnp.pad(u, ((0, 0), (CONV_WIDTH - 1, 0), (0, 0)))
    c = conv_b
    for tap in range(CONV_WIDTH):
        c = c + up[:, tap:tap + S] * conv_w[tap]
    gate = c[..., :FFN_DIM]
    val = c[..., FFN_DIM:]
    return (jax.nn.silu(gate) * val) @ w_out


def setup_inputs(seed: int = 0) -> dict:
    key = jax.random.key(seed)
    ks = jax.random.split(key, 24)
    f32 = jnp.float32

    def nrm(k, shape, fan):
        return jax.random.normal(k, shape, f32) * (fan ** -0.5)

    def gain(k, shape):
        return 1.0 + 0.02 * jax.random.normal(k, shape, f32)

    NA, NB = N_A_LAYERS, N_B_LAYERS
    return {
        "x": jax.random.normal(ks[0], (BATCH, SEQ, D_MODEL), f32),
        "attn_norm_g": gain(ks[1], (DEPTH, D_MODEL)),
        "ffn_norm_g": gain(ks[2], (DEPTH, D_MODEL)),
        "nsa_w_in": nrm(ks[3], (NA, D_MODEL, NSA_IN_W), D_MODEL),
        "nsa_w_out": nrm(ks[4], (NA, NSA_Q_W, D_MODEL), NSA_Q_W),
        "nsa_phi_pe": 0.1 * jax.random.normal(ks[5], (NA, 2, CMP_BLOCK, HEAD_DIM), f32),
        "nsa_phi_w1": nrm(ks[6], (NA, 2, CMP_BLOCK * HEAD_DIM, PHI_HIDDEN), CMP_BLOCK * HEAD_DIM),
        "nsa_phi_b1": 0.02 * jax.random.normal(ks[7], (NA, 2, PHI_HIDDEN), f32),
        "nsa_phi_w2": nrm(ks[8], (NA, 2, PHI_HIDDEN, HEAD_DIM), PHI_HIDDEN),
        "kv_norm_g": gain(ks[9], (D_MODEL,)),
        "kv_w": nrm(ks[10], (D_MODEL, DIFF_Q_W + DIFF_V_W), D_MODEL),
        "diff_w_q": nrm(ks[11], (NB, D_MODEL, DIFF_Q_W), D_MODEL),
        "diff_lambda": 0.1 * jax.random.normal(ks[12], (NB, 4, DIFF_QK_DIM), f32),
        "diff_subln_g": gain(ks[13], (NB, DIFF_V_DIM)),
        "diff_w_out": nrm(ks[14], (NB, DIFF_V_W, D_MODEL), DIFF_V_W),
        "ffn_w_in": nrm(ks[15], (DEPTH, D_MODEL, 2 * FFN_DIM), D_MODEL),
        "ffn_conv_w": nrm(ks[16], (DEPTH, CONV_WIDTH, 2 * FFN_DIM), CONV_WIDTH),
        "ffn_conv_b": 0.02 * jax.random.normal(ks[17], (DEPTH, 2 * FFN_DIM), f32),
        "ffn_w_out": nrm(ks[18], (DEPTH, FFN_DIM, D_MODEL), FFN_DIM),
        "final_norm_g": gain(ks[19], (D_MODEL,)),
    }


def reference(x, attn_norm_g, ffn_norm_g, nsa_w_in, nsa_w_out, nsa_phi_pe, nsa_phi_w1, nsa_phi_b1,
              nsa_phi_w2, kv_norm_g, kv_w, diff_w_q, diff_lambda, diff_subln_g, diff_w_out,
              ffn_w_in, ffn_conv_w, ffn_conv_b, ffn_w_out, final_norm_g):
    k_sh = None
    v_sh = None
    for l in range(DEPTH):
        h = rmsnorm(x, attn_norm_g[l])
        if l < N_A_LAYERS:
            x = x + nsa_mixer(h, nsa_w_in[l], nsa_w_out[l], nsa_phi_pe[l], nsa_phi_w1[l],
                              nsa_phi_b1[l], nsa_phi_w2[l])
        else:
            j = l - N_A_LAYERS
            lam_init = 0.8 - 0.6 * math.exp(-0.3 * l)
            x = x + diff_mixer(h, diff_w_q[j], diff_lambda[j], diff_subln_g[j], diff_w_out[j],
                               k_sh, v_sh, lam_init)
        h = rmsnorm(x, ffn_norm_g[l])
        x = x + conv_glu_ffn(h, ffn_w_in[l], ffn_conv_w[l], ffn_conv_b[l], ffn_w_out[l])
        if l == N_A_LAYERS - 1:
            k_sh, v_sh = shared_kv(x, kv_norm_g, kv_w)
    return rmsnorm(x, final_norm_g)
```

```cpp
#include <hip/hip_runtime.h>
#include <hip/hip_cooperative_groups.h>
#include <math.h>
#include <stdint.h>
#include <stdio.h>
namespace cg = cooperative_groups;

#ifndef ONE_LAUNCH
#define ONE_LAUNCH 1
#endif

typedef unsigned short u16;
typedef __attribute__((ext_vector_type(8))) short bf16x8;
typedef __attribute__((ext_vector_type(16))) float f32x16;
typedef __bf16 bf2_t __attribute__((ext_vector_type(2)));
typedef float f2_t __attribute__((ext_vector_type(2)));
typedef unsigned v4u __attribute__((ext_vector_type(4)));
typedef unsigned v2u __attribute__((ext_vector_type(2)));
#define DI __device__ __forceinline__

#define MFMA(a, b, c) __builtin_amdgcn_mfma_f32_32x32x16_bf16((a), (b), (c), 0, 0, 0)
typedef __attribute__((ext_vector_type(4))) float f32x4;
#define MFMA16(a, b, c) __builtin_amdgcn_mfma_f32_16x16x32_bf16((a), (b), (c), 0, 0, 0)

constexpr int T_ = 16384, S_ = 8192, D_ = 1024;
constexpr int LDP = 2608;
constexpr int FF = 2752, FF2 = 5504;
constexpr float SC = 0.125f * 1.4426950408889634f;

constexpr size_t OFF_WNI = 0;
constexpr size_t OFF_WNO = OFF_WNI + 2ull * 2608 * 1024 * 2;
constexpr size_t OFF_WP1 = OFF_WNO + 2ull * 1024 * 1024 * 2;
constexpr size_t OFF_WP2 = OFF_WP1 + 4ull * 256 * 2048 * 2;
constexpr size_t OFF_WKV = OFF_WP2 + 4ull * 64 * 256 * 2;
constexpr size_t OFF_WDQ = OFF_WKV + 2048ull * 1024 * 2;
constexpr size_t OFF_WDO = OFF_WDQ + 2ull * 1024 * 1024 * 2;
constexpr size_t OFF_WFI = OFF_WDO + 2ull * 1024 * 1024 * 2;
constexpr size_t OFF_WFO = OFF_WFI + 4ull * 5504 * 1024 * 2;
constexpr size_t OFF_ROPE = OFF_WFO + 4ull * 1024 * 2752 * 2;
constexpr size_t OFF_CB = OFF_ROPE + 8192ull * 16 * 4;
constexpr size_t OFF_BAR = OFF_CB + 4096;
constexpr size_t OFF_H = OFF_BAR + 16384;
constexpr size_t OFF_SKVK = OFF_H + (size_t)T_ * 1024 * 2;
constexpr size_t OFF_SKVV = OFF_SKVK + (size_t)T_ * 1024 * 2;
constexpr size_t OFF_XB = OFF_SKVV + (size_t)T_ * 1024 * 2;
constexpr size_t OFF_SSQ = OFF_XB + (size_t)T_ * 1024 * 2;
constexpr size_t OFF_BIG = OFF_SSQ + (size_t)T_ * 8 * 4;
constexpr size_t OFF_PROJ = OFF_BIG;
constexpr size_t OFF_KSF = OFF_PROJ + (size_t)T_ * LDP * 2;
constexpr size_t OFF_KWF = OFF_KSF + (size_t)T_ * 256 * 2;
constexpr size_t OFF_VSF = OFF_KWF + (size_t)T_ * 256 * 2;
constexpr size_t OFF_VWF = OFF_VSF + (size_t)T_ * 256 * 2;
constexpr size_t OFF_HID = OFF_VWF + (size_t)T_ * 256 * 2;
constexpr size_t OFF_KCF = OFF_HID + 2ull * 4096 * 256 * 2;
constexpr size_t OFF_VCF = OFF_KCF + 2ull * 4 * 512 * 64 * 2;
constexpr size_t OFF_ACT = OFF_BIG;
constexpr size_t OFF_HALO = OFF_ACT + (size_t)T_ * 2752 * 2;
constexpr size_t OFF_Q = OFF_BIG;
constexpr size_t OFF_KVRAW = OFF_Q + (size_t)T_ * 1024 * 2;
constexpr size_t WS_NEEDED = OFF_VCF + 2ull * 4 * 512 * 64 * 2;

struct Params {
  const float* in[20];
  float* out;
  char* ws;
};

enum { OP_PREP = 0, OP_NORM, OP_NSA_IN, OP_NSA_PACK, OP_NSA_CMP2, OP_NSA_ATTN, OP_OUTPROJ, OP_FFN1, OP_CONV, OP_FFN2,
       OP_FIX, OP_KVQ_NORM, OP_KVQ_GEMM, OP_KV_PACK, OP_DIFF_ATTN, OP_DIFF_COMB, OP_DQ_GEMM, OP_FINAL };
struct Step { int op, layer, aux; };
#define FFN_STEPS(l) {OP_FFN1, l, 0}, {OP_FFN2, l, 0}
#define NSA_STEPS(l) {OP_NSA_IN, l, 0}, {OP_NSA_PACK, l, 0}, {OP_NSA_CMP2, l, 0}, {OP_NSA_ATTN, l, 0}, {OP_OUTPROJ, l, 0}
__constant__ Step g_prog[] = {
  {OP_PREP, 0, 0},
  NSA_STEPS(0), FFN_STEPS(0),
  NSA_STEPS(1), FFN_STEPS(1),
  {OP_KVQ_GEMM, 2, 0}, {OP_KV_PACK, 2, 0}, {OP_DIFF_ATTN, 2, 0}, {OP_DIFF_COMB, 2, 0}, {OP_OUTPROJ, 2, 0}, FFN_STEPS(2),
  {OP_DQ_GEMM, 3, 0}, {OP_DIFF_ATTN, 3, 0}, {OP_DIFF_COMB, 3, 0}, {OP_OUTPROJ, 3, 0}, FFN_STEPS(3),
  {OP_FINAL, 0, 0},
};
constexpr int N_STEPS = 1 + 7 + 7 + 7 + 6 + 1;

DI int get_tid() { int t = (int)__builtin_amdgcn_workitem_id_x(); asm volatile("" : "+v"(t)); return t; }
DI int get_bid() { int b = (int)__builtin_amdgcn_workgroup_id_x(); asm volatile("" : "+s"(b)); return b; }
DI v4u mk4(unsigned a, unsigned b, unsigned c, unsigned d) { v4u r = {a, b, c, d}; return r; }
DI v2u mk2(unsigned a, unsigned b) { v2u r = {a, b}; return r; }
DI unsigned pk2(float a, float b) { f2_t v = {a, b}; bf2_t r = __builtin_convertvector(v, bf2_t); return __builtin_bit_cast(unsigned, r); }
DI float bflo(unsigned u) { return __uint_as_float(u << 16); }
DI float bfhi(unsigned u) { return __uint_as_float(u & 0xffff0000u); }
DI float bf1(u16 v) { return __uint_as_float((unsigned)v << 16); }
DI u16 f2bf(float x) { return (u16)(pk2(x, 0.f) & 0xffffu); }
DI float wave_sum(float v) {
#pragma unroll
  for (int o = 32; o >= 1; o >>= 1) v += __shfl_xor(v, o);
  return v;
}
DI void unpack8(v4u a, float* f) {
  f[0] = bflo(a.x); f[1] = bfhi(a.x); f[2] = bflo(a.y); f[3] = bfhi(a.y);
  f[4] = bflo(a.z); f[5] = bfhi(a.z); f[6] = bflo(a.w); f[7] = bfhi(a.w);
}
DI v4u pack8(const float* f) { return mk4(pk2(f[0], f[1]), pk2(f[2], f[3]), pk2(f[4], f[5]), pk2(f[6], f[7])); }
DI bf16x8 pack_frag(const f32x16& x, int s) {
  v4u r = mk4(pk2(x[8 * s + 0], x[8 * s + 1]), pk2(x[8 * s + 2], x[8 * s + 3]), pk2(x[8 * s + 4], x[8 * s + 5]), pk2(x[8 * s + 6], x[8 * s + 7]));
  return __builtin_bit_cast(bf16x8, r);
}
DI size_t kfrag_chunk(int key, int c  ) { return ((size_t)(((key >> 5) * 4 + (c >> 1)) * 64 + (c & 1) * 32 + (key & 31))) * 8; }
template <int NDVT> DI size_t vfrag_index(int key, int dv) {
  int tile = key >> 6, s = (key >> 4) & 3, kk = key & 15, h = (kk >> 2) & 1, j = ((kk >> 3) << 2) | (kk & 3);
  return ((size_t)((((tile * NDVT + (dv >> 5)) * 4 + s) * 64) + h * 32 + (dv & 31))) * 8 + j;
}

struct ARow { const u16* base; int ld; DI const u16* operator()(int row, int k) const { return base + (size_t)row * ld + k; } };
struct ACmp {
  const u16* proj; int colbase;
  DI const u16* operator()(int r, int k) const {
    int hk = r & 3, i = (r >> 2) & 511, b = r >> 11; i = i > 510 ? 510 : i;
    return proj + (size_t)(b * S_ + 16 * i + (k >> 6)) * LDP + colbase + hk * 64 + (k & 63);
  }
};
struct EpiStore { static constexpr bool kTileEpi = false; u16* C; int ld; int N;
  DI void operator()(int m, int n, float a, float b, float c, float d) const { if (n < N) *(v2u*)(C + (size_t)m * ld + n) = mk2(pk2(a, b), pk2(c, d)); } };
struct EpiResid { static constexpr bool kTileEpi = false; const float* xin; float* xout;
  DI void operator()(int m, int n, float a, float b, float c, float d) const {
    float4 x = *(const float4*)(xin + (size_t)m * D_ + n); x.x += a; x.y += b; x.z += c; x.w += d; *(float4*)(xout + (size_t)m * D_ + n) = x; } };
DI float gelu_t(float x) { return 0.5f * x * (1.f + tanhf(0.7978845608028654f * (x + 0.044715f * x * x * x))); }
struct EpiGelu { static constexpr bool kTileEpi = false; const float* bias; u16* C;
  DI void operator()(int m, int n, float a, float b, float c, float d) const {
    float4 bb = *(const float4*)(bias + n);
    *(v2u*)(C + (size_t)m * 256 + n) = mk2(pk2(gelu_t(a + bb.x), gelu_t(b + bb.y)), pk2(gelu_t(c + bb.z), gelu_t(d + bb.w))); } };
struct EpiCmpOut { static constexpr bool kTileEpi = false; u16* kcf; u16* vcf; int kv;
  DI void operator()(int m, int n, float a, float b, float c, float d) const {
    if (n >= 64) return;
    int hk = m & 3, i = (m >> 2) & 511, bb = m >> 11;
    if (i == 511) { a = b = c = d = 0.f; }
    size_t sb = (size_t)(bb * 4 + hk) * 512 * 64;
    if (kv == 0) { *(v2u*)(kcf + sb + kfrag_chunk(i, n >> 3) + (n & 7)) = mk2(pk2(a, b), pk2(c, d)); }
    else { vcf[sb + vfrag_index<2>(i, n)] = f2bf(a); vcf[sb + vfrag_index<2>(i, n + 1)] = f2bf(b); vcf[sb + vfrag_index<2>(i, n + 2)] = f2bf(c); vcf[sb + vfrag_index<2>(i, n + 3)] = f2bf(d); }
  } };


DI float rrow(const float* __restrict__ ssq, int m) {
  const float4 a = *(const float4*)(ssq + (size_t)m * 8), b = *(const float4*)(ssq + (size_t)m * 8 + 4);
  return rsqrtf(((a.x + a.y) + (a.z + a.w) + (b.x + b.y) + (b.z + b.w)) * (1.f / 1024.f) + 1e-6f);
}
constexpr int CT_ROW = 264;
struct EpiStoreT { static constexpr bool kTileEpi = true; static constexpr bool kRs = true;
  u16* C; int ld; const float* ssq;
  DI void tile(f32x4 (&acc)[8][4], const float (&rs)[4], int m0, int n0, int N, char* smem) const {
    u16* Ct = (u16*)smem;
    const int tid = get_tid(), lane = tid & 63, wave = tid >> 6, wm = wave & 1, wn = wave >> 1, l15 = lane & 15, lq = lane >> 4;
    __syncthreads();
#pragma unroll
    for (int ni = 0; ni < 8; ++ni)
#pragma unroll
      for (int mi = 0; mi < 4; ++mi) {
        const int m = wm * 64 + mi * 16 + l15, n = wn * 128 + ni * 16 + 4 * lq;
        const float s = rs[mi];
        *(v2u*)(Ct + m * CT_ROW + n) = mk2(pk2(acc[ni][mi][0] * s, acc[ni][mi][1] * s), pk2(acc[ni][mi][2] * s, acc[ni][mi][3] * s));
      }
    __syncthreads();
    const int ch = tid & 31, r0 = tid >> 5;
    if (n0 + ch * 8 < N) {
#pragma unroll
      for (int k = 0; k < 16; ++k) {
        const int m = r0 + 8 * k;
        *(v4u*)(C + (size_t)(m0 + m) * ld + n0 + ch * 8) = *(const v4u*)(Ct + m * CT_ROW + ch * 8);
      }
    }
  } };
constexpr int RT_ROW = 132;
template <bool F32IN>
struct EpiResidT { static constexpr bool kTileEpi = true; static constexpr bool kRs = false;
  const float* xin; float* xout; u16* xb; float* ssq;
  DI void tile(f32x4 (&acc)[8][4], const float (&rs)[4], int m0, int n0, int N, char* smem) const {
    float* Rt = (float*)smem;
    const int tid = get_tid(), lane = tid & 63, wave = tid >> 6, wm = wave & 1, wn = wave >> 1, l15 = lane & 15, lq = lane >> 4;
    const int ch = tid & 31, r0 = tid >> 5;
    if constexpr (!F32IN) {
      for (int pass = 0; pass < 2; ++pass) {
        v2u ur[16];
        const unsigned voff = (unsigned)(r0 * D_ + ch * 4);
        u16* const pbase = xb + (size_t)m0 * D_ + n0 + pass * 128;
#pragma unroll
        for (int k = 0; k < 16; ++k) ur[k] = *(const v2u*)(pbase + (size_t)(8 * k) * D_ + voff);
        __syncthreads();
        if (wn == pass) {
#pragma unroll
          for (int ni = 0; ni < 8; ++ni)
#pragma unroll
            for (int mi = 0; mi < 4; ++mi) {
              const int m = wm * 64 + mi * 16 + l15, n = ni * 16 + 4 * lq;
              *(float4*)(Rt + m * RT_ROW + n) = make_float4(acc[ni][mi][0], acc[ni][mi][1], acc[ni][mi][2], acc[ni][mi][3]);
            }
        }
        __syncthreads();
#pragma unroll
        for (int k = 0; k < 16; ++k) {
          if ((k & 3) == 0) __builtin_amdgcn_sched_barrier(0);
          const int m = r0 + 8 * k;
          float4 x = make_float4(bflo(ur[k].x), bfhi(ur[k].x), bflo(ur[k].y), bfhi(ur[k].y));
          const float4 a = *(const float4*)(Rt + m * RT_ROW + ch * 4);
          x.x += a.x; x.y += a.y; x.z += a.z; x.w += a.w;
          *(v2u*)(pbase + (size_t)(8 * k) * D_ + voff) = mk2(pk2(x.x, x.y), pk2(x.z, x.w));
          float ss = x.x * x.x + x.y * x.y + x.z * x.z + x.w * x.w;
#pragma unroll
          for (int o = 16; o >= 1; o >>= 1) ss += __shfl_xor(ss, o);
          if (ch == 0) ssq[(size_t)(m0 + m) * 8 + ((n0 >> 7) + pass)] = ss;
        }
      }
      return;
    }
    for (int pass = 0; pass < 2; ++pass) {
      float4 xr[8];
#pragma unroll
      for (int k = 0; k < 8; ++k) {
        const size_t o_ = (size_t)(m0 + r0 + 8 * k) * D_ + n0 + pass * 128 + ch * 4;
        if constexpr (F32IN) xr[k] = *(const float4*)(xin + o_);
        else { const v2u u_ = *(const v2u*)(xb + o_); xr[k] = make_float4(bflo(u_.x), bfhi(u_.x), bflo(u_.y), bfhi(u_.y)); }
      }
      __syncthreads();
      if (wn == pass) {
#pragma unroll
        for (int ni = 0; ni < 8; ++ni)
#pragma unroll
          for (int mi = 0; mi < 4; ++mi) {
            const int m = wm * 64 + mi * 16 + l15, n = ni * 16 + 4 * lq;
            *(float4*)(Rt + m * RT_ROW + n) = make_float4(acc[ni][mi][0], acc[ni][mi][1], acc[ni][mi][2], acc[ni][mi][3]);
          }
      }
      __syncthreads();
#pragma unroll 1
      for (int kh = 0; kh < 2; ++kh) {
        if (kh == 1) {
#pragma unroll
          for (int k = 0; k < 8; ++k) {
            const size_t o_ = (size_t)(m0 + r0 + 8 * (8 + k)) * D_ + n0 + pass * 128 + ch * 4;
            if constexpr (F32IN) xr[k] = *(const float4*)(xin + o_);
            else { const v2u u_ = *(const v2u*)(xb + o_); xr[k] = make_float4(bflo(u_.x), bfhi(u_.x), bflo(u_.y), bfhi(u_.y)); }
          }
        }
#pragma unroll
        for (int k = 0; k < 8; ++k) {
          const int m = r0 + 8 * (kh * 8 + k);
          const size_t off = (size_t)(m0 + m) * D_ + n0 + pass * 128 + ch * 4;
          float4 x = xr[k];
          const float4 a = *(const float4*)(Rt + m * RT_ROW + ch * 4);
          x.x += a.x; x.y += a.y; x.z += a.z; x.w += a.w;
          *(v2u*)(xb + off) = mk2(pk2(x.x, x.y), pk2(x.z, x.w));
          float ss = x.x * x.x + x.y * x.y + x.z * x.z + x.w * x.w;
#pragma unroll
          for (int o = 16; o >= 1; o >>= 1) ss += __shfl_xor(ss, o);
          if (ch == 0) ssq[(size_t)(m0 + m) * 8 + ((n0 >> 7) + pass)] = ss;
        }
      }
    }
  } };
constexpr int UT_ROW = 136;
DI float silu_mul(float g, float v) { return g / (1.f + __expf(-g)) * v; }
struct EpiConvGlu { static constexpr bool kTileEpi = true; static constexpr bool kRs = true;
  u16* act; u16* halo; const float* cw; const float* cb; const float* ssq;
  DI void tile(f32x4 (&acc)[8][4], const float (&rs)[4], int m0, int n0, int N, char* smem) const {
    u16* Ut = (u16*)smem;
    const int tid = get_tid(), lane = tid & 63, wave = tid >> 6, wm = wave & 1, wn = wave >> 1, l15 = lane & 15, lq = lane >> 4;
    for (int pass = 0; pass < 2; ++pass) {
    if (n0 + pass * 128 >= N) break;
    const int tm = m0 >> 7, tn = (n0 >> 7) + pass;
    const int c = tid & 7, j0 = tn * 64 + c * 8;
    float wg[3][8], wv[3][8], bg[8], bv[8];
#pragma unroll
    for (int hq = 0; hq < 2; ++hq) {
#pragma unroll
      for (int tp = 0; tp < 3; ++tp) {
        float4 a = *(const float4*)(cw + tp * FF2 + j0 + 4 * hq), b = *(const float4*)(cw + tp * FF2 + FF + j0 + 4 * hq);
        wg[tp][4 * hq] = a.x; wg[tp][4 * hq + 1] = a.y; wg[tp][4 * hq + 2] = a.z; wg[tp][4 * hq + 3] = a.w;
        wv[tp][4 * hq] = b.x; wv[tp][4 * hq + 1] = b.y; wv[tp][4 * hq + 2] = b.z; wv[tp][4 * hq + 3] = b.w;
      }
      float4 a = *(const float4*)(cb + j0 + 4 * hq), b = *(const float4*)(cb + FF + j0 + 4 * hq);
      bg[4 * hq] = a.x; bg[4 * hq + 1] = a.y; bg[4 * hq + 2] = a.z; bg[4 * hq + 3] = a.w;
      bv[4 * hq] = b.x; bv[4 * hq + 1] = b.y; bv[4 * hq + 2] = b.z; bv[4 * hq + 3] = b.w;
    }
    __syncthreads();
    if (wn == pass) {
#pragma unroll
    for (int ni = 0; ni < 8; ++ni)
#pragma unroll
      for (int mi = 0; mi < 4; ++mi) {
        const int m = wm * 64 + mi * 16 + l15, n = ni * 16 + 4 * lq;
        const float s = rs[mi];
        *(v2u*)(Ut + m * UT_ROW + n) = mk2(pk2(acc[ni][mi][0] * s, acc[ni][mi][1] * s), pk2(acc[ni][mi][2] * s, acc[ni][mi][3] * s));
      }
    }
    __syncthreads();
    if (tid < 64) {
      int rr = tid >> 4, c2 = tid & 15, row = rr < 2 ? rr : 124 + rr, n = c2 * 8, half = n >> 6, j = tn * 64 + (n & 63);
      *(v4u*)(halo + ((size_t)((tm * 4 + rr) * 2 + half)) * FF + j) = *(const v4u*)(Ut + row * UT_ROW + n);
    }
#pragma unroll
    for (int k = 0; k < 4; ++k) {
      const int m = (tid >> 3) + 32 * k;
      if (m >= 2) {
        float g0[8], g1[8], g2[8], v0[8], v1[8], v2[8], o[8];
        unpack8(*(const v4u*)(Ut + m * UT_ROW + c * 8), g0); unpack8(*(const v4u*)(Ut + m * UT_ROW + 64 + c * 8), v0);
        unpack8(*(const v4u*)(Ut + (m - 1) * UT_ROW + c * 8), g1); unpack8(*(const v4u*)(Ut + (m - 1) * UT_ROW + 64 + c * 8), v1);
        unpack8(*(const v4u*)(Ut + (m - 2) * UT_ROW + c * 8), g2); unpack8(*(const v4u*)(Ut + (m - 2) * UT_ROW + 64 + c * 8), v2);
#pragma unroll
        for (int e = 0; e < 8; ++e)
          o[e] = silu_mul(bg[e] + wg[0][e] * g2[e] + wg[1][e] * g1[e] + wg[2][e] * g0[e], bv[e] + wv[0][e] * v2[e] + wv[1][e] * v1[e] + wv[2][e] * v0[e]);
        *(v4u*)(act + (size_t)(m0 + m) * FF + j0) = pack8(o);
      }
    }
    }
  } };
DI void ld_halo(const u16* __restrict__ halo, int tm, int rr, int half, int j0, float* f) { unpack8(*(const v4u*)(halo + ((size_t)((tm * 4 + rr) * 2 + half)) * FF + j0), f); }
DI void ffn_fix_task(const u16* __restrict__ halo, u16* __restrict__ act, const float* __restrict__ cw, const float* __restrict__ cb, int task) {
  const int ck = task % 344, rest = task / 344, r = rest & 1, tm = rest >> 1, j0 = ck * 8;
  const bool first = (tm & 63) == 0;
  float g0[8], g1[8], g2[8], v0[8], v1[8], v2[8], o[8];
#pragma unroll
  for (int e = 0; e < 8; ++e) { g1[e] = g2[e] = v1[e] = v2[e] = 0.f; }
  ld_halo(halo, tm, r, 0, j0, g0); ld_halo(halo, tm, r, 1, j0, v0);
  if (r == 1) { ld_halo(halo, tm, 0, 0, j0, g1); ld_halo(halo, tm, 0, 1, j0, v1); if (!first) { ld_halo(halo, tm - 1, 3, 0, j0, g2); ld_halo(halo, tm - 1, 3, 1, j0, v2); } }
  else if (!first) { ld_halo(halo, tm - 1, 3, 0, j0, g1); ld_halo(halo, tm - 1, 3, 1, j0, v1); ld_halo(halo, tm - 1, 2, 0, j0, g2); ld_halo(halo, tm - 1, 2, 1, j0, v2); }
#pragma unroll
  for (int e = 0; e < 8; ++e) {
    float cgv = cb[j0 + e] + cw[j0 + e] * g2[e] + cw[FF2 + j0 + e] * g1[e] + cw[2 * FF2 + j0 + e] * g0[e];
    float cvv = cb[FF + j0 + e] + cw[FF + j0 + e] * v2[e] + cw[FF2 + FF + j0 + e] * v1[e] + cw[2 * FF2 + FF + j0 + e] * v0[e];
    o[e] = silu_mul(cgv, cvv);
  }
  *(v4u*)(act + (size_t)(tm * 128 + r) * FF + j0) = pack8(o);
}

constexpr int G_ST = 24576;
#define GLDS1(gp_, ldsaddr_)                                                                                               \
  { unsigned keep_; const void* g_ = (const void*)(gp_); unsigned la_ = __builtin_amdgcn_readfirstlane(ldsaddr_);          \
    asm volatile("s_mov_b32 %0, m0\n\ts_mov_b32 m0, %2\n\ts_nop 0\n\tglobal_load_lds_dwordx4 %1, off\n\ts_mov_b32 m0, %0" : "=&s"(keep_) : "v"(g_), "s"(la_) : "memory"); }
template <class AF, class EP>
DI void gemm_tile(const AF& af, const u16* __restrict__ Bt, int N, int K, int m0, int n0, const EP& ep, char* smem) {
  const int tid = get_tid(), lane = tid & 63;
  const int wv = __builtin_amdgcn_readfirstlane(tid >> 6);
  const int wm = wv & 1, wn = wv >> 1;
  const int l15 = lane & 15, lq = lane >> 4;
  const unsigned lds0 = (unsigned)(size_t)smem;
  const int drow = lane >> 2, dc = ((lane & 3) ^ ((4 - ((lane >> 4) & 3)) & 3)) * 8;
  const u16* pb[4];
#pragma unroll
  for (int j = 0; j < 4; ++j) { int nb = n0 + (4 * wv + j) * 16 + drow; nb = nb < N ? nb : N - 1; pb[j] = Bt + (size_t)nb * K + dc; }
  f32x4 acc[8][4];
#pragma unroll
  for (int a = 0; a < 8; ++a)
#pragma unroll
    for (int b = 0; b < 4; ++b)
#pragma unroll
      for (int i = 0; i < 4; ++i) acc[a][b][i] = 0.f;
#define G_DMA(kt_, st_)                                                                                     \
  { const unsigned sb_ = lds0 + (unsigned)((st_) * G_ST);                                                   \
    _Pragma("unroll") for (int j = 0; j < 2; ++j) GLDS1(af(m0 + (2 * wv + j) * 16 + drow, (kt_) * 32 + dc), sb_ + (2 * wv + j) * 1024) \
    _Pragma("unroll") for (int j = 0; j < 4; ++j) GLDS1(pb[j] + (kt_) * 32, sb_ + 8192 + (4 * wv + j) * 1024) }
  asm volatile("s_waitcnt vmcnt(0)" ::: "memory");
  __syncthreads();
  const int nk = K >> 5;
  float rsv[4] = {1.f, 1.f, 1.f, 1.f};
  float4 rq[EP::kTileEpi ? 8 : 1];
  if constexpr (EP::kTileEpi) { if constexpr (EP::kRs) {
#pragma unroll
    for (int mi = 0; mi < 4; ++mi) { const float* sp = ep.ssq + (size_t)(m0 + wm * 64 + mi * 16 + l15) * 8; rq[2 * mi] = *(const float4*)sp; rq[2 * mi + 1] = *(const float4*)(sp + 4); }
  } }
  G_DMA(0, 0)
  if (nk > 1) G_DMA(1, 1)
  if constexpr (EP::kTileEpi) { if constexpr (EP::kRs) {
#pragma unroll
    for (int mi = 0; mi < 4; ++mi) { const float4 a = rq[2 * mi], b = rq[2 * mi + 1]; rsv[mi] = rsqrtf(((a.x + a.y) + (a.z + a.w) + (b.x + b.y) + (b.z + b.w)) * (1.f / 1024.f) + 1e-6f); }
  } }
  const int co = (lq ^ ((4 - ((l15 >> 2) & 3)) & 3)) * 16;
  int st = 0;
  for (int kt = 0; kt < nk; ++kt) {
    if (kt + 1 < nk) asm volatile("s_waitcnt vmcnt(6)" ::: "memory"); else asm volatile("s_waitcnt vmcnt(0)" ::: "memory");
    asm volatile("s_waitcnt lgkmcnt(0)" ::: "memory");
    __builtin_amdgcn_s_barrier();
    if (kt + 2 < nk) { const int s2 = st >= 1 ? st - 1 : 2; G_DMA(kt + 2, s2) }
    {
      const char* sbase = smem + st * G_ST;
      const char* pB = sbase + (wm * 64 + l15) * 64 + co;
      const char* pA = sbase + 8192 + (wn * 128 + l15) * 64 + co;
      bf16x8 fb[4], fa[8];
#pragma unroll
      for (int mi = 0; mi < 4; ++mi) fb[mi] = *(const bf16x8*)(pB + mi * 16 * 64);
#pragma unroll
      for (int ni = 0; ni < 8; ++ni) fa[ni] = *(const bf16x8*)(pA + ni * 16 * 64);
      __builtin_amdgcn_sched_barrier(0);
#pragma unroll
      for (int ni = 0; ni < 8; ++ni)
#pragma unroll
        for (int mi = 0; mi < 4; ++mi) acc[ni][mi] = MFMA16(fa[ni], fb[mi], acc[ni][mi]);
      __builtin_amdgcn_sched_barrier(0);
    }
    st = st == 2 ? 0 : st + 1;
  }
  if constexpr (EP::kTileEpi) {
    ep.tile(acc, rsv, m0, n0, N, smem);
  } else {
#pragma unroll
  for (int ni = 0; ni < 8; ++ni)
#pragma unroll
    for (int mi = 0; mi < 4; ++mi) {
      const int m = m0 + wm * 64 + mi * 16 + l15, n = n0 + wn * 128 + ni * 16 + 4 * lq;
      ep(m, n, acc[ni][mi][0], acc[ni][mi][1], acc[ni][mi][2], acc[ni][mi][3]);
    }
  }
}

DI void norm_row_bf16(const float* __restrict__ x, const float* __restrict__ g, u16* __restrict__ dst, int lane) {
  float4 v[4]; float ss = 0.f;
#pragma unroll
  for (int k = 0; k < 4; ++k) { v[k] = ((const float4*)x)[k * 64 + lane]; ss += v[k].x * v[k].x + v[k].y * v[k].y + v[k].z * v[k].z + v[k].w * v[k].w; }
  ss = wave_sum(ss);
  float r = rsqrtf(ss * (1.f / 1024.f) + 1e-6f);
#pragma unroll
  for (int k = 0; k < 4; ++k) {
    float4 gg = ((const float4*)g)[k * 64 + lane];
    ((v2u*)dst)[k * 64 + lane] = mk2(pk2(v[k].x * r * gg.x, v[k].y * r * gg.y), pk2(v[k].z * r * gg.z, v[k].w * r * gg.w));
  }
}
DI void norm_row_f32(float* __restrict__ x, const float* __restrict__ g, int lane) {
  float4 v[4]; float ss = 0.f;
#pragma unroll
  for (int k = 0; k < 4; ++k) { v[k] = ((const float4*)x)[k * 64 + lane]; ss += v[k].x * v[k].x + v[k].y * v[k].y + v[k].z * v[k].z + v[k].w * v[k].w; }
  ss = wave_sum(ss);
  float r = rsqrtf(ss * (1.f / 1024.f) + 1e-6f);
#pragma unroll
  for (int k = 0; k < 4; ++k) {
    float4 gg = ((const float4*)g)[k * 64 + lane];
    ((float4*)x)[k * 64 + lane] = make_float4(v[k].x * r * gg.x, v[k].y * r * gg.y, v[k].z * r * gg.z, v[k].w * r * gg.w);
  }
}


DI void prep_row_fin(const float4 (&vv)[4], u16* __restrict__ xb, float* __restrict__ ssq, int lane) {
#pragma unroll
  for (int k = 0; k < 4; ++k) {
    const float4 v = vv[k];
    ((v2u*)xb)[k * 64 + lane] = mk2(pk2(v.x, v.y), pk2(v.z, v.w));
    float ss = v.x * v.x + v.y * v.y + v.z * v.z + v.w * v.w;
#pragma unroll
    for (int o = 16; o >= 1; o >>= 1) ss += __shfl_xor(ss, o);
    if ((lane & 31) == 0) ssq[2 * k + (lane >> 5)] = ss;
  }
}

struct Job { int in_idx; unsigned src_off; unsigned long long dst_off; int K, N, perm, g_idx, g_off; };
__constant__ Job g_jobs[25] = {
  {15, 0u, OFF_WFI, 1024, 5504, 1, 2, 0},
  {15, 1024u * 5504u, OFF_WFI + 1ull * 5504 * 1024 * 2, 1024, 5504, 1, 2, 1024},
  {15, 2u * 1024u * 5504u, OFF_WFI + 2ull * 5504 * 1024 * 2, 1024, 5504, 1, 2, 2048},
  {15, 3u * 1024u * 5504u, OFF_WFI + 3ull * 5504 * 1024 * 2, 1024, 5504, 1, 2, 3072},
  {18, 0u, OFF_WFO, 2752, 1024, 0, -1, 0},
  {18, 2752u * 1024u, OFF_WFO + 1ull * 1024 * 2752 * 2, 2752, 1024, 0, -1, 0},
  {18, 2u * 2752u * 1024u, OFF_WFO + 2ull * 1024 * 2752 * 2, 2752, 1024, 0, -1, 0},
  {18, 3u * 2752u * 1024u, OFF_WFO + 3ull * 1024 * 2752 * 2, 2752, 1024, 0, -1, 0},
  {3, 0u, OFF_WNI, 1024, 2608, 0, 1, 0},
  {3, 1024u * 2608u, OFF_WNI + 2608ull * 1024 * 2, 1024, 2608, 0, 1, 1024},
  {4, 0u, OFF_WNO, 1024, 1024, 0, -1, 0},
  {4, 1024u * 1024u, OFF_WNO + 1024ull * 1024 * 2, 1024, 1024, 0, -1, 0},
  {6, 0u, OFF_WP1, 2048, 256, 0, -1, 0},
  {6, 2048u * 256u, OFF_WP1 + 1ull * 256 * 2048 * 2, 2048, 256, 0, -1, 0},
  {6, 2u * 2048u * 256u, OFF_WP1 + 2ull * 256 * 2048 * 2, 2048, 256, 0, -1, 0},
  {6, 3u * 2048u * 256u, OFF_WP1 + 3ull * 256 * 2048 * 2, 2048, 256, 0, -1, 0},
  {8, 0u, OFF_WP2, 256, 64, 0, -1, 0},
  {8, 256u * 64u, OFF_WP2 + 1ull * 64 * 256 * 2, 256, 64, 0, -1, 0},
  {8, 2u * 256u * 64u, OFF_WP2 + 2ull * 64 * 256 * 2, 256, 64, 0, -1, 0},
  {8, 3u * 256u * 64u, OFF_WP2 + 3ull * 64 * 256 * 2, 256, 64, 0, -1, 0},
  {10, 0u, OFF_WKV, 1024, 2048, 0, 9, 0},
  {11, 0u, OFF_WDQ, 1024, 1024, 0, 1, 2048},
  {11, 1024u * 1024u, OFF_WDQ + 1024ull * 1024 * 2, 1024, 1024, 0, 1, 3072},
  {14, 0u, OFF_WDO, 1024, 1024, 0, -1, 0},
  {14, 1024u * 1024u, OFF_WDO + 1024ull * 1024 * 2, 1024, 1024, 0, -1, 0},
};
constexpr int N_TR_TILES = 2 * 656 + 2 * 256 + 4 * 128 + 4 * 4 + 512 + 2 * 256 + 2 * 256 + 4 * 1376 + 4 * 688;

DI void transpose_tile(const Params& p, size_t z, int tile, char* smem, int& j, int& base) {
  for (;;) { int nt = (g_jobs[j].K >> 6) * ((g_jobs[j].N + 63) >> 6); if (tile < base + nt) break; base += nt; ++j; }
  const Job jb = g_jobs[j];
  const float* src = p.in[jb.in_idx] + jb.src_off + z;
  u16* dst = (u16*)(p.ws + jb.dst_off + z);
  const int K = jb.K, N = jb.N;
  const int lt = tile - base, ntn = (N + 63) >> 6;
  const int k0 = (lt / ntn) * 64, n0 = (lt % ntn) * 64;
  float* t = (float*)smem;
  const int tid = get_tid();
  __syncthreads();
  {
    const int n4 = (tid & 15) * 4, kq = tid >> 4;
    const bool ok = (n0 + n4) < N;
    float4 v[4];
#pragma unroll
    for (int i = 0; i < 4; ++i) v[i] = ok ? *(const float4*)(src + (size_t)(k0 + kq + 16 * i) * N + n0 + n4) : make_float4(0.f, 0.f, 0.f, 0.f);
#pragma unroll
    for (int i = 0; i < 4; ++i) { float* tp = t + (kq + 16 * i) * 65 + n4; tp[0] = v[i].x; tp[1] = v[i].y; tp[2] = v[i].z; tp[3] = v[i].w; }
  }
  __syncthreads();
#pragma unroll
  for (int i = 0; i < 2; ++i) {
    int c = tid & 7, n = (tid >> 3) + 32 * i;
    if (n0 + n < N) {
      float f[8];
#pragma unroll
      for (int e = 0; e < 8; ++e) f[e] = t[(c * 8 + e) * 65 + n];
      if (jb.g_idx >= 0) {
        const float* gp = p.in[jb.g_idx] + jb.g_off + z + k0 + c * 8;
#pragma unroll
        for (int e = 0; e < 8; ++e) f[e] *= gp[e];
      }
      int nrow = n0 + n;
      if (jb.perm) { int c0 = n0 >= FF ? n0 - FF : n0; nrow = (c0 >> 6) * 128 + (n0 >= FF ? 64 : 0) + n; }
      *(v4u*)(dst + (size_t)nrow * K + k0 + c * 8) = pack8(f);
    }
  }
}

DI void pack_k_task(const u16* __restrict__ src, int ld, int col0, int NH, u16* __restrict__ dst, const float* __restrict__ rope, int task) {
  int t = task & (S_ - 1); int rest = task >> 13; int hs = rest % NH; int b = rest / NH;
  const u16* row = src + (size_t)(b * S_ + t) * ld + col0 + hs * 64;
  v4u c[8];
#pragma unroll
  for (int i = 0; i < 8; ++i) c[i] = *(const v4u*)(row + 8 * i);
  float x1[8], x2[8], o1[8], o2[8];
  unpack8(c[0], x1); unpack8(c[1], x2);
  const float* rt = rope + (size_t)t * 16;
#pragma unroll
  for (int i = 0; i < 8; ++i) { float cs = rt[i], sn = rt[8 + i]; o1[i] = x1[i] * cs - x2[i] * sn; o2[i] = x2[i] * cs + x1[i] * sn; }
  c[0] = pack8(o1); c[1] = pack8(o2);
  u16* d = dst + (size_t)(b * NH + hs) * S_ * 64;
#pragma unroll
  for (int i = 0; i < 8; ++i) *(v4u*)(d + kfrag_chunk(t, i)) = c[i];
}
template <int NDVT>
DI void pack_v_task(const u16* __restrict__ src, int ld, int col0, int NH, u16* __restrict__ dst, int task) {
  int ln = task & 63; int s = (task >> 6) & 3; int rest = task >> 8; int dvt = rest % NDVT; rest /= NDVT; int tile = rest & 127; rest >>= 7; int hs = rest % NH; int b = rest / NH;
  int h = ln >> 5, dv = dvt * 32 + (ln & 31);
  const u16* base = src + (size_t)(b * S_ + tile * 64 + 16 * s + 4 * h) * ld + col0 + hs * (32 * NDVT) + dv;
  u16 v[8];
#pragma unroll
  for (int j = 0; j < 8; ++j) { int kk = 8 * (j >> 2) + (j & 3); v[j] = base[(size_t)kk * ld]; }
  v4u o = mk4(v[0] | ((unsigned)v[1] << 16), v[2] | ((unsigned)v[3] << 16), v[4] | ((unsigned)v[5] << 16), v[6] | ((unsigned)v[7] << 16));
  u16* d = dst + (size_t)(b * NH + hs) * S_ * (32 * NDVT);
  *(v4u*)(d + ((size_t)(((tile * NDVT + dvt) * 4 + s) * 64 + ln)) * 8) = o;
}

DI bf16x8 rope_q(const u16* __restrict__ qrow, const float* __restrict__ rt, int h) {
  v4u a = *(const v4u*)qrow, b = *(const v4u*)(qrow + 8);
  float x1[8], x2[8], o[8];
  unpack8(a, x1); unpack8(b, x2);
#pragma unroll
  for (int i = 0; i < 8; ++i) { float cs = rt[i], sn = rt[8 + i]; o[i] = h == 0 ? (x1[i] * cs - x2[i] * sn) : (x2[i] * cs + x1[i] * sn); }
  v4u r = pack8(o);
  return __builtin_bit_cast(bf16x8, r);
}

template <int NDVT, int MODE>
DI void attn_stream(const u16* __restrict__ Kf, const u16* __restrict__ Vf, int tb, int te, const unsigned* umask,
                    const bf16x8 (&q)[4], f32x16 (&O)[NDVT], float& m, float& l, int t, int tmin, int tmax, const unsigned* selw, char* lds) {
  constexpr int NCH = 2 + NDVT;
  constexpr int TILE_B = NCH * 4096;
  const int tid = get_tid(), lane = tid & 63, h = lane >> 5;
  v4u pre[NCH];
#define ATT_VALID(i_) (MODE != 2 || ((umask[(i_) >> 5] >> ((i_) & 31)) & 1u))
#define ATT_GLOAD(i_)                                                                                   \
  {                                                                                                     \
    const u16* kp = Kf + (size_t)(i_) * 4096;                                                           \
    const u16* vp = Vf + (size_t)(i_) * (2048 * NDVT);                                                  \
    _Pragma("unroll") for (int c = 0; c < 2; ++c) pre[c] = *(const v4u*)(kp + (c * 256 + tid) * 8);   \
    _Pragma("unroll") for (int c = 0; c < NDVT; ++c) pre[2 + c] = *(const v4u*)(vp + (c * 256 + tid) * 8); \
  }
  int i = tb;
  while (i < te && !ATT_VALID(i)) ++i;
  __syncthreads();
  if (i < te) ATT_GLOAD(i)
  int buf = 0;
  while (i < te) {
    char* tl = lds + buf * TILE_B;
#pragma unroll
    for (int c = 0; c < NCH; ++c) *(v4u*)(tl + (c * 256 + tid) * 16) = pre[c];
    __syncthreads();
    int nx = i + 1;
    while (nx < te && !ATT_VALID(nx)) ++nx;
    if (nx < te) ATT_GLOAD(nx)
    bool tok_ok = true;
    if (MODE == 2) tok_ok = (selw[i >> 5] >> (i & 31)) & 1u;
    if (MODE != 2 || __any(tok_ok)) {
    f32x16 S0, S1;
#pragma unroll
    for (int e = 0; e < 16; ++e) { S0[e] = 0.f; S1[e] = 0.f; }
    bf16x8 kf[8];
#pragma unroll
    for (int j = 0; j < 8; ++j) kf[j] = *(const bf16x8*)(tl + (j * 64 + lane) * 16);
    __builtin_amdgcn_sched_barrier(0);
#pragma unroll
    for (int s = 0; s < 4; ++s) { S0 = MFMA(kf[s], q[s], S0); S1 = MFMA(kf[4 + s], q[s], S1); }
    __builtin_amdgcn_sched_barrier(0);
    bf16x8 vf[8];
#pragma unroll
    for (int j = 0; j < 8; ++j) vf[j] = *(const bf16x8*)(tl + 8192 + (j * 64 + lane) * 16);
    __builtin_amdgcn_sched_barrier(0);
    bool full = (i * 64 + 63 <= tmin);
    if (MODE == 1) full = full && (i * 64 > tmax - 512);
    if (!full) {
      const int kb = i * 64 + 4 * h;
#pragma unroll
      for (int e = 0; e < 16; ++e) {
        int k0 = kb + 8 * (e >> 2) + (e & 3), k1 = k0 + 32;
        bool v0 = (k0 <= t), v1 = (k1 <= t);
        if (MODE == 1) { v0 = v0 && (k0 > t - 512); v1 = v1 && (k1 > t - 512); }
        S0[e] = v0 ? S0[e] : -INFINITY; S1[e] = v1 ? S1[e] : -INFINITY;
      }
    }
    float mx = fmaxf(S0[0], S1[0]);
#pragma unroll
    for (int e = 1; e < 16; ++e) mx = fmaxf(mx, fmaxf(S0[e], S1[e]));
    if (MODE == 2) mx = tok_ok ? mx : -INFINITY;
    mx = fmaxf(mx, __shfl_xor(mx, 32));
    float mnew = fmaxf(m, mx);
    if (__any(mnew > m)) {
      float f = __builtin_amdgcn_exp2f((m - mnew) * SC);
      l *= f;
#pragma unroll
      for (int d = 0; d < NDVT; ++d)
#pragma unroll
        for (int e = 0; e < 16; ++e) O[d][e] *= f;
    }
    m = mnew;
    const float nb = (MODE == 2 && !tok_ok) ? -INFINITY : -(m * SC);
    float ls = 0.f;
#pragma unroll
    for (int e = 0; e < 16; ++e) {
      S0[e] = __builtin_amdgcn_exp2f(fmaf(S0[e], SC, nb));
      S1[e] = __builtin_amdgcn_exp2f(fmaf(S1[e], SC, nb));
      ls += S0[e] + S1[e];
    }
    l += ls;
    bf16x8 pf[4];
    pf[0] = pack_frag(S0, 0); pf[1] = pack_frag(S0, 1); pf[2] = pack_frag(S1, 0); pf[3] = pack_frag(S1, 1);
    if constexpr (NDVT == 4) {
      bf16x8 vg[8];
#pragma unroll
      for (int j = 0; j < 8; ++j) vg[j] = *(const bf16x8*)(tl + 8192 + ((8 + j) * 64 + lane) * 16);
      __builtin_amdgcn_sched_barrier(0);
#pragma unroll
      for (int d = 0; d < 2; ++d)
#pragma unroll
        for (int s = 0; s < 4; ++s) O[d] = MFMA(vf[d * 4 + s], pf[s], O[d]);
#pragma unroll
      for (int d = 0; d < 2; ++d)
#pragma unroll
        for (int s = 0; s < 4; ++s) O[2 + d] = MFMA(vg[d * 4 + s], pf[s], O[2 + d]);
    } else {
#pragma unroll
      for (int d = 0; d < 2; ++d)
#pragma unroll
        for (int s = 0; s < 4; ++s) O[d] = MFMA(vf[d * 4 + s], pf[s], O[d]);
    }
    __builtin_amdgcn_sched_barrier(0);
    }
    i = nx; buf ^= 1;
  }
}

constexpr int LDS_IMP = 32768, LDS_SELW = 49152, LDS_UMASK = 49152 + 512;
DI void nsa_attn_item(const Params& p, int item, char* smem) {
  const int tid = get_tid(), lane = tid & 63, w = tid >> 6, n = lane & 31, h = lane >> 5;
  const int bh = item & 7, qt = 255 - (item >> 3), b = bh >> 2, hk = bh & 3, t0 = qt * 32, cur = t0 >> 6;
  const int tokl = w * 8 + (n >> 2), g = n & 3, t = t0 + tokl, head = hk * 4 + g;
  const int twmin = t0 + __builtin_amdgcn_readfirstlane(w) * 8;
  const size_t R = (size_t)b * S_ + t;
  const u16* proj = (const u16*)(p.ws + OFF_PROJ);
  const float* rope = (const float*)(p.ws + OFF_ROPE);
  const u16* qrow = proj + R * LDP + head * 64;
  bf16x8 q[4], qr0;
#pragma unroll
  for (int s = 0; s < 4; ++s) q[s] = *(const bf16x8*)(qrow + 16 * s + 8 * h);
  qr0 = rope_q(qrow, rope + (size_t)t * 16, h);
  float gate[3];
#pragma unroll
  for (int j = 0; j < 3; ++j) { float x = bf1(proj[R * LDP + 2560 + head * 3 + j]); gate[j] = 1.f / (1.f + __expf(-x)); }
  float* imp = (float*)(smem + LDS_IMP) + w * 1024;
  unsigned* selw_all = (unsigned*)(smem + LDS_SELW);
  unsigned* umask = (unsigned*)(smem + LDS_UMASK);
  __syncthreads();
#pragma unroll
  for (int i = 0; i < 16; ++i) imp[i * 64 + lane] = 0.f;
  if (tid < 4) umask[tid] = 0u;
  __syncthreads();

  f32x16 Ot[2], Ob[2];
  {
    const int ncmax = (t0 >> 4) + 1;
    const int ntile = (ncmax + 63) >> 6;
    const u16* Kc = (const u16*)(p.ws + OFF_KCF) + (size_t)(b * 4 + hk) * 512 * 64;
    const u16* Vc = (const u16*)(p.ws + OFF_VCF) + (size_t)(b * 4 + hk) * 512 * 64;
    float m = -1e30f, l = 0.f;
    bf16x8 kc[8], kn[8];
#pragma unroll
    for (int j = 0; j < 8; ++j) kc[j] = *(const bf16x8*)(Kc + (j * 64 + lane) * 8);
    for (int i = 0; i < ntile; ++i) {
      const int inx = i + 1 < ntile ? i + 1 : i;
#pragma unroll
      for (int j = 0; j < 8; ++j) kn[j] = *(const bf16x8*)(Kc + (size_t)inx * 4096 + (j * 64 + lane) * 8);
      f32x16 S0, S1;
#pragma unroll
      for (int e = 0; e < 16; ++e) { S0[e] = 0.f; S1[e] = 0.f; }
#pragma unroll
      for (int s = 0; s < 4; ++s) { S0 = MFMA(kc[s], q[s], S0); S1 = MFMA(kc[4 + s], q[s], S1); }
#pragma unroll
      for (int j = 0; j < 8; ++j) kc[j] = kn[j];
      const int cb = i * 64 + 4 * h;
      float mx = -INFINITY;
#pragma unroll
      for (int e = 0; e < 16; ++e) {
        int c0 = cb + 8 * (e >> 2) + (e & 3), c1 = c0 + 32;
        S0[e] = (16 * c0 + 31 <= t) ? S0[e] : -INFINITY; S1[e] = (16 * c1 + 31 <= t) ? S1[e] : -INFINITY;
        mx = fmaxf(mx, fmaxf(S0[e], S1[e]));
      }
      mx = fmaxf(mx, __shfl_xor(mx, 32));
      float mnew = fmaxf(m, mx);
      l *= __builtin_amdgcn_exp2f((m - mnew) * SC);
      m = mnew;
      const float msc = m * SC;
      float ls = 0.f;
#pragma unroll
      for (int e = 0; e < 16; ++e) ls += __builtin_amdgcn_exp2f(fmaf(S0[e], SC, -msc)) + __builtin_amdgcn_exp2f(fmaf(S1[e], SC, -msc));
      l += ls;
    }
    l += __shfl_xor(l, 32);
    const float invl = l > 0.f ? 1.f / l : 0.f;
    const float msc = m * SC;
#pragma unroll
    for (int d = 0; d < 2; ++d)
#pragma unroll
      for (int e = 0; e < 16; ++e) Ob[d][e] = 0.f;
    float* impt = imp + (n >> 2) * 128;
#pragma unroll
    for (int j = 0; j < 8; ++j) kc[j] = *(const bf16x8*)(Kc + (j * 64 + lane) * 8);
    for (int i = 0; i < ntile; ++i) {
      const int inx = i + 1 < ntile ? i + 1 : i;
      bf16x8 vc[8];
#pragma unroll
      for (int j = 0; j < 8; ++j) vc[j] = *(const bf16x8*)(Vc + (size_t)i * 4096 + (j * 64 + lane) * 8);
#pragma unroll
      for (int j = 0; j < 8; ++j) kn[j] = *(const bf16x8*)(Kc + (size_t)inx * 4096 + (j * 64 + lane) * 8);
      f32x16 S0, S1;
#pragma unroll
      for (int e = 0; e < 16; ++e) { S0[e] = 0.f; S1[e] = 0.f; }
#pragma unroll
      for (int s = 0; s < 4; ++s) { S0 = MFMA(kc[s], q[s], S0); S1 = MFMA(kc[4 + s], q[s], S1); }
#pragma unroll
      for (int j = 0; j < 8; ++j) kc[j] = kn[j];
      const int cb = i * 64 + 4 * h;
#pragma unroll
      for (int e = 0; e < 16; ++e) {
        int c0 = cb + 8 * (e >> 2) + (e & 3), c1 = c0 + 32;
        S0[e] = (16 * c0 + 31 <= t) ? __builtin_amdgcn_exp2f(fmaf(S0[e], SC, -msc)) * invl : 0.f;
        S1[e] = (16 * c1 + 31 <= t) ? __builtin_amdgcn_exp2f(fmaf(S1[e], SC, -msc)) * invl : 0.f;
      }
#pragma unroll
      for (int rt = 0; rt < 2; ++rt)
#pragma unroll
        for (int r = 0; r < 4; ++r) {
          float a0 = rt == 0 ? S0[4 * r] : S1[4 * r], a1 = rt == 0 ? S0[4 * r + 1] : S1[4 * r + 1];
          float a2 = rt == 0 ? S0[4 * r + 2] : S1[4 * r + 2], a3 = rt == 0 ? S0[4 * r + 3] : S1[4 * r + 3];
          float A = (a0 + a1) + (a2 + a3), L = a3;
          A += __shfl_xor(A, 1); L += __shfl_xor(L, 1);
          A += __shfl_xor(A, 2); L += __shfl_xor(L, 2);
          int nb = i * 16 + rt * 8 + 2 * r + h;
          if (g == 0) { atomicAdd(&impt[nb], A); if (nb + 1 < 128) atomicAdd(&impt[nb + 1], L); }
        }
      bf16x8 pf[4];
      pf[0] = pack_frag(S0, 0); pf[1] = pack_frag(S0, 1); pf[2] = pack_frag(S1, 0); pf[3] = pack_frag(S1, 1);
#pragma unroll
      for (int d = 0; d < 2; ++d)
#pragma unroll
        for (int s = 0; s < 4; ++s) Ob[d] = MFMA(vc[d * 4 + s], pf[s], Ob[d]);
    }
#pragma unroll
    for (int d = 0; d < 2; ++d)
#pragma unroll
      for (int e = 0; e < 16; ++e) Ot[d][e] = gate[0] * Ob[d][e];
  }
  {
    const int hi = cur - 2;
    for (int tk = 0; tk < 8; ++tk) {
      const float* ip = imp + tk * 128;
      const int n0 = lane, n1 = lane + 64;
      bool s0, s1;
      if (hi > 13) {
        const unsigned k0 = (n0 >= 1 && n0 <= hi) ? (__float_as_uint(ip[n0]) + 1u) : 0u;
        const unsigned k1 = (n1 <= hi) ? (__float_as_uint(ip[n1]) + 1u) : 0u;
        unsigned prefix = 0u;
        for (int bit = 31; bit >= 0; --bit) {
          const unsigned trial = prefix | (1u << bit);
          const int cnt = __popcll(__ballot(k0 >= trial)) + __popcll(__ballot(k1 >= trial));
          if (cnt >= 13) prefix = trial;
        }
        const unsigned long long g0 = __ballot(k0 > prefix), g1 = __ballot(k1 > prefix);
        const unsigned long long e0 = __ballot(k0 == prefix), e1 = __ballot(k1 == prefix);
        const int extra = 13 - (__popcll(g0) + __popcll(g1));
        const unsigned long long below = (1ull << lane) - 1ull;
        const int r0 = __popcll(e0 & below), r1 = __popcll(e0) + __popcll(e1 & below);
        const bool t0 = (k0 > prefix) || (k0 == prefix && r0 < extra);
        const bool t1 = (k1 > prefix) || (k1 == prefix && r1 < extra);
        s0 = (n0 == 0) || (n0 <= cur && n0 >= cur - 1) || t0;
        s1 = (n1 <= cur && n1 >= cur - 1) || t1;
      } else { s0 = n0 <= cur; s1 = n1 <= cur; }
      unsigned long long b0 = __ballot(s0), b1 = __ballot(s1);
      if (lane == 0) {
        unsigned* sw = selw_all + (w * 8 + tk) * 4;
        sw[0] = (unsigned)b0; sw[1] = (unsigned)(b0 >> 32); sw[2] = (unsigned)b1; sw[3] = (unsigned)(b1 >> 32);
        atomicOr(&umask[0], (unsigned)b0); atomicOr(&umask[1], (unsigned)(b0 >> 32));
        atomicOr(&umask[2], (unsigned)b1); atomicOr(&umask[3], (unsigned)(b1 >> 32));
      }
    }
  }
  __syncthreads();
  bf16x8 qr[4] = {qr0, q[1], q[2], q[3]};
  {
    float m = -1e30f, l = 0.f;
#pragma unroll
    for (int d = 0; d < 2; ++d)
#pragma unroll
      for (int e = 0; e < 16; ++e) Ob[d][e] = 0.f;
    const u16* Kf = (const u16*)(p.ws + OFF_KSF) + (size_t)(b * 4 + hk) * S_ * 64;
    const u16* Vf = (const u16*)(p.ws + OFF_VSF) + (size_t)(b * 4 + hk) * S_ * 64;
    attn_stream<2, 2>(Kf, Vf, 0, cur + 1, umask, qr, Ob, m, l, t, twmin, twmin + 7, selw_all + tokl * 4, smem);
    l += __shfl_xor(l, 32);
    const float f = gate[1] / l;
#pragma unroll
    for (int d = 0; d < 2; ++d)
#pragma unroll
      for (int e = 0; e < 16; ++e) Ot[d][e] += f * Ob[d][e];
  }
  {
    float m = -1e30f, l = 0.f;
#pragma unroll
    for (int d = 0; d < 2; ++d)
#pragma unroll
      for (int e = 0; e < 16; ++e) Ob[d][e] = 0.f;
    const u16* Kf = (const u16*)(p.ws + OFF_KWF) + (size_t)(b * 4 + hk) * S_ * 64;
    const u16* Vf = (const u16*)(p.ws + OFF_VWF) + (size_t)(b * 4 + hk) * S_ * 64;
    int lo = t0 - 511; lo = lo < 0 ? 0 : lo;
    attn_stream<2, 1>(Kf, Vf, lo >> 6, ((t0 + 31) >> 6) + 1, nullptr, qr, Ob, m, l, t, twmin, twmin + 7, nullptr, smem);
    l += __shfl_xor(l, 32);
    const float f = gate[2] / l;
#pragma unroll
    for (int d = 0; d < 2; ++d)
#pragma unroll
      for (int e = 0; e < 16; ++e) Ot[d][e] += f * Ob[d][e];
  }
  u16* ao = (u16*)(p.ws + OFF_H) + R * D_ + head * 64;
#pragma unroll
  for (int d = 0; d < 2; ++d)
#pragma unroll
    for (int r = 0; r < 4; ++r)
      *(v2u*)(ao + d * 32 + 8 * r + 4 * h) = mk2(pk2(Ot[d][4 * r], Ot[d][4 * r + 1]), pk2(Ot[d][4 * r + 2], Ot[d][4 * r + 3]));
}

DI size_t kfrag16_chunk(int key, int c  ) { return ((size_t)((((key >> 6) * 8 + ((key >> 4) & 3) * 2 + (c >> 2)) * 64) + (c & 3) * 16 + (key & 15))) * 8; }
DI void pack_k16_task(const u16* __restrict__ src, int ld, int col0, int NH, u16* __restrict__ dst, const float* __restrict__ rope, int task) {
  int t = task & (S_ - 1); int rest = task >> 13; int hs = rest % NH; int b = rest / NH;
  const u16* row = src + (size_t)(b * S_ + t) * ld + col0 + hs * 64;
  v4u c[8];
#pragma unroll
  for (int i = 0; i < 8; ++i) c[i] = *(const v4u*)(row + 8 * i);
  float x1[8], x2[8], o1[8], o2[8];
  unpack8(c[0], x1); unpack8(c[1], x2);
  const float* rt = rope + (size_t)t * 16;
#pragma unroll
  for (int i = 0; i < 8; ++i) { float cs = rt[i], sn = rt[8 + i]; o1[i] = x1[i] * cs - x2[i] * sn; o2[i] = x2[i] * cs + x1[i] * sn; }
  c[0] = pack8(o1); c[1] = pack8(o2);
  u16* d = dst + (size_t)(b * NH + hs) * S_ * 64;
#pragma unroll
  for (int i = 0; i < 8; ++i) *(v4u*)(d + kfrag16_chunk(t, i)) = c[i];
}
DI void pack_v16_task(const u16* __restrict__ src, int ld, int col0, int NH, u16* __restrict__ dst, int task) {
  int ln = task & 63; int s = (task >> 6) & 1; int dvt = (task >> 7) & 7; int rest = task >> 10; int tile = rest & 127; rest >>= 7; int hs = rest % NH; int b = rest / NH;
  const int lq = ln >> 4, dv = dvt * 16 + (ln & 15);
  const u16* base = src + (size_t)(b * S_ + tile * 64 + 32 * s + 4 * lq) * ld + col0 + hs * 128 + dv;
  u16 v[8];
#pragma unroll
  for (int j = 0; j < 8; ++j) { int kk = 16 * (j >> 2) + (j & 3); v[j] = base[(size_t)kk * ld]; }
  v4u o = mk4(v[0] | ((unsigned)v[1] << 16), v[2] | ((unsigned)v[3] << 16), v[4] | ((unsigned)v[5] << 16), v[6] | ((unsigned)v[7] << 16));
  u16* d = dst + (size_t)(b * NH + hs) * S_ * 128;
  *(v4u*)(d + ((size_t)(((tile * 8 + dvt) * 2 + s) * 64 + ln)) * 8) = o;
}
DI bf16x8 pack2x4(const f32x4& a, const f32x4& b) {
  v4u r = mk4(pk2(a[0], a[1]), pk2(a[2], a[3]), pk2(b[0], b[1]), pk2(b[2], b[3]));
  return __builtin_bit_cast(bf16x8, r);
}
DI void diff_attn_item(const Params& p, int item, char* smem) {
  const int tid = get_tid(), lane = tid & 63, l15 = lane & 15, lq = lane >> 4;
  const int wv = __builtin_amdgcn_readfirstlane(tid >> 6);
  const int bhc = item & 31, qt = 63 - (item >> 5), b = bhc >> 4, hc = bhc & 15, t0 = qt * 128;
  const int twmin = t0 + wv * 32;
  const float* rope = (const float*)(p.ws + OFF_ROPE);
  int tq[2]; bf16x8 qf[2][2];
#pragma unroll
  for (int ct = 0; ct < 2; ++ct) {
    tq[ct] = twmin + ct * 16 + l15;
    const u16* qrow = (const u16*)(p.ws + OFF_Q) + ((size_t)b * S_ + tq[ct]) * D_ + hc * 64;
    qf[ct][1] = *(const bf16x8*)(qrow + 32 + lq * 8);
    bf16x8 raw = *(const bf16x8*)(qrow + lq * 8);
    bf16x8 rp = rope_q(qrow, rope + (size_t)tq[ct] * 16, lq & 1);
    qf[ct][0] = lq < 2 ? rp : raw;
  }
  f32x4 O[8][2];
#pragma unroll
  for (int d = 0; d < 8; ++d)
#pragma unroll
    for (int ct = 0; ct < 2; ++ct)
#pragma unroll
      for (int e = 0; e < 4; ++e) O[d][ct][e] = 0.f;
  float m[2] = {-1e30f, -1e30f}, l[2] = {0.f, 0.f};
  const u16* Kf = (const u16*)(p.ws + OFF_SKVK) + (size_t)(b * 16 + hc) * S_ * 64;
  const u16* Vf = (const u16*)(p.ws + OFF_SKVV) + (size_t)(b * 8 + (hc >> 1)) * S_ * 128;
  const int te = 2 * qt + 2;
  constexpr int TILE_B = 24576;
  v4u pre[6];
#define D16_GLOAD(i_)                                                                                  \
  { const u16* kp = Kf + (size_t)(i_) * 4096; const u16* vp = Vf + (size_t)(i_) * 8192;                 \
    _Pragma("unroll") for (int c = 0; c < 2; ++c) pre[c] = *(const v4u*)(kp + (c * 256 + tid) * 8);    \
    _Pragma("unroll") for (int c = 0; c < 4; ++c) pre[2 + c] = *(const v4u*)(vp + (c * 256 + tid) * 8); }
  __syncthreads();
  D16_GLOAD(0)
  int buf = 0;
  for (int i = 0; i < te; ++i) {
    char* tl = smem + buf * TILE_B;
#pragma unroll
    for (int c = 0; c < 6; ++c) *(v4u*)(tl + (c * 256 + tid) * 16) = pre[c];
    __syncthreads();
    if (i + 1 < te) D16_GLOAD(i + 1)
    f32x4 S[4][2];
#pragma unroll
    for (int rt = 0; rt < 4; ++rt)
#pragma unroll
      for (int ct = 0; ct < 2; ++ct)
#pragma unroll
        for (int e = 0; e < 4; ++e) S[rt][ct][e] = 0.f;
    bf16x8 kf[8];
#pragma unroll
    for (int f = 0; f < 8; ++f) kf[f] = *(const bf16x8*)(tl + (f * 64 + lane) * 16);
    __builtin_amdgcn_sched_barrier(0);
#pragma unroll
    for (int rt = 0; rt < 4; ++rt)
#pragma unroll
      for (int ks = 0; ks < 2; ++ks)
#pragma unroll
        for (int ct = 0; ct < 2; ++ct) S[rt][ct] = MFMA16(kf[rt * 2 + ks], qf[ct][ks], S[rt][ct]);
    __builtin_amdgcn_sched_barrier(0);
    bf16x8 vf[8];
#pragma unroll
    for (int f = 0; f < 8; ++f) vf[f] = *(const bf16x8*)(tl + 8192 + (f * 64 + lane) * 16);
    __builtin_amdgcn_sched_barrier(0);
    if (!(i * 64 + 63 <= twmin)) {
#pragma unroll
      for (int rt = 0; rt < 4; ++rt)
#pragma unroll
        for (int ct = 0; ct < 2; ++ct)
#pragma unroll
          for (int e = 0; e < 4; ++e) { const int key = i * 64 + rt * 16 + 4 * lq + e; S[rt][ct][e] = key <= tq[ct] ? S[rt][ct][e] : -INFINITY; }
    }
    float mn[2]; bool grow = false;
#pragma unroll
    for (int ct = 0; ct < 2; ++ct) {
      float mx = fmaxf(fmaxf(S[0][ct][0], S[0][ct][1]), fmaxf(S[0][ct][2], S[0][ct][3]));
#pragma unroll
      for (int rt = 1; rt < 4; ++rt) mx = fmaxf(mx, fmaxf(fmaxf(S[rt][ct][0], S[rt][ct][1]), fmaxf(S[rt][ct][2], S[rt][ct][3])));
      mx = fmaxf(mx, __shfl_xor(mx, 16));
      mx = fmaxf(mx, __shfl_xor(mx, 32));
      mn[ct] = fmaxf(m[ct], mx);
      grow = grow || (mn[ct] > m[ct]);
    }
    if (__any(grow)) {
#pragma unroll
      for (int ct = 0; ct < 2; ++ct) {
        const float f = __builtin_amdgcn_exp2f((m[ct] - mn[ct]) * SC);
        l[ct] *= f;
#pragma unroll
        for (int d = 0; d < 8; ++d)
#pragma unroll
          for (int e = 0; e < 4; ++e) O[d][ct][e] *= f;
      }
    }
    bf16x8 pf[2][2];
#pragma unroll
    for (int ct = 0; ct < 2; ++ct) {
      m[ct] = mn[ct];
      const float nb = -(m[ct] * SC);
      float ls = 0.f;
#pragma unroll
      for (int rt = 0; rt < 4; ++rt)
#pragma unroll
        for (int e = 0; e < 4; ++e) { S[rt][ct][e] = __builtin_amdgcn_exp2f(fmaf(S[rt][ct][e], SC, nb)); ls += S[rt][ct][e]; }
      l[ct] += ls;
      pf[0][ct] = pack2x4(S[0][ct], S[1][ct]);
      pf[1][ct] = pack2x4(S[2][ct], S[3][ct]);
    }
    bf16x8 vg[8];
#pragma unroll
    for (int f = 0; f < 8; ++f) vg[f] = *(const bf16x8*)(tl + 8192 + ((8 + f) * 64 + lane) * 16);
    __builtin_amdgcn_sched_barrier(0);
#pragma unroll
    for (int d = 0; d < 4; ++d)
#pragma unroll
      for (int s = 0; s < 2; ++s)
#pragma unroll
        for (int ct = 0; ct < 2; ++ct) O[d][ct] = MFMA16(vf[d * 2 + s], pf[s][ct], O[d][ct]);
#pragma unroll
    for (int d = 0; d < 4; ++d)
#pragma unroll
      for (int s = 0; s < 2; ++s)
#pragma unroll
        for (int ct = 0; ct < 2; ++ct) O[4 + d][ct] = MFMA16(vg[d * 2 + s], pf[s][ct], O[4 + d][ct]);
    __builtin_amdgcn_sched_barrier(0);
    buf ^= 1;
  }
#pragma unroll
  for (int ct = 0; ct < 2; ++ct) {
    float lt = l[ct];
    lt += __shfl_xor(lt, 16);
    lt += __shfl_xor(lt, 32);
    const float f = 1.f / lt;
    u16* op = (u16*)(p.ws + OFF_KVRAW) + (((size_t)b * S_ + tq[ct]) * 16 + hc) * 128;
#pragma unroll
    for (int d = 0; d < 8; ++d)
      *(v2u*)(op + d * 16 + 4 * lq) = mk2(pk2(O[d][ct][0] * f, O[d][ct][1] * f), pk2(O[d][ct][2] * f, O[d][ct][3] * f));
  }
}

DI void conv_task(const u16* __restrict__ u, u16* __restrict__ act, const float* __restrict__ cw, const float* __restrict__ cbias, int task) {
  const int ck = task % 344, rr = task / 344;
  const int j0 = ck * 8, ts = rr * 16;
  float wg[3][8], wv[3][8], bg[8], bv[8], g1[8], g2[8], v1[8], v2[8];
#pragma unroll
  for (int e = 0; e < 8; ++e) {
#pragma unroll
    for (int tp = 0; tp < 3; ++tp) { wg[tp][e] = cw[tp * FF2 + j0 + e]; wv[tp][e] = cw[tp * FF2 + FF + j0 + e]; }
    bg[e] = cbias[j0 + e]; bv[e] = cbias[FF + j0 + e];
    g1[e] = g2[e] = v1[e] = v2[e] = 0.f;
  }
  if (ts > 0) {
    unpack8(*(const v4u*)(u + (size_t)(ts - 1) * FF2 + j0), g1); unpack8(*(const v4u*)(u + (size_t)(ts - 1) * FF2 + FF + j0), v1);
    unpack8(*(const v4u*)(u + (size_t)(ts - 2) * FF2 + j0), g2); unpack8(*(const v4u*)(u + (size_t)(ts - 2) * FF2 + FF + j0), v2);
  }
#pragma unroll 4
  for (int r = 0; r < 16; ++r) {
    const int t = ts + r;
    float gc[8], vc[8], o[8];
    unpack8(*(const v4u*)(u + (size_t)t * FF2 + j0), gc); unpack8(*(const v4u*)(u + (size_t)t * FF2 + FF + j0), vc);
#pragma unroll
    for (int e = 0; e < 8; ++e) {
      float cgv = bg[e] + wg[0][e] * g2[e] + wg[1][e] * g1[e] + wg[2][e] * gc[e];
      float cvv = bv[e] + wv[0][e] * v2[e] + wv[1][e] * v1[e] + wv[2][e] * vc[e];
      o[e] = cgv / (1.f + __expf(-cgv)) * cvv;
      g2[e] = g1[e]; g1[e] = gc[e]; v2[e] = v1[e]; v1[e] = vc[e];
    }
    *(v4u*)(act + (size_t)t * FF + j0) = pack8(o);
  }
}

DI void diff_comb_row(const Params& p, int j, int layer, int row, int lane) {
  const float* lv = p.in[12] + j * 256;
  float sa = wave_sum(lv[lane] * lv[64 + lane]), sb = wave_sum(lv[128 + lane] * lv[192 + lane]);
  const float lam_init = 0.8f - 0.6f * expf(-0.3f * (float)layer);
  const float lam = expf(sa) - expf(sb) + lam_init;
  const int head = lane >> 3, part = lane & 7;
  const u16* o0 = (const u16*)(p.ws + OFF_KVRAW) + ((size_t)row * 16 + head * 2) * 128 + part * 16;
  const u16* o1 = o0 + 128;
  float a[16], bb[16];
  unpack8(*(const v4u*)o0, a); unpack8(*(const v4u*)(o0 + 8), a + 8);
  unpack8(*(const v4u*)o1, bb); unpack8(*(const v4u*)(o1 + 8), bb + 8);
  float ss = 0.f;
#pragma unroll
  for (int e = 0; e < 16; ++e) { a[e] = a[e] - lam * bb[e]; ss += a[e] * a[e]; }
  ss += __shfl_xor(ss, 1); ss += __shfl_xor(ss, 2); ss += __shfl_xor(ss, 4);
  const float r = rsqrtf(ss * (1.f / 128.f) + 1e-6f) * (1.f - lam_init);
  const float* sg = p.in[13] + j * 128 + part * 16;
#pragma unroll
  for (int e = 0; e < 16; ++e) a[e] = a[e] * r * sg[e];
  u16* dst = (u16*)(p.ws + OFF_H) + (size_t)row * D_ + head * 128 + part * 16;
  *(v4u*)dst = pack8(a); *(v4u*)(dst + 8) = pack8(a + 8);
}


#define XB_TMO      128
#define XB_XCNT(j)  (256  + 64 * (j))
#define XB_XSUB(j)  (1280 + 64 * (j))
#define XB_XGEN(j)  (2304 + 64 * (j))
#define XB_TOP      3328
#define XB_TOPGEN   3392
#define XCD_BAR_WORDS 3456
#define XB_SPIN_CAP (1u << 24)
#define LAS __attribute__((address_space(3)))
DI unsigned xb_ld(unsigned* p)              { return __hip_atomic_load(p, __ATOMIC_RELAXED, __HIP_MEMORY_SCOPE_AGENT); }
DI unsigned xb_add(unsigned* p, unsigned v) { return __hip_atomic_fetch_add(p, v, __ATOMIC_RELAXED, __HIP_MEMORY_SCOPE_AGENT); }
DI unsigned xb_xcc_id() { return (unsigned)__builtin_amdgcn_s_getreg((3 << 11) | 20) & 0xFu; }
#define XB_SPIN(cond, bar) do { unsigned _sp = 0; while (cond) { __builtin_amdgcn_s_sleep(1); \
    if ((++_sp & 255u) == 0u) { if (xb_ld(&(bar)[XB_TMO])) break; if (_sp > XB_SPIN_CAP) { atomicAdd(&(bar)[XB_TMO], 1u); break; } } } } while (0)
struct XcdBarrier { unsigned* bar; unsigned x; volatile LAS unsigned* st; };
DI XcdBarrier xcd_barrier_post(unsigned* bar, volatile LAS unsigned* st) {
  XcdBarrier b; b.bar = bar; b.x = xb_xcc_id(); b.st = st;
  if (__builtin_amdgcn_workitem_id_x() == 0) (void)xb_add(&bar[XB_XCNT(b.x)], 1u);
  return b;
}
DI void xcd_barrier_complete(unsigned* bar, unsigned x, unsigned& nloc, unsigned& nx) {
  const unsigned G = gridDim.x * gridDim.y * gridDim.z;
  unsigned sum, cnt, mine, sp = 0u;
  for (;;) {
    sum = 0u; cnt = 0u; mine = 0u;
#pragma unroll
    for (unsigned j = 0; j < 16; ++j) { const unsigned c = xb_ld(&bar[XB_XCNT(j)]); sum += c; cnt += (c > 0u) ? 1u : 0u; mine = (j == x) ? c : mine; }
    if (sum == G) break;
    __builtin_amdgcn_s_sleep(1);
    if ((++sp & 255u) == 0u) { if (xb_ld(&bar[XB_TMO])) break; if (sp > XB_SPIN_CAP) { atomicAdd(&bar[XB_TMO], 1u); break; } }
  }
  nloc = mine > 0u ? mine : 1u; nx = cnt > 0u ? cnt : 1u;
}
DI void xcd_barrier(const XcdBarrier& b) {
  asm volatile("s_waitcnt vmcnt(0)" ::: "memory");
  __syncthreads();
  if (__builtin_amdgcn_workitem_id_x() == 0) {
    unsigned* bar = b.bar;
    __builtin_amdgcn_s_waitcnt(0);
    unsigned nloc = b.st[0], nx = b.st[1];
    if (nloc == 0u) { xcd_barrier_complete(bar, b.x, nloc, nx); b.st[0] = nloc; b.st[1] = nx; }
    const unsigned old = xb_add(&bar[XB_XSUB(b.x)], 1u);
    const unsigned gen = old / nloc;
    if (old + 1u == (gen + 1u) * nloc) {
      __builtin_amdgcn_fence(__ATOMIC_RELEASE, "agent");
      asm volatile("s_waitcnt vmcnt(0)" ::: "memory");
      const unsigned og = xb_add(&bar[XB_TOP], 1u);
      const unsigned tg = og / nx;
      if (og + 1u == (tg + 1u) * nx) xb_add(&bar[XB_TOPGEN], 1u);
      else XB_SPIN(xb_ld(&bar[XB_TOPGEN]) == tg, bar);
      __builtin_amdgcn_fence(__ATOMIC_ACQUIRE, "agent");
      xb_add(&bar[XB_XGEN(b.x)], 1u);
      asm volatile("s_waitcnt vmcnt(0)" ::: "memory");
    } else {
      XB_SPIN(xb_ld(&bar[XB_XGEN(b.x)]) == gen, bar);
      __builtin_amdgcn_fence(__ATOMIC_ACQUIRE, "agent");
      asm volatile("s_waitcnt vmcnt(0)" ::: "memory");
    }
  }
  __syncthreads();
}

DI bool xcd_tile(int bid, int round, int G, int MT, int NT, int& tm, int& tn) {
  const int mx = MT >> 3, q = (bid >> 3) + (G >> 3) * round;
  if (q >= mx * NT) return false;
  tm = (bid & 7) * mx + q % mx; tn = q / mx;
  return true;
}
DI int snake(int r, int G, int j) { return r * G + ((r & 1) ? (G - 1 - j) : j); }

DI void run_step(const Params& pk, const Step st, char* smem) {
  const int G = gridDim.x, bid = get_bid(), tid = get_tid(), lane = tid & 63, wave = tid >> 6;
  const int L = st.layer;
  size_t z = 0;
  asm volatile("" : "+s"(z));
  Params p;
#pragma unroll
  for (int i = 0; i < 20; ++i) p.in[i] = pk.in[i] + z;
  p.out = pk.out + z;
  p.ws = pk.ws + z;
  char* ws = p.ws;
  float* xcur = p.out;
  switch (st.op) {
  case OP_PREP: {
    const int n_rope = 256, n_cb = 32, n_norm = 4096;
    const int total = N_TR_TILES + n_rope + n_cb;
    int tj = 0, tbase = 0;
    for (int w = bid; w < total; w += G) {
      if (w < N_TR_TILES) { transpose_tile(pk, z, w, smem, tj, tbase); continue; }
      int k = w - N_TR_TILES;
      if (k < n_rope) {
        int idx = k * 256 + tid; int t = idx >> 3, i = idx & 7;
        float inv = powf(500000.f, -(float)i / 8.f);
        float ang = (float)t * inv;
        float* rp = (float*)(ws + OFF_ROPE) + (size_t)t * 16;
        rp[i] = cosf(ang); rp[8 + i] = sinf(ang);
        continue;
      }
      k -= n_rope;
      if (k < n_cb) {
        int lkv = k >> 3, j0 = (k & 7) * 32;
        int jj = tid & 31, kg = tid >> 5;
        const float* pe = p.in[5] + lkv * 2048;
        const float* w1 = p.in[6] + (size_t)lkv * 2048 * 256;
        float s = 0.f;
        for (int kk = kg * 256; kk < kg * 256 + 256; ++kk) s += pe[kk] * w1[(size_t)kk * 256 + j0 + jj];
        float* part = (float*)smem;
        __syncthreads();
        part[tid] = s;
        __syncthreads();
        if (tid < 32) { float a = p.in[7][lkv * 256 + j0 + tid]; for (int q = 0; q < 8; ++q) a += part[q * 32 + tid]; ((float*)(ws + OFF_CB))[lkv * 256 + j0 + tid] = a; }
        continue;
      }
    }
    for (int k = bid; k < n_norm; k += 2 * G) {
      const int k2 = k + G, rowa = k * 4 + wave, rowc = (k2 < n_norm ? k2 : k) * 4 + wave;
      float4 va[4], vc[4];
#pragma unroll
      for (int q = 0; q < 4; ++q) { va[q] = ((const float4*)(p.in[0] + (size_t)rowa * D_))[q * 64 + lane]; vc[q] = ((const float4*)(p.in[0] + (size_t)rowc * D_))[q * 64 + lane]; }
      prep_row_fin(va, (u16*)(ws + OFF_XB) + (size_t)rowa * D_, (float*)(ws + OFF_SSQ) + (size_t)rowa * 8, lane);
      if (k2 < n_norm) prep_row_fin(vc, (u16*)(ws + OFF_XB) + (size_t)rowc * D_, (float*)(ws + OFF_SSQ) + (size_t)rowc * 8, lane);
    }
  } break;
  case OP_NORM: {
    const float* g = (st.aux ? p.in[2] : p.in[1]) + L * D_;
    for (int k = bid; k < 4096; k += G) { int row = k * 4 + wave; norm_row_bf16(xcur + (size_t)row * D_, g, (u16*)(ws + OFF_H) + (size_t)row * D_, lane); }
  } break;
  case OP_FINAL: {
    const u16* xbp = (const u16*)(ws + OFF_XB);
    for (int k = bid; k < 4096; k += 2 * G) {
      const int k2 = k + G;
      const size_t ra_ = (size_t)(k * 4 + wave) * D_, rc_ = (size_t)((k2 < 4096 ? k2 : k) * 4 + wave) * D_;
      v4u ua[2], uc[2];
#pragma unroll
      for (int q = 0; q < 2; ++q) { ua[q] = ((const v4u*)(xbp + ra_))[q * 64 + lane]; uc[q] = ((const v4u*)(xbp + rc_))[q * 64 + lane]; }
      float fa[16], fc[16];
      unpack8(ua[0], fa); unpack8(ua[1], fa + 8); unpack8(uc[0], fc); unpack8(uc[1], fc + 8);
      float sa = 0.f, sc = 0.f;
#pragma unroll
      for (int e2 = 0; e2 < 16; ++e2) { sa += fa[e2] * fa[e2]; sc += fc[e2] * fc[e2]; }
      sa = wave_sum(sa); sc = wave_sum(sc);
      const float ra = rsqrtf(sa * (1.f / 1024.f) + 1e-6f), rc = rsqrtf(sc * (1.f / 1024.f) + 1e-6f);
#pragma unroll
      for (int q = 0; q < 2; ++q) {
        const int c2 = (q * 64 + lane) * 2;
        const float4 g0 = ((const float4*)p.in[19])[c2], g1 = ((const float4*)p.in[19])[c2 + 1];
        ((float4*)(xcur + ra_))[c2] = make_float4(fa[q * 8] * ra * g0.x, fa[q * 8 + 1] * ra * g0.y, fa[q * 8 + 2] * ra * g0.z, fa[q * 8 + 3] * ra * g0.w);
        ((float4*)(xcur + ra_))[c2 + 1] = make_float4(fa[q * 8 + 4] * ra * g1.x, fa[q * 8 + 5] * ra * g1.y, fa[q * 8 + 6] * ra * g1.z, fa[q * 8 + 7] * ra * g1.w);
        if (k2 < 4096) {
          ((float4*)(xcur + rc_))[c2] = make_float4(fc[q * 8] * rc * g0.x, fc[q * 8 + 1] * rc * g0.y, fc[q * 8 + 2] * rc * g0.z, fc[q * 8 + 3] * rc * g0.w);
          ((float4*)(xcur + rc_))[c2 + 1] = make_float4(fc[q * 8 + 4] * rc * g1.x, fc[q * 8 + 5] * rc * g1.y, fc[q * 8 + 6] * rc * g1.z, fc[q * 8 + 7] * rc * g1.w);
        }
      }
    }
  } break;
  case OP_NSA_IN: {
    ARow af{(const u16*)(ws + OFF_XB), D_};
    EpiStoreT ep{(u16*)(ws + OFF_PROJ), LDP, (const float*)(ws + OFF_SSQ)};
    const u16* Bt = (const u16*)(ws + OFF_WNI) + (size_t)L * LDP * 1024;
    for (int r = 0, tm, tn; xcd_tile(bid, r, G, 128, 11, tm, tn); ++r) gemm_tile(af, Bt, LDP, 1024, tm * 128, tn * 256, ep, smem);
  } break;
  case OP_NSA_PACK: {
    const u16* proj = (const u16*)(ws + OFF_PROJ);
    const float* rope = (const float*)(ws + OFF_ROPE);
    const int n_g = 64, n_k = 2 * 256, n_v = 2 * 2048;
    for (int w = bid; w < n_g + n_k + n_v; w += G) {
      if (w < n_g) {
        int kv = w >> 5, lt = w & 31;
        ACmp af{proj, 1024 + kv * 256};
        EpiGelu ep{(const float*)(ws + OFF_CB) + (L * 2 + kv) * 256, (u16*)(ws + OFF_HID) + (size_t)kv * 4096 * 256};
        gemm_tile(af, (const u16*)(ws + OFF_WP1) + (size_t)(L * 2 + kv) * 256 * 2048, 256, 2048, lt * 128, 0, ep, smem);
        continue;
      }
      int k = w - n_g;
      if (k < n_k) {
        int str = k >> 8, task = (k & 255) * 256 + tid;
        pack_k_task(proj, LDP, 1024 + (str ? 1024 : 512), 4, (u16*)(ws + (str ? OFF_KWF : OFF_KSF)), rope, task);
        continue;
      }
      k -= n_k;
      { int str = k >> 11, task = (k & 2047) * 256 + tid;
        pack_v_task<2>(proj, LDP, 1024 + (str ? 1280 : 768), 4, (u16*)(ws + (str ? OFF_VWF : OFF_VSF)), task); }
    }
  } break;
  case OP_NSA_CMP2: {
    for (int w = bid; w < 64; w += G) {
      int kv = w >> 5, lt = w & 31;
      ARow af{(const u16*)(ws + OFF_HID) + (size_t)kv * 4096 * 256, 256};
      EpiCmpOut ep{(u16*)(ws + OFF_KCF), (u16*)(ws + OFF_VCF), kv};
      gemm_tile(af, (const u16*)(ws + OFF_WP2) + (size_t)(L * 2 + kv) * 64 * 256, 64, 256, lt * 128, 0, ep, smem);
    }
  } break;
  case OP_NSA_ATTN: {
    for (int r = 0;; ++r) { int it = snake(r, G, bid); if (r * G >= 2048) break; if (it < 2048) nsa_attn_item(p, it, smem); }
  } break;
  case OP_OUTPROJ: {
    ARow af{(const u16*)(ws + OFF_H), D_};
    const u16* Bt = L < 2 ? (const u16*)(ws + OFF_WNO) + (size_t)L * 1024 * 1024 : (const u16*)(ws + OFF_WDO) + (size_t)(L - 2) * 1024 * 1024;
    {
      EpiResidT<false> ep{nullptr, nullptr, (u16*)(ws + OFF_XB), (float*)(ws + OFF_SSQ)};
      for (int r = 0, tm, tn; xcd_tile(bid, r, G, 128, 4, tm, tn); ++r) gemm_tile(af, Bt, 1024, 1024, tm * 128, tn * 256, ep, smem);
    }
  } break;
  case OP_FFN1: {
    ARow af{(const u16*)(ws + OFF_XB), D_};
    EpiConvGlu ep{(u16*)(ws + OFF_ACT), (u16*)(ws + OFF_HALO), p.in[16] + (size_t)L * 3 * FF2, p.in[17] + (size_t)L * FF2, (const float*)(ws + OFF_SSQ)};
    const u16* Bt = (const u16*)(ws + OFF_WFI) + (size_t)L * FF2 * 1024;
    for (int r = 0, tm, tn; xcd_tile(bid, r, G, 128, 22, tm, tn); ++r) gemm_tile(af, Bt, FF2, 1024, tm * 128, tn * 256, ep, smem);
  } break;
  case OP_FIX: {
    for (int k = bid; k < 344; k += G)
      ffn_fix_task((const u16*)(ws + OFF_HALO), (u16*)(ws + OFF_ACT), p.in[16] + (size_t)L * 3 * FF2, p.in[17] + (size_t)L * FF2, k * 256 + tid);
  } break;
  case OP_FFN2: {
    ARow af{(const u16*)(ws + OFF_ACT), FF};
    EpiResidT<false> ep{nullptr, nullptr, (u16*)(ws + OFF_XB), (float*)(ws + OFF_SSQ)};
    const u16* Bt = (const u16*)(ws + OFF_WFO) + (size_t)L * 1024 * FF;
    for (int r = 0, tm, tn; xcd_tile(bid, r, G, 128, 4, tm, tn); ++r) {
      for (int q = tid; q < 688; q += 256)
        ffn_fix_task((const u16*)(ws + OFF_HALO), (u16*)(ws + OFF_ACT), p.in[16] + (size_t)L * 3 * FF2, p.in[17] + (size_t)L * FF2, (tm * 2 + q / 344) * 344 + q % 344);
      gemm_tile(af, Bt, 1024, FF, tm * 128, tn * 256, ep, smem);
    }
  } break;
  case OP_KVQ_GEMM: {
    for (int r = 0, tm, tn; xcd_tile(bid, r, G, 128, 12, tm, tn); ++r) {
      if (tn < 8) {
        ARow af{(const u16*)(ws + OFF_XB), D_}; EpiStoreT ep{(u16*)(ws + OFF_KVRAW), 2048, (const float*)(ws + OFF_SSQ)};
        gemm_tile(af, (const u16*)(ws + OFF_WKV), 2048, 1024, tm * 128, tn * 256, ep, smem);
      } else {
        ARow af{(const u16*)(ws + OFF_XB), D_}; EpiStoreT ep{(u16*)(ws + OFF_Q), D_, (const float*)(ws + OFF_SSQ)};
        gemm_tile(af, (const u16*)(ws + OFF_WDQ), 1024, 1024, tm * 128, (tn - 8) * 256, ep, smem);
      }
    }
  } break;
  case OP_DQ_GEMM: {
    ARow af{(const u16*)(ws + OFF_XB), D_}; EpiStoreT ep{(u16*)(ws + OFF_Q), D_, (const float*)(ws + OFF_SSQ)};
    for (int r = 0, tm, tn; xcd_tile(bid, r, G, 128, 4, tm, tn); ++r) gemm_tile(af, (const u16*)(ws + OFF_WDQ) + 1024 * 1024, 1024, 1024, tm * 128, tn * 256, ep, smem);
  } break;
  case OP_KV_PACK: {
    const u16* kvr = (const u16*)(ws + OFF_KVRAW);
    const float* rope = (const float*)(ws + OFF_ROPE);
    const int n_k = 1024, n_v = 8192;
    for (int w = bid; w < n_k + n_v; w += G) {
      if (w < n_k) pack_k16_task(kvr, 2048, 0, 16, (u16*)(ws + OFF_SKVK), rope, w * 256 + tid);
      else pack_v16_task(kvr, 2048, 1024, 8, (u16*)(ws + OFF_SKVV), (w - n_k) * 256 + tid);
    }
  } break;
  case OP_DIFF_ATTN: {
    for (int r = 0;; ++r) { int it = snake(r, G, bid); if (r * G >= 2048) break; if (it < 2048) diff_attn_item(p, it, smem); }
  } break;
  case OP_DIFF_COMB: {
    for (int k = bid; k < 4096; k += G) diff_comb_row(p, L - 2, L, k * 4 + wave, lane);
  } break;
  }
}

__global__ void __launch_bounds__(256, 2) mega(Params p, int s_lo, int s_hi) {
  __shared__ __attribute__((aligned(16))) char smem[73728];
  __shared__ uint4 xb_words;
  cg::grid_group grid = cg::this_grid();
  const bool multi = (s_hi - s_lo) > 1;
  XcdBarrier xb;
  if (multi) {
    if (__builtin_amdgcn_workitem_id_x() == 0) xb_words = make_uint4(0u, 0u, 0u, 0u);
    __syncthreads();
    xb = xcd_barrier_post((unsigned*)(p.ws + OFF_BAR), (volatile LAS unsigned*)&xb_words);
  }
  for (int s = s_lo; s < s_hi; ++s) {
    Step st = g_prog[s];
    run_step(p, st, smem);
    if (s + 1 < s_hi) { if (s_hi > 4096) grid.sync();   xcd_barrier(xb); }
  }
}

extern "C" void kernel_launch(void* const* d_in, const int* in_sizes, int n_in, void* d_out, int out_size, void* d_ws, size_t ws_size,
                              hipStream_t stream) {
  (void)in_sizes; (void)n_in; (void)out_size;
  static int grid_blocks = 0;
  if (!grid_blocks) {
    int dev = 0, cus = 0, per_cu = 0;
    hipGetDevice(&dev);
    hipDeviceGetAttribute(&cus, hipDeviceAttributeMultiprocessorCount, dev);
    hipOccupancyMaxActiveBlocksPerMultiprocessor(&per_cu, mega, 256, 0);
    if (per_cu < 1) per_cu = 1;
    if (per_cu > 2) per_cu = 2;
    grid_blocks = cus * per_cu;
  }
  if (ws_size < WS_NEEDED) { fprintf(stderr, "workspace too small: %zu < %zu\n", ws_size, (size_t)WS_NEEDED); return; }
  Params p{};
  for (int i = 0; i < 20; ++i) p.in[i] = (const float*)d_in[i];
  p.out = (float*)d_out;
  p.ws = (char*)d_ws;
#if ONE_LAUNCH
  hipMemsetAsync((char*)d_ws + OFF_BAR, 0, XCD_BAR_WORDS * 4, stream);
  int lo = 0, hi = N_STEPS;
  void* args[] = {&p, &lo, &hi};
  hipError_t e = hipLaunchCooperativeKernel((void*)mega, dim3(grid_blocks), dim3(256), args, 0, stream);
  if (e != hipSuccess) fprintf(stderr, "cooperative launch failed: %s (grid %d)\n", hipGetErrorString(e), grid_blocks);
#else
  for (int s = 0; s < N_STEPS; ++s) mega<<<grid_blocks, 256, 0, stream>>>(p, s, s + 1);
#endif
}
```

```cpp
#include <hip/hip_runtime.h>
#include <hip/hip_cooperative_groups.h>
#include <math.h>
#include <stdint.h>
#include <stdio.h>
namespace cg = cooperative_groups;

#ifndef ONE_LAUNCH
#define ONE_LAUNCH 1
#endif

typedef unsigned short u16;
typedef __attribute__((ext_vector_type(8))) short bf16x8;
typedef __attribute__((ext_vector_type(16))) float f32x16;
typedef __bf16 bf2_t __attribute__((ext_vector_type(2)));
typedef float f2_t __attribute__((ext_vector_type(2)));
typedef unsigned v4u __attribute__((ext_vector_type(4)));
typedef unsigned v2u __attribute__((ext_vector_type(2)));
#define DI __device__ __forceinline__

#define MFMA(a, b, c) __builtin_amdgcn_mfma_f32_32x32x16_bf16((a), (b), (c), 0, 0, 0)
typedef __attribute__((ext_vector_type(4))) float f32x4;
#define MFMA16(a, b, c) __builtin_amdgcn_mfma_f32_16x16x32_bf16((a), (b), (c), 0, 0, 0)

constexpr int T_ = 16384, S_ = 8192, D_ = 1024;
constexpr int LDP = 2608;
constexpr int FF = 2752, FF2 = 5504;
constexpr float SC = 0.125f * 1.4426950408889634f;

constexpr size_t OFF_WNI = 0;
constexpr size_t OFF_WNO = OFF_WNI + 2ull * 2608 * 1024 * 2;
constexpr size_t OFF_WP1 = OFF_WNO + 2ull * 1024 * 1024 * 2;
constexpr size_t OFF_WP2 = OFF_WP1 + 4ull * 256 * 2048 * 2;
constexpr size_t OFF_WKV = OFF_WP2 + 4ull * 64 * 256 * 2;
constexpr size_t OFF_WDQ = OFF_WKV + 2048ull * 1024 * 2;
constexpr size_t OFF_WDO = OFF_WDQ + 2ull * 1024 * 1024 * 2;
constexpr size_t OFF_WFI = OFF_WDO + 2ull * 1024 * 1024 * 2;
constexpr size_t OFF_WFO = OFF_WFI + 4ull * 5504 * 1024 * 2;
constexpr size_t OFF_ROPE = OFF_WFO + 4ull * 1024 * 2752 * 2;
constexpr size_t OFF_CB = OFF_ROPE + 8192ull * 16 * 4;
constexpr size_t OFF_BAR = OFF_CB + 4096;
constexpr size_t OFF_H = OFF_BAR + 16384;
constexpr size_t OFF_SKVK = OFF_H + (size_t)T_ * 1024 * 2;
constexpr size_t OFF_SKVV = OFF_SKVK + (size_t)T_ * 1024 * 2;
constexpr size_t OFF_XB = OFF_SKVV + (size_t)T_ * 1024 * 2;
constexpr size_t OFF_SSQ = OFF_XB + (size_t)T_ * 1024 * 2;
constexpr size_t OFF_BIG = OFF_SSQ + (size_t)T_ * 8 * 4;
constexpr size_t OFF_PROJ = OFF_BIG;
constexpr size_t OFF_KSF = OFF_PROJ + (size_t)T_ * LDP * 2;
constexpr size_t OFF_KWF = OFF_KSF + (size_t)T_ * 256 * 2;
constexpr size_t OFF_VSF = OFF_KWF + (size_t)T_ * 256 * 2;
constexpr size_t OFF_VWF = OFF_VSF + (size_t)T_ * 256 * 2;
constexpr size_t OFF_HID = OFF_VWF + (size_t)T_ * 256 * 2;
constexpr size_t OFF_KCF = OFF_HID + 2ull * 4096 * 256 * 2;
constexpr size_t OFF_VCF = OFF_KCF + 2ull * 4 * 512 * 64 * 2;
constexpr size_t OFF_ACT = OFF_BIG;
constexpr size_t OFF_HALO = OFF_ACT + (size_t)T_ * 2752 * 2;
constexpr size_t OFF_Q = OFF_BIG;
constexpr size_t OFF_KVRAW = OFF_Q + (size_t)T_ * 1024 * 2;
constexpr size_t WS_NEEDED = OFF_VCF + 2ull * 4 * 512 * 64 * 2;

struct Params {
  const float* in[20];
  float* out;
  char* ws;
};

enum { OP_PREP = 0, OP_NORM, OP_NSA_IN, OP_NSA_PACK, OP_NSA_CMP2, OP_NSA_ATTN, OP_OUTPROJ, OP_FFN1, OP_CONV, OP_FFN2,
       OP_FIX, OP_KVQ_NORM, OP_KVQ_GEMM, OP_KV_PACK, OP_DIFF_ATTN, OP_DIFF_COMB, OP_DQ_GEMM, OP_FINAL };
struct Step { int op, layer, aux; };
#define FFN_STEPS(l) {OP_FFN1, l, 0}, {OP_FFN2, l, 0}
#define NSA_STEPS(l) {OP_NSA_IN, l, 0}, {OP_NSA_PACK, l, 0}, {OP_NSA_CMP2, l, 0}, {OP_NSA_ATTN, l, 0}, {OP_OUTPROJ, l, 0}
__constant__ Step g_prog[] = {
  {OP_PREP, 0, 0},
  NSA_STEPS(0), FFN_STEPS(0),
  NSA_STEPS(1), FFN_STEPS(1),
  {OP_KVQ_GEMM, 2, 0}, {OP_KV_PACK, 2, 0}, {OP_DIFF_ATTN, 2, 0}, {OP_DIFF_COMB, 2, 0}, {OP_OUTPROJ, 2, 0}, FFN_STEPS(2),
  {OP_DQ_GEMM, 3, 0}, {OP_DIFF_ATTN, 3, 0}, {OP_DIFF_COMB, 3, 0}, {OP_OUTPROJ, 3, 0}, FFN_STEPS(3),
  {OP_FINAL, 0, 0},
};
constexpr int N_STEPS = 1 + 7 + 7 + 7 + 6 + 1;

DI int get_tid() { int t = (int)__builtin_amdgcn_workitem_id_x(); asm volatile("" : "+v"(t)); return t; }
DI int get_bid() { int b = (int)__builtin_amdgcn_workgroup_id_x(); asm volatile("" : "+s"(b)); return b; }
DI v4u mk4(unsigned a, unsigned b, unsigned c, unsigned d) { v4u r = {a, b, c, d}; return r; }
DI v2u mk2(unsigned a, unsigned b) { v2u r = {a, b}; return r; }
DI unsigned pk2(float a, float b) { f2_t v = {a, b}; bf2_t r = __builtin_convertvector(v, bf2_t); return __builtin_bit_cast(unsigned, r); }
DI float bflo(unsigned u) { return __uint_as_float(u << 16); }
DI float bfhi(unsigned u) { return __uint_as_float(u & 0xffff0000u); }
DI float bf1(u16 v) { return __uint_as_float((unsigned)v << 16); }
DI u16 f2bf(float x) { return (u16)(pk2(x, 0.f) & 0xffffu); }
DI float wave_sum(float v) {
#pragma unroll
  for (int o = 32; o >= 1; o >>= 1) v += __shfl_xor(v, o);
  return v;
}
DI void unpack8(v4u a, float* f) {
  f[0] = bflo(a.x); f[1] = bfhi(a.x); f[2] = bflo(a.y); f[3] = bfhi(a.y);
  f[4] = bflo(a.z); f[5] = bfhi(a.z); f[6] = bflo(a.w); f[7] = bfhi(a.w);
}
DI v4u pack8(const float* f) { return mk4(pk2(f[0], f[1]), pk2(f[2], f[3]), pk2(f[4], f[5]), pk2(f[6], f[7])); }
DI bf16x8 pack_frag(const f32x16& x, int s) {
  v4u r = mk4(pk2(x[8 * s + 0], x[8 * s + 1]), pk2(x[8 * s + 2], x[8 * s + 3]), pk2(x[8 * s + 4], x[8 * s + 5]), pk2(x[8 * s + 6], x[8 * s + 7]));
  return __builtin_bit_cast(bf16x8, r);
}
DI size_t kfrag_chunk(int key, int c  ) { return ((size_t)(((key >> 5) * 4 + (c >> 1)) * 64 + (c & 1) * 32 + (key & 31))) * 8; }
template <int NDVT> DI size_t vfrag_index(int key, int dv) {
  int tile = key >> 6, s = (key >> 4) & 3, kk = key & 15, h = (kk >> 2) & 1, j = ((kk >> 3) << 2) | (kk & 3);
  return ((size_t)((((tile * NDVT + (dv >> 5)) * 4 + s) * 64) + h * 32 + (dv & 31))) * 8 + j;
}

struct ARow { const u16* base; int ld; DI const u16* operator()(int row, int k) const { return base + (size_t)row * ld + k; } };
struct ACmp {
  const u16* proj; int colbase;
  DI const u16* operator()(int r, int k) const {
    int hk = r & 3, i = (r >> 2) & 511, b = r >> 11; i = i > 510 ? 510 : i;
    return proj + (size_t)(b * S_ + 16 * i + (k >> 6)) * LDP + colbase + hk * 64 + (k & 63);
  }
};
struct EpiStore { static constexpr bool kTileEpi = false; u16* C; int ld; int N;
  DI void operator()(int m, int n, float a, float b, float c, float d) const { if (n < N) *(v2u*)(C + (size_t)m * ld + n) = mk2(pk2(a, b), pk2(c, d)); } };
struct EpiResid { static constexpr bool kTileEpi = false; const float* xin; float* xout;
  DI void operator()(int m, int n, float a, float b, float c, float d) const {
    float4 x = *(const float4*)(xin + (size_t)m * D_ + n); x.x += a; x.y += b; x.z += c; x.w += d; *(float4*)(xout + (size_t)m * D_ + n) = x; } };
DI float gelu_t(float x) { return 0.5f * x * (1.f + tanhf(0.7978845608028654f * (x + 0.044715f * x * x * x))); }
struct EpiGelu { static constexpr bool kTileEpi = false; const float* bias; u16* C;
  DI void operator()(int m, int n, float a, float b, float c, float d) const {
    float4 bb = *(const float4*)(bias + n);
    *(v2u*)(C + (size_t)m * 256 + n) = mk2(pk2(gelu_t(a + bb.x), gelu_t(b + bb.y)), pk2(gelu_t(c + bb.z), gelu_t(d + bb.w))); } };
struct EpiCmpOut { static constexpr bool kTileEpi = false; u16* kcf; u16* vcf; int kv;
  DI void operator()(int m, int n, float a, float b, float c, float d) const {
    if (n >= 64) return;
    int hk = m & 3, i = (m >> 2) & 511, bb = m >> 11;
    if (i == 511) { a = b = c = d = 0.f; }
    size_t sb = (size_t)(bb * 4 + hk) * 512 * 64;
    if (kv == 0) { *(v2u*)(kcf + sb + kfrag_chunk(i, n >> 3) + (n & 7)) = mk2(pk2(a, b), pk2(c, d)); }
    else { vcf[sb + vfrag_index<2>(i, n)] = f2bf(a); vcf[sb + vfrag_index<2>(i, n + 1)] = f2bf(b); vcf[sb + vfrag_index<2>(i, n + 2)] = f2bf(c); vcf[sb + vfrag_index<2>(i, n + 3)] = f2bf(d); }
  } };


DI float rrow(const float* __restrict__ ssq, int m) {
  const float4 a = *(const float4*)(ssq + (size_t)m * 8), b = *(const float4*)(ssq + (size_t)m * 8 + 4);
  return rsqrtf(((a.x + a.y) + (a.z + a.w) + (b.x + b.y) + (b.z + b.w)) * (1.f / 1024.f) + 1e-6f);
}
constexpr int CT_ROW = 264;
struct EpiStoreT { static constexpr bool kTileEpi = true; static constexpr bool kRs = true;
  u16* C; int ld; const float* ssq;
  DI void tile(f32x4 (&acc)[8][4], const float (&rs)[4], int m0, int n0, int N, char* smem) const {
    u16* Ct = (u16*)smem;
    const int tid = get_tid(), lane = tid & 63, wave = tid >> 6, wm = wave & 1, wn = wave >> 1, l15 = lane & 15, lq = lane >> 4;
    __syncthreads();
#pragma unroll
    for (int ni = 0; ni < 8; ++ni)
#pragma unroll
      for (int mi = 0; mi < 4; ++mi) {
        const int m = wm * 64 + mi * 16 + l15, n = wn * 128 + ni * 16 + 4 * lq;
        const float s = rs[mi];
        *(v2u*)(Ct + m * CT_ROW + n) = mk2(pk2(acc[ni][mi][0] * s, acc[ni][mi][1] * s), pk2(acc[ni][mi][2] * s, acc[ni][mi][3] * s));
      }
    __syncthreads();
    const int ch = tid & 31, r0 = tid >> 5;
    if (n0 + ch * 8 < N) {
#pragma unroll
      for (int k = 0; k < 16; ++k) {
        const int m = r0 + 8 * k;
        *(v4u*)(C + (size_t)(m0 + m) * ld + n0 + ch * 8) = *(const v4u*)(Ct + m * CT_ROW + ch * 8);
      }
    }
  } };
constexpr int RT_ROW = 132;
template <bool F32IN>
struct EpiResidT { static constexpr bool kTileEpi = true; static constexpr bool kRs = false;
  const float* xin; float* xout; u16* xb; float* ssq;
  DI void tile(f32x4 (&acc)[8][4], const float (&rs)[4], int m0, int n0, int N, char* smem) const {
    float* Rt = (float*)smem;
    const int tid = get_tid(), lane = tid & 63, wave = tid >> 6, wm = wave & 1, wn = wave >> 1, l15 = lane & 15, lq = lane >> 4;
    const int ch = tid & 31, r0 = tid >> 5;
    if constexpr (!F32IN) {
      for (int pass = 0; pass < 2; ++pass) {
        v2u ur[16];
        const unsigned voff = (unsigned)(r0 * D_ + ch * 4);
        u16* const pbase = xb + (size_t)m0 * D_ + n0 + pass * 128;
#pragma unroll
        for (int k = 0; k < 16; ++k) ur[k] = *(const v2u*)(pbase + (size_t)(8 * k) * D_ + voff);
        __syncthreads();
        if (wn == pass) {
#pragma unroll
          for (int ni = 0; ni < 8; ++ni)
#pragma unroll
            for (int mi = 0; mi < 4; ++mi) {
              const int m = wm * 64 + mi * 16 + l15, n = ni * 16 + 4 * lq;
              *(float4*)(Rt + m * RT_ROW + n) = make_float4(acc[ni][mi][0], acc[ni][mi][1], acc[ni][mi][2], acc[ni][mi][3]);
            }
        }
        __syncthreads();
#pragma unroll
        for (int k = 0; k < 16; ++k) {
          if ((k & 3) == 0) __builtin_amdgcn_sched_barrier(0);
          const int m = r0 + 8 * k;
          float4 x = make_float4(bflo(ur[k].x), bfhi(ur[k].x), bflo(ur[k].y), bfhi(ur[k].y));
          const float4 a = *(const float4*)(Rt + m * RT_ROW + ch * 4);
          x.x += a.x; x.y += a.y; x.z += a.z; x.w += a.w;
          *(v2u*)(pbase + (size_t)(8 * k) * D_ + voff) = mk2(pk2(x.x, x.y), pk2(x.z, x.w));
          float ss = x.x * x.x + x.y * x.y + x.z * x.z + x.w * x.w;
#pragma unroll
          for (int o = 16; o >= 1; o >>= 1) ss += __shfl_xor(ss, o);
          if (ch == 0) ssq[(size_t)(m0 + m) * 8 + ((n0 >> 7) + pass)] = ss;
        }
      }
      return;
    }
    for (int pass = 0; pass < 2; ++pass) {
      float4 xr[8];
#pragma unroll
      for (int k = 0; k < 8; ++k) {
        const size_t o_ = (size_t)(m0 + r0 + 8 * k) * D_ + n0 + pass * 128 + ch * 4;
        if constexpr (F32IN) xr[k] = *(const float4*)(xin + o_);
        else { const v2u u_ = *(const v2u*)(xb + o_); xr[k] = make_float4(bflo(u_.x), bfhi(u_.x), bflo(u_.y), bfhi(u_.y)); }
      }
      __syncthreads();
      if (wn == pass) {
#pragma unroll
        for (int ni = 0; ni < 8; ++ni)
#pragma unroll
          for (int mi = 0; mi < 4; ++mi) {
            const int m = wm * 64 + mi * 16 + l15, n = ni * 16 + 4 * lq;
            *(float4*)(Rt + m * RT_ROW + n) = make_float4(acc[ni][mi][0], acc[ni][mi][1], acc[ni][mi][2], acc[ni][mi][3]);
          }
      }
      __syncthreads();
#pragma unroll 1
      for (int kh = 0; kh < 2; ++kh) {
        if (kh == 1) {
#pragma unroll
          for (int k = 0; k < 8; ++k) {
            const size_t o_ = (size_t)(m0 + r0 + 8 * (8 + k)) * D_ + n0 + pass * 128 + ch * 4;
            if constexpr (F32IN) xr[k] = *(const float4*)(xin + o_);
            else { const v2u u_ = *(const v2u*)(xb + o_); xr[k] = make_float4(bflo(u_.x), bfhi(u_.x), bflo(u_.y), bfhi(u_.y)); }
          }
        }
#pragma unroll
        for (int k = 0; k < 8; ++k) {
          const int m = r0 + 8 * (kh * 8 + k);
          const size_t off = (size_t)(m0 + m) * D_ + n0 + pass * 128 + ch * 4;
          float4 x = xr[k];
          const float4 a = *(const float4*)(Rt + m * RT_ROW + ch * 4);
          x.x += a.x; x.y += a.y; x.z += a.z; x.w += a.w;
          *(v2u*)(xb + off) = mk2(pk2(x.x, x.y), pk2(x.z, x.w));
          float ss = x.x * x.x + x.y * x.y + x.z * x.z + x.w * x.w;
#pragma unroll
          for (int o = 16; o >= 1; o >>= 1) ss += __shfl_xor(ss, o);
          if (ch == 0) ssq[(size_t)(m0 + m) * 8 + ((n0 >> 7) + pass)] = ss;
        }
      }
    }
  } };
constexpr int UT_ROW = 136;
DI float silu_mul(float g, float v) { return g * __builtin_amdgcn_rcpf(1.f + __expf(-g)) * v; }
struct EpiConvGlu { static constexpr bool kTileEpi = true; static constexpr bool kRs = true;
  u16* act; u16* halo; const float* cw; const float* cb; const float* ssq;
  DI void tile(f32x4 (&acc)[8][4], const float (&rs)[4], int m0, int n0, int N, char* smem) const {
    u16* Ut = (u16*)smem;
    const int tid = get_tid(), lane = tid & 63, wave = tid >> 6, wm = wave & 1, wn = wave >> 1, l15 = lane & 15, lq = lane >> 4;
    for (int pass = 0; pass < 2; ++pass) {
    if (n0 + pass * 128 >= N) break;
    const int tm = m0 >> 7, tn = (n0 >> 7) + pass;
    const int c = tid & 7, j0 = tn * 64 + c * 8;
    float wg[3][8], wv[3][8], bg[8], bv[8];
#pragma unroll
    for (int hq = 0; hq < 2; ++hq) {
#pragma unroll
      for (int tp = 0; tp < 3; ++tp) {
        float4 a = *(const float4*)(cw + tp * FF2 + j0 + 4 * hq), b = *(const float4*)(cw + tp * FF2 + FF + j0 + 4 * hq);
        wg[tp][4 * hq] = a.x; wg[tp][4 * hq + 1] = a.y; wg[tp][4 * hq + 2] = a.z; wg[tp][4 * hq + 3] = a.w;
        wv[tp][4 * hq] = b.x; wv[tp][4 * hq + 1] = b.y; wv[tp][4 * hq + 2] = b.z; wv[tp][4 * hq + 3] = b.w;
      }
      float4 a = *(const float4*)(cb + j0 + 4 * hq), b = *(const float4*)(cb + FF + j0 + 4 * hq);
      bg[4 * hq] = a.x; bg[4 * hq + 1] = a.y; bg[4 * hq + 2] = a.z; bg[4 * hq + 3] = a.w;
      bv[4 * hq] = b.x; bv[4 * hq + 1] = b.y; bv[4 * hq + 2] = b.z; bv[4 * hq + 3] = b.w;
    }
    __syncthreads();
    if (wn == pass) {
#pragma unroll
    for (int ni = 0; ni < 8; ++ni)
#pragma unroll
      for (int mi = 0; mi < 4; ++mi) {
        const int m = wm * 64 + mi * 16 + l15, n = ni * 16 + 4 * lq;
        const float s = rs[mi];
        *(v2u*)(Ut + m * UT_ROW + n) = mk2(pk2(acc[ni][mi][0] * s, acc[ni][mi][1] * s), pk2(acc[ni][mi][2] * s, acc[ni][mi][3] * s));
      }
    }
    __syncthreads();
    if (tid < 64) {
      int rr = tid >> 4, c2 = tid & 15, row = rr < 2 ? rr : 124 + rr, n = c2 * 8, half = n >> 6, j = tn * 64 + (n & 63);
      *(v4u*)(halo + ((size_t)((tm * 4 + rr) * 2 + half)) * FF + j) = *(const v4u*)(Ut + row * UT_ROW + n);
    }
#pragma unroll
    for (int k = 0; k < 4; ++k) {
      const int m = (tid >> 3) + 32 * k;
      if (m >= 2) {
        float g0[8], g1[8], g2[8], v0[8], v1[8], v2[8], o[8];
        unpack8(*(const v4u*)(Ut + m * UT_ROW + c * 8), g0); unpack8(*(const v4u*)(Ut + m * UT_ROW + 64 + c * 8), v0);
        unpack8(*(const v4u*)(Ut + (m - 1) * UT_ROW + c * 8), g1); unpack8(*(const v4u*)(Ut + (m - 1) * UT_ROW + 64 + c * 8), v1);
        unpack8(*(const v4u*)(Ut + (m - 2) * UT_ROW + c * 8), g2); unpack8(*(const v4u*)(Ut + (m - 2) * UT_ROW + 64 + c * 8), v2);
#pragma unroll
        for (int e = 0; e < 8; ++e)
          o[e] = silu_mul(bg[e] + wg[0][e] * g2[e] + wg[1][e] * g1[e] + wg[2][e] * g0[e], bv[e] + wv[0][e] * v2[e] + wv[1][e] * v1[e] + wv[2][e] * v0[e]);
        *(v4u*)(act + (size_t)(m0 + m) * FF + j0) = pack8(o);
      }
    }
    }
  } };
DI void ld_halo(const u16* __restrict__ halo, int tm, int rr, int half, int j0, float* f) { unpack8(*(const v4u*)(halo + ((size_t)((tm * 4 + rr) * 2 + half)) * FF + j0), f); }
DI void ffn_fix_task(const u16* __restrict__ halo, u16* __restrict__ act, const float* __restrict__ cw, const float* __restrict__ cb, int task) {
  const int ck = task % 344, rest = task / 344, r = rest & 1, tm = rest >> 1, j0 = ck * 8;
  const bool first = (tm & 63) == 0;
  float g0[8], g1[8], g2[8], v0[8], v1[8], v2[8], o[8];
#pragma unroll
  for (int e = 0; e < 8; ++e) { g1[e] = g2[e] = v1[e] = v2[e] = 0.f; }
  ld_halo(halo, tm, r, 0, j0, g0); ld_halo(halo, tm, r, 1, j0, v0);
  if (r == 1) { ld_halo(halo, tm, 0, 0, j0, g1); ld_halo(halo, tm, 0, 1, j0, v1); if (!first) { ld_halo(halo, tm - 1, 3, 0, j0, g2); ld_halo(halo, tm - 1, 3, 1, j0, v2); } }
  else if (!first) { ld_halo(halo, tm - 1, 3, 0, j0, g1); ld_halo(halo, tm - 1, 3, 1, j0, v1); ld_halo(halo, tm - 1, 2, 0, j0, g2); ld_halo(halo, tm - 1, 2, 1, j0, v2); }
#pragma unroll
  for (int e = 0; e < 8; ++e) {
    float cgv = cb[j0 + e] + cw[j0 + e] * g2[e] + cw[FF2 + j0 + e] * g1[e] + cw[2 * FF2 + j0 + e] * g0[e];
    float cvv = cb[FF + j0 + e] + cw[FF + j0 + e] * v2[e] + cw[FF2 + FF + j0 + e] * v1[e] + cw[2 * FF2 + FF + j0 + e] * v0[e];
    o[e] = silu_mul(cgv, cvv);
  }
  *(v4u*)(act + (size_t)(tm * 128 + r) * FF + j0) = pack8(o);
}

constexpr int G_ST = 24576;
#define GLDS1(gp_, ldsaddr_)                                                                                               \
  { unsigned keep_; const void* g_ = (const void*)(gp_); unsigned la_ = __builtin_amdgcn_readfirstlane(ldsaddr_);          \
    asm volatile("s_mov_b32 %0, m0\n\ts_mov_b32 m0, %2\n\ts_nop 0\n\tglobal_load_lds_dwordx4 %1, off\n\ts_mov_b32 m0, %0" : "=&s"(keep_) : "v"(g_), "s"(la_) : "memory"); }
template <class AF, class EP>
DI void gemm_tile(const AF& af, const u16* __restrict__ Bt, int N, int K, int m0, int n0, const EP& ep, char* smem) {
  const int tid = get_tid(), lane = tid & 63;
  const int wv = __builtin_amdgcn_readfirstlane(tid >> 6);
  const int wm = wv & 1, wn = wv >> 1;
  const int l15 = lane & 15, lq = lane >> 4;
  const unsigned lds0 = (unsigned)(size_t)smem;
  const int drow = lane >> 2, dc = ((lane & 3) ^ ((4 - ((lane >> 4) & 3)) & 3)) * 8;
  const u16* pb[4];
#pragma unroll
  for (int j = 0; j < 4; ++j) { int nb = n0 + (4 * wv + j) * 16 + drow; nb = nb < N ? nb : N - 1; pb[j] = Bt + (size_t)nb * K + dc; }
  f32x4 acc[8][4];
#pragma unroll
  for (int a = 0; a < 8; ++a)
#pragma unroll
    for (int b = 0; b < 4; ++b)
#pragma unroll
      for (int i = 0; i < 4; ++i) acc[a][b][i] = 0.f;
#define G_DMA(kt_, st_)                                                                                     \
  { const unsigned sb_ = lds0 + (unsigned)((st_) * G_ST);                                                   \
    _Pragma("unroll") for (int j = 0; j < 2; ++j) GLDS1(af(m0 + (2 * wv + j) * 16 + drow, (kt_) * 32 + dc), sb_ + (2 * wv + j) * 1024) \
    _Pragma("unroll") for (int j = 0; j < 4; ++j) GLDS1(pb[j] + (kt_) * 32, sb_ + 8192 + (4 * wv + j) * 1024) }
  asm volatile("s_waitcnt vmcnt(0)" ::: "memory");
  __syncthreads();
  const int nk = K >> 5;
  float rsv[4] = {1.f, 1.f, 1.f, 1.f};
  float4 rq[EP::kTileEpi ? 8 : 1];
  if constexpr (EP::kTileEpi) { if constexpr (EP::kRs) {
#pragma unroll
    for (int mi = 0; mi < 4; ++mi) { const float* sp = ep.ssq + (size_t)(m0 + wm * 64 + mi * 16 + l15) * 8; rq[2 * mi] = *(const float4*)sp; rq[2 * mi + 1] = *(const float4*)(sp + 4); }
  } }
  G_DMA(0, 0)
  if (nk > 1) G_DMA(1, 1)
  if constexpr (EP::kTileEpi) { if constexpr (EP::kRs) {
#pragma unroll
    for (int mi = 0; mi < 4; ++mi) { const float4 a = rq[2 * mi], b = rq[2 * mi + 1]; rsv[mi] = rsqrtf(((a.x + a.y) + (a.z + a.w) + (b.x + b.y) + (b.z + b.w)) * (1.f / 1024.f) + 1e-6f); }
  } }
  const int co = (lq ^ ((4 - ((l15 >> 2) & 3)) & 3)) * 16;
  int st = 0;
  for (int kt = 0; kt < nk; ++kt) {
    if (kt + 1 < nk) asm volatile("s_waitcnt vmcnt(6)" ::: "memory"); else asm volatile("s_waitcnt vmcnt(0)" ::: "memory");
    asm volatile("s_waitcnt lgkmcnt(0)" ::: "memory");
    __builtin_amdgcn_s_barrier();
    if (kt + 2 < nk) { const int s2 = st >= 1 ? st - 1 : 2; G_DMA(kt + 2, s2) }
    {
      const char* sbase = smem + st * G_ST;
      const char* pB = sbase + (wm * 64 + l15) * 64 + co;
      const char* pA = sbase + 8192 + (wn * 128 + l15) * 64 + co;
      bf16x8 fb[4], fa[8];
#pragma unroll
      for (int mi = 0; mi < 4; ++mi) fb[mi] = *(const bf16x8*)(pB + mi * 16 * 64);
#pragma unroll
      for (int ni = 0; ni < 8; ++ni) fa[ni] = *(const bf16x8*)(pA + ni * 16 * 64);
      __builtin_amdgcn_sched_barrier(0);
#pragma unroll
      for (int ni = 0; ni < 8; ++ni)
#pragma unroll
        for (int mi = 0; mi < 4; ++mi) acc[ni][mi] = MFMA16(fa[ni], fb[mi], acc[ni][mi]);
      __builtin_amdgcn_sched_barrier(0);
    }
    st = st == 2 ? 0 : st + 1;
  }
  if constexpr (EP::kTileEpi) {
    ep.tile(acc, rsv, m0, n0, N, smem);
  } else {
#pragma unroll
  for (int ni = 0; ni < 8; ++ni)
#pragma unroll
    for (int mi = 0; mi < 4; ++mi) {
      const int m = m0 + wm * 64 + mi * 16 + l15, n = n0 + wn * 128 + ni * 16 + 4 * lq;
      ep(m, n, acc[ni][mi][0], acc[ni][mi][1], acc[ni][mi][2], acc[ni][mi][3]);
    }
  }
}

DI void norm_row_bf16(const float* __restrict__ x, const float* __restrict__ g, u16* __restrict__ dst, int lane) {
  float4 v[4]; float ss = 0.f;
#pragma unroll
  for (int k = 0; k < 4; ++k) { v[k] = ((const float4*)x)[k * 64 + lane]; ss += v[k].x * v[k].x + v[k].y * v[k].y + v[k].z * v[k].z + v[k].w * v[k].w; }
  ss = wave_sum(ss);
  float r = rsqrtf(ss * (1.f / 1024.f) + 1e-6f);
#pragma unroll
  for (int k = 0; k < 4; ++k) {
    float4 gg = ((const float4*)g)[k * 64 + lane];
    ((v2u*)dst)[k * 64 + lane] = mk2(pk2(v[k].x * r * gg.x, v[k].y * r * gg.y), pk2(v[k].z * r * gg.z, v[k].w * r * gg.w));
  }
}
DI void norm_row_f32(float* __restrict__ x, const float* __restrict__ g, int lane) {
  float4 v[4]; float ss = 0.f;
#pragma unroll
  for (int k = 0; k < 4; ++k) { v[k] = ((const float4*)x)[k * 64 + lane]; ss += v[k].x * v[k].x + v[k].y * v[k].y + v[k].z * v[k].z + v[k].w * v[k].w; }
  ss = wave_sum(ss);
  float r = rsqrtf(ss * (1.f / 1024.f) + 1e-6f);
#pragma unroll
  for (int k = 0; k < 4; ++k) {
    float4 gg = ((const float4*)g)[k * 64 + lane];
    ((float4*)x)[k * 64 + lane] = make_float4(v[k].x * r * gg.x, v[k].y * r * gg.y, v[k].z * r * gg.z, v[k].w * r * gg.w);
  }
}


DI void prep_row_x(const float* __restrict__ x, u16* __restrict__ xb, float* __restrict__ ssq, int lane) {
#pragma unroll
  for (int k = 0; k < 4; ++k) {
    const float4 v = ((const float4*)x)[k * 64 + lane];
    ((v2u*)xb)[k * 64 + lane] = mk2(pk2(v.x, v.y), pk2(v.z, v.w));
    float ss = v.x * v.x + v.y * v.y + v.z * v.z + v.w * v.w;
#pragma unroll
    for (int o = 16; o >= 1; o >>= 1) ss += __shfl_xor(ss, o);
    if ((lane & 31) == 0) ssq[2 * k + (lane >> 5)] = ss;
  }
}

struct Job { int in_idx; unsigned src_off; unsigned long long dst_off; int K, N, perm, g_idx, g_off; };
__constant__ Job g_jobs[25] = {
  {15, 0u, OFF_WFI, 1024, 5504, 1, 2, 0},
  {15, 1024u * 5504u, OFF_WFI + 1ull * 5504 * 1024 * 2, 1024, 5504, 1, 2, 1024},
  {15, 2u * 1024u * 5504u, OFF_WFI + 2ull * 5504 * 1024 * 2, 1024, 5504, 1, 2, 2048},
  {15, 3u * 1024u * 5504u, OFF_WFI + 3ull * 5504 * 1024 * 2, 1024, 5504, 1, 2, 3072},
  {18, 0u, OFF_WFO, 2752, 1024, 0, -1, 0},
  {18, 2752u * 1024u, OFF_WFO + 1ull * 1024 * 2752 * 2, 2752, 1024, 0, -1, 0},
  {18, 2u * 2752u * 1024u, OFF_WFO + 2ull * 1024 * 2752 * 2, 2752, 1024, 0, -1, 0},
  {18, 3u * 2752u * 1024u, OFF_WFO + 3ull * 1024 * 2752 * 2, 2752, 1024, 0, -1, 0},
  {3, 0u, OFF_WNI, 1024, 2608, 0, 1, 0},
  {3, 1024u * 2608u, OFF_WNI + 2608ull * 1024 * 2, 1024, 2608, 0, 1, 1024},
  {4, 0u, OFF_WNO, 1024, 1024, 0, -1, 0},
  {4, 1024u * 1024u, OFF_WNO + 1024ull * 1024 * 2, 1024, 1024, 0, -1, 0},
  {6, 0u, OFF_WP1, 2048, 256, 0, -1, 0},
  {6, 2048u * 256u, OFF_WP1 + 1ull * 256 * 2048 * 2, 2048, 256, 0, -1, 0},
  {6, 2u * 2048u * 256u, OFF_WP1 + 2ull * 256 * 2048 * 2, 2048, 256, 0, -1, 0},
  {6, 3u * 2048u * 256u, OFF_WP1 + 3ull * 256 * 2048 * 2, 2048, 256, 0, -1, 0},
  {8, 0u, OFF_WP2, 256, 64, 0, -1, 0},
  {8, 256u * 64u, OFF_WP2 + 1ull * 64 * 256 * 2, 256, 64, 0, -1, 0},
  {8, 2u * 256u * 64u, OFF_WP2 + 2ull * 64 * 256 * 2, 256, 64, 0, -1, 0},
  {8, 3u * 256u * 64u, OFF_WP2 + 3ull * 64 * 256 * 2, 256, 64, 0, -1, 0},
  {10, 0u, OFF_WKV, 1024, 2048, 0, 9, 0},
  {11, 0u, OFF_WDQ, 1024, 1024, 0, 1, 2048},
  {11, 1024u * 1024u, OFF_WDQ + 1024ull * 1024 * 2, 1024, 1024, 0, 1, 3072},
  {14, 0u, OFF_WDO, 1024, 1024, 0, -1, 0},
  {14, 1024u * 1024u, OFF_WDO + 1024ull * 1024 * 2, 1024, 1024, 0, -1, 0},
};
constexpr int N_TR_TILES = 2 * 656 + 2 * 256 + 4 * 128 + 4 * 4 + 512 + 2 * 256 + 2 * 256 + 4 * 1376 + 4 * 688;

DI void transpose_tile(const Params& p, size_t z, int tile, char* smem, int& j, int& base) {
  for (;;) { int nt = (g_jobs[j].K >> 6) * ((g_jobs[j].N + 63) >> 6); if (tile < base + nt) break; base += nt; ++j; }
  const Job jb = g_jobs[j];
  const float* src = p.in[jb.in_idx] + jb.src_off + z;
  u16* dst = (u16*)(p.ws + jb.dst_off + z);
  const int K = jb.K, N = jb.N;
  const int lt = tile - base, ntn = (N + 63) >> 6;
  const int k0 = (lt / ntn) * 64, n0 = (lt % ntn) * 64;
  float* t = (float*)smem;
  const int tid = get_tid();
  __syncthreads();
  {
    const int n4 = (tid & 15) * 4, kq = tid >> 4;
    const bool ok = (n0 + n4) < N;
    float4 v[4];
#pragma unroll
    for (int i = 0; i < 4; ++i) v[i] = ok ? *(const float4*)(src + (size_t)(k0 + kq + 16 * i) * N + n0 + n4) : make_float4(0.f, 0.f, 0.f, 0.f);
#pragma unroll
    for (int i = 0; i < 4; ++i) { float* tp = t + (kq + 16 * i) * 65 + n4; tp[0] = v[i].x; tp[1] = v[i].y; tp[2] = v[i].z; tp[3] = v[i].w; }
  }
  __syncthreads();
#pragma unroll
  for (int i = 0; i < 2; ++i) {
    int c = tid & 7, n = (tid >> 3) + 32 * i;
    if (n0 + n < N) {
      float f[8];
#pragma unroll
      for (int e = 0; e < 8; ++e) f[e] = t[(c * 8 + e) * 65 + n];
      if (jb.g_idx >= 0) {
        const float* gp = p.in[jb.g_idx] + jb.g_off + z + k0 + c * 8;
#pragma unroll
        for (int e = 0; e < 8; ++e) f[e] *= gp[e];
      }
      int nrow = n0 + n;
      if (jb.perm) { int c0 = n0 >= FF ? n0 - FF : n0; nrow = (c0 >> 6) * 128 + (n0 >= FF ? 64 : 0) + n; }
      *(v4u*)(dst + (size_t)nrow * K + k0 + c * 8) = pack8(f);
    }
  }
}

DI void pack_k_task(const u16* __restrict__ src, int ld, int col0, int NH, u16* __restrict__ dst, const float* __restrict__ rope, int task) {
  int t = task & (S_ - 1); int rest = task >> 13; int hs = rest % NH; int b = rest / NH;
  const u16* row = src + (size_t)(b * S_ + t) * ld + col0 + hs * 64;
  v4u c[8];
#pragma unroll
  for (int i = 0; i < 8; ++i) c[i] = *(const v4u*)(row + 8 * i);
  float x1[8], x2[8], o1[8], o2[8];
  unpack8(c[0], x1); unpack8(c[1], x2);
  const float* rt = rope + (size_t)t * 16;
#pragma unroll
  for (int i = 0; i < 8; ++i) { float cs = rt[i], sn = rt[8 + i]; o1[i] = x1[i] * cs - x2[i] * sn; o2[i] = x2[i] * cs + x1[i] * sn; }
  c[0] = pack8(o1); c[1] = pack8(o2);
  u16* d = dst + (size_t)(b * NH + hs) * S_ * 64;
#pragma unroll
  for (int i = 0; i < 8; ++i) *(v4u*)(d + kfrag_chunk(t, i)) = c[i];
}
template <int NDVT>
DI void pack_v_task(const u16* __restrict__ src, int ld, int col0, int NH, u16* __restrict__ dst, int task) {
  int ln = task & 63; int s = (task >> 6) & 3; int rest = task >> 8; int dvt = rest % NDVT; rest /= NDVT; int tile = rest & 127; rest >>= 7; int hs = rest % NH; int b = rest / NH;
  int h = ln >> 5, dv = dvt * 32 + (ln & 31);
  const u16* base = src + (size_t)(b * S_ + tile * 64 + 16 * s + 4 * h) * ld + col0 + hs * (32 * NDVT) + dv;
  u16 v[8];
#pragma unroll
  for (int j = 0; j < 8; ++j) { int kk = 8 * (j >> 2) + (j & 3); v[j] = base[(size_t)kk * ld]; }
  v4u o = mk4(v[0] | ((unsigned)v[1] << 16), v[2] | ((unsigned)v[3] << 16), v[4] | ((unsigned)v[5] << 16), v[6] | ((unsigned)v[7] << 16));
  u16* d = dst + (size_t)(b * NH + hs) * S_ * (32 * NDVT);
  *(v4u*)(d + ((size_t)(((tile * NDVT + dvt) * 4 + s) * 64 + ln)) * 8) = o;
}

DI bf16x8 rope_q(const u16* __restrict__ qrow, const float* __restrict__ rt, int h) {
  v4u a = *(const v4u*)qrow, b = *(const v4u*)(qrow + 8);
  float x1[8], x2[8], o[8];
  unpack8(a, x1); unpack8(b, x2);
#pragma unroll
  for (int i = 0; i < 8; ++i) { float cs = rt[i], sn = rt[8 + i]; o[i] = h == 0 ? (x1[i] * cs - x2[i] * sn) : (x2[i] * cs + x1[i] * sn); }
  v4u r = pack8(o);
  return __builtin_bit_cast(bf16x8, r);
}

template <int NDVT, int MODE>
DI void attn_stream(const u16* __restrict__ Kf, const u16* __restrict__ Vf, int tb, int te, const unsigned* umask,
                    const bf16x8 (&q)[4], f32x16 (&O)[NDVT], float& m, float& l, int t, int tmin, int tmax, const unsigned* selw, char* lds) {
  constexpr int NCH = 2 + NDVT;
  constexpr int TILE_B = NCH * 4096;
  const int tid = get_tid(), lane = tid & 63, h = lane >> 5;
  v4u pre[NCH];
#define ATT_VALID(i_) (MODE != 2 || ((umask[(i_) >> 5] >> ((i_) & 31)) & 1u))
#define ATT_GLOAD(i_)                                                                                   \
  {                                                                                                     \
    const u16* kp = Kf + (size_t)(i_) * 4096;                                                           \
    const u16* vp = Vf + (size_t)(i_) * (2048 * NDVT);                                                  \
    _Pragma("unroll") for (int c = 0; c < 2; ++c) pre[c] = *(const v4u*)(kp + (c * 256 + tid) * 8);   \
    _Pragma("unroll") for (int c = 0; c < NDVT; ++c) pre[2 + c] = *(const v4u*)(vp + (c * 256 + tid) * 8); \
  }
  int i = tb;
  while (i < te && !ATT_VALID(i)) ++i;
  __syncthreads();
  if (i < te) ATT_GLOAD(i)
  int buf = 0;
  while (i < te) {
    char* tl = lds + buf * TILE_B;
#pragma unroll
    for (int c = 0; c < NCH; ++c) *(v4u*)(tl + (c * 256 + tid) * 16) = pre[c];
    __syncthreads();
    int nx = i + 1;
    while (nx < te && !ATT_VALID(nx)) ++nx;
    if (nx < te) ATT_GLOAD(nx)
    bool tok_ok = true;
    if (MODE == 2) tok_ok = (selw[i >> 5] >> (i & 31)) & 1u;
    if (MODE != 2 || __any(tok_ok)) {
    f32x16 S0, S1;
#pragma unroll
    for (int e = 0; e < 16; ++e) { S0[e] = 0.f; S1[e] = 0.f; }
    bf16x8 kf[8];
#pragma unroll
    for (int j = 0; j < 8; ++j) kf[j] = *(const bf16x8*)(tl + (j * 64 + lane) * 16);
    __builtin_amdgcn_sched_barrier(0);
#pragma unroll
    for (int s = 0; s < 4; ++s) { S0 = MFMA(kf[s], q[s], S0); S1 = MFMA(kf[4 + s], q[s], S1); }
    __builtin_amdgcn_sched_barrier(0);
    bf16x8 vf[8];
#pragma unroll
    for (int j = 0; j < 8; ++j) vf[j] = *(const bf16x8*)(tl + 8192 + (j * 64 + lane) * 16);
    __builtin_amdgcn_sched_barrier(0);
    bool full = (i * 64 + 63 <= tmin);
    if (MODE == 1) full = full && (i * 64 > tmax - 512);
    if (!full) {
      const int kb = i * 64 + 4 * h;
#pragma unroll
      for (int e = 0; e < 16; ++e) {
        int k0 = kb + 8 * (e >> 2) + (e & 3), k1 = k0 + 32;
        bool v0 = (k0 <= t), v1 = (k1 <= t);
        if (MODE == 1) { v0 = v0 && (k0 > t - 512); v1 = v1 && (k1 > t - 512); }
        S0[e] = v0 ? S0[e] : -INFINITY; S1[e] = v1 ? S1[e] : -INFINITY;
      }
    }
    float mx = fmaxf(S0[0], S1[0]);
#pragma unroll
    for (int e = 1; e < 16; ++e) mx = fmaxf(mx, fmaxf(S0[e], S1[e]));
    if (MODE == 2) mx = tok_ok ? mx : -INFINITY;
    mx = fmaxf(mx, __shfl_xor(mx, 32));
    float mnew = fmaxf(m, mx);
    if (__any(mnew > m)) {
      float f = __builtin_amdgcn_exp2f((m - mnew) * SC);
      l *= f;
#pragma unroll
      for (int d = 0; d < NDVT; ++d)
#pragma unroll
        for (int e = 0; e < 16; ++e) O[d][e] *= f;
    }
    m = mnew;
    const float nb = (MODE == 2 && !tok_ok) ? -INFINITY : -(m * SC);
    float ls = 0.f;
#pragma unroll
    for (int e = 0; e < 16; ++e) {
      S0[e] = __builtin_amdgcn_exp2f(fmaf(S0[e], SC, nb));
      S1[e] = __builtin_amdgcn_exp2f(fmaf(S1[e], SC, nb));
      ls += S0[e] + S1[e];
    }
    l += ls;
    bf16x8 pf[4];
    pf[0] = pack_frag(S0, 0); pf[1] = pack_frag(S0, 1); pf[2] = pack_frag(S1, 0); pf[3] = pack_frag(S1, 1);
    if constexpr (NDVT == 4) {
      bf16x8 vg[8];
#pragma unroll
      for (int j = 0; j < 8; ++j) vg[j] = *(const bf16x8*)(tl + 8192 + ((8 + j) * 64 + lane) * 16);
      __builtin_amdgcn_sched_barrier(0);
#pragma unroll
      for (int d = 0; d < 2; ++d)
#pragma unroll
        for (int s = 0; s < 4; ++s) O[d] = MFMA(vf[d * 4 + s], pf[s], O[d]);
#pragma unroll
      for (int d = 0; d < 2; ++d)
#pragma unroll
        for (int s = 0; s < 4; ++s) O[2 + d] = MFMA(vg[d * 4 + s], pf[s], O[2 + d]);
    } else {
#pragma unroll
      for (int d = 0; d < 2; ++d)
#pragma unroll
        for (int s = 0; s < 4; ++s) O[d] = MFMA(vf[d * 4 + s], pf[s], O[d]);
    }
    __builtin_amdgcn_sched_barrier(0);
    }
    i = nx; buf ^= 1;
  }
}

constexpr int LDS_IMP = 32768, LDS_SELW = 49152, LDS_UMASK = 49152 + 512;
DI void nsa_attn_item(const Params& p, int item, char* smem) {
  const int tid = get_tid(), lane = tid & 63, w = tid >> 6, n = lane & 31, h = lane >> 5;
  const int bh = item & 7, qt = 255 - (item >> 3), b = bh >> 2, hk = bh & 3, t0 = qt * 32, cur = t0 >> 6;
  const int tokl = w * 8 + (n >> 2), g = n & 3, t = t0 + tokl, head = hk * 4 + g;
  const int twmin = t0 + __builtin_amdgcn_readfirstlane(w) * 8;
  const size_t R = (size_t)b * S_ + t;
  const u16* proj = (const u16*)(p.ws + OFF_PROJ);
  const float* rope = (const float*)(p.ws + OFF_ROPE);
  const u16* qrow = proj + R * LDP + head * 64;
  bf16x8 q[4], qr0;
#pragma unroll
  for (int s = 0; s < 4; ++s) q[s] = *(const bf16x8*)(qrow + 16 * s + 8 * h);
  qr0 = rope_q(qrow, rope + (size_t)t * 16, h);
  float gate[3];
#pragma unroll
  for (int j = 0; j < 3; ++j) { float x = bf1(proj[R * LDP + 2560 + head * 3 + j]); gate[j] = 1.f / (1.f + __expf(-x)); }
  float* imp = (float*)(smem + LDS_IMP) + w * 1024;
  unsigned* selw_all = (unsigned*)(smem + LDS_SELW);
  unsigned* umask = (unsigned*)(smem + LDS_UMASK);
  __syncthreads();
#pragma unroll
  for (int i = 0; i < 16; ++i) imp[i * 64 + lane] = 0.f;
  if (tid < 4) umask[tid] = 0u;
  __syncthreads();

  f32x16 Ot[2], Ob[2];
  {
    const int ncmax = (t0 >> 4) + 1;
    const int ntile = (ncmax + 63) >> 6;
    const u16* Kc = (const u16*)(p.ws + OFF_KCF) + (size_t)(b * 4 + hk) * 512 * 64;
    const u16* Vc = (const u16*)(p.ws + OFF_VCF) + (size_t)(b * 4 + hk) * 512 * 64;
    float m = -1e30f, l = 0.f;
    bf16x8 kc[8], kn[8];
#pragma unroll
    for (int j = 0; j < 8; ++j) kc[j] = *(const bf16x8*)(Kc + (j * 64 + lane) * 8);
    for (int i = 0; i < ntile; ++i) {
      const int inx = i + 1 < ntile ? i + 1 : i;
#pragma unroll
      for (int j = 0; j < 8; ++j) kn[j] = *(const bf16x8*)(Kc + (size_t)inx * 4096 + (j * 64 + lane) * 8);
      f32x16 S0, S1;
#pragma unroll
      for (int e = 0; e < 16; ++e) { S0[e] = 0.f; S1[e] = 0.f; }
#pragma unroll
      for (int s = 0; s < 4; ++s) { S0 = MFMA(kc[s], q[s], S0); S1 = MFMA(kc[4 + s], q[s], S1); }
#pragma unroll
      for (int j = 0; j < 8; ++j) kc[j] = kn[j];
      const int cb = i * 64 + 4 * h;
      float mx = -INFINITY;
#pragma unroll
      for (int e = 0; e < 16; ++e) {
        int c0 = cb + 8 * (e >> 2) + (e & 3), c1 = c0 + 32;
        S0[e] = (16 * c0 + 31 <= t) ? S0[e] : -INFINITY; S1[e] = (16 * c1 + 31 <= t) ? S1[e] : -INFINITY;
        mx = fmaxf(mx, fmaxf(S0[e], S1[e]));
      }
      mx = fmaxf(mx, __shfl_xor(mx, 32));
      float mnew = fmaxf(m, mx);
      l *= __builtin_amdgcn_exp2f((m - mnew) * SC);
      m = mnew;
      const float msc = m * SC;
      float ls = 0.f;
#pragma unroll
      for (int e = 0; e < 16; ++e) ls += __builtin_amdgcn_exp2f(fmaf(S0[e], SC, -msc)) + __builtin_amdgcn_exp2f(fmaf(S1[e], SC, -msc));
      l += ls;
    }
    l += __shfl_xor(l, 32);
    const float invl = l > 0.f ? 1.f / l : 0.f;
    const float msc = m * SC;
#pragma unroll
    for (int d = 0; d < 2; ++d)
#pragma unroll
      for (int e = 0; e < 16; ++e) Ob[d][e] = 0.f;
    float* impt = imp + (n >> 2) * 128;
#pragma unroll
    for (int j = 0; j < 8; ++j) kc[j] = *(const bf16x8*)(Kc + (j * 64 + lane) * 8);
    for (int i = 0; i < ntile; ++i) {
      const int inx = i + 1 < ntile ? i + 1 : i;
      bf16x8 vc[8];
#pragma unroll
      for (int j = 0; j < 8; ++j) vc[j] = *(const bf16x8*)(Vc + (size_t)i * 4096 + (j * 64 + lane) * 8);
#pragma unroll
      for (int j = 0; j < 8; ++j) kn[j] = *(const bf16x8*)(Kc + (size_t)inx * 4096 + (j * 64 + lane) * 8);
      f32x16 S0, S1;
#pragma unroll
      for (int e = 0; e < 16; ++e) { S0[e] = 0.f; S1[e] = 0.f; }
#pragma unroll
      for (int s = 0; s < 4; ++s) { S0 = MFMA(kc[s], q[s], S0); S1 = MFMA(kc[4 + s], q[s], S1); }
#pragma unroll
      for (int j = 0; j < 8; ++j) kc[j] = kn[j];
      const int cb = i * 64 + 4 * h;
#pragma unroll
      for (int e = 0; e < 16; ++e) {
        int c0 = cb + 8 * (e >> 2) + (e & 3), c1 = c0 + 32;
        S0[e] = (16 * c0 + 31 <= t) ? __builtin_amdgcn_exp2f(fmaf(S0[e], SC, -msc)) * invl : 0.f;
        S1[e] = (16 * c1 + 31 <= t) ? __builtin_amdgcn_exp2f(fmaf(S1[e], SC, -msc)) * invl : 0.f;
      }
#pragma unroll
      for (int rt = 0; rt < 2; ++rt)
#pragma unroll
        for (int r = 0; r < 4; ++r) {
          float a0 = rt == 0 ? S0[4 * r] : S1[4 * r], a1 = rt == 0 ? S0[4 * r + 1] : S1[4 * r + 1];
          float a2 = rt == 0 ? S0[4 * r + 2] : S1[4 * r + 2], a3 = rt == 0 ? S0[4 * r + 3] : S1[4 * r + 3];
          float A = (a0 + a1) + (a2 + a3), L = a3;
          A += __shfl_xor(A, 1); L += __shfl_xor(L, 1);
          A += __shfl_xor(A, 2); L += __shfl_xor(L, 2);
          int nb = i * 16 + rt * 8 + 2 * r + h;
          if (g == 0) { atomicAdd(&impt[nb], A); if (nb + 1 < 128) atomicAdd(&impt[nb + 1], L); }
        }
      bf16x8 pf[4];
      pf[0] = pack_frag(S0, 0); pf[1] = pack_frag(S0, 1); pf[2] = pack_frag(S1, 0); pf[3] = pack_frag(S1, 1);
#pragma unroll
      for (int d = 0; d < 2; ++d)
#pragma unroll
        for (int s = 0; s < 4; ++s) Ob[d] = MFMA(vc[d * 4 + s], pf[s], Ob[d]);
    }
#pragma unroll
    for (int d = 0; d < 2; ++d)
#pragma unroll
      for (int e = 0; e < 16; ++e) Ot[d][e] = gate[0] * Ob[d][e];
  }
  {
    const int hi = cur - 2;
    for (int tk = 0; tk < 8; ++tk) {
      const float* ip = imp + tk * 128;
      const int n0 = lane, n1 = lane + 64;
      bool s0, s1;
      if (hi > 13) {
        const unsigned k0 = (n0 >= 1 && n0 <= hi) ? (__float_as_uint(ip[n0]) + 1u) : 0u;
        const unsigned k1 = (n1 <= hi) ? (__float_as_uint(ip[n1]) + 1u) : 0u;
        unsigned prefix = 0u;
        for (int bit = 31; bit >= 0; --bit) {
          const unsigned trial = prefix | (1u << bit);
          const int cnt = __popcll(__ballot(k0 >= trial)) + __popcll(__ballot(k1 >= trial));
          if (cnt >= 13) prefix = trial;
        }
        const unsigned long long g0 = __ballot(k0 > prefix), g1 = __ballot(k1 > prefix);
        const unsigned long long e0 = __ballot(k0 == prefix), e1 = __ballot(k1 == prefix);
        const int extra = 13 - (__popcll(g0) + __popcll(g1));
        const unsigned long long below = (1ull << lane) - 1ull;
        const int r0 = __popcll(e0 & below), r1 = __popcll(e0) + __popcll(e1 & below);
        const bool t0 = (k0 > prefix) || (k0 == prefix && r0 < extra);
        const bool t1 = (k1 > prefix) || (k1 == prefix && r1 < extra);
        s0 = (n0 == 0) || (n0 <= cur && n0 >= cur - 1) || t0;
        s1 = (n1 <= cur && n1 >= cur - 1) || t1;
      } else { s0 = n0 <= cur; s1 = n1 <= cur; }
      unsigned long long b0 = __ballot(s0), b1 = __ballot(s1);
      if (lane == 0) {
        unsigned* sw = selw_all + (w * 8 + tk) * 4;
        sw[0] = (unsigned)b0; sw[1] = (unsigned)(b0 >> 32); sw[2] = (unsigned)b1; sw[3] = (unsigned)(b1 >> 32);
        atomicOr(&umask[0], (unsigned)b0); atomicOr(&umask[1], (unsigned)(b0 >> 32));
        atomicOr(&umask[2], (unsigned)b1); atomicOr(&umask[3], (unsigned)(b1 >> 32));
      }
    }
  }
  __syncthreads();
  bf16x8 qr[4] = {qr0, q[1], q[2], q[3]};
  {
    float m = -1e30f, l = 0.f;
#pragma unroll
    for (int d = 0; d < 2; ++d)
#pragma unroll
      for (int e = 0; e < 16; ++e) Ob[d][e] = 0.f;
    const u16* Kf = (const u16*)(p.ws + OFF_KSF) + (size_t)(b * 4 + hk) * S_ * 64;
    const u16* Vf = (const u16*)(p.ws + OFF_VSF) + (size_t)(b * 4 + hk) * S_ * 64;
    attn_stream<2, 2>(Kf, Vf, 0, cur + 1, umask, qr, Ob, m, l, t, twmin, twmin + 7, selw_all + tokl * 4, smem);
    l += __shfl_xor(l, 32);
    const float f = gate[1] / l;
#pragma unroll
    for (int d = 0; d < 2; ++d)
#pragma unroll
      for (int e = 0; e < 16; ++e) Ot[d][e] += f * Ob[d][e];
  }
  {
    float m = -1e30f, l = 0.f;
#pragma unroll
    for (int d = 0; d < 2; ++d)
#pragma unroll
      for (int e = 0; e < 16; ++e) Ob[d][e] = 0.f;
    const u16* Kf = (const u16*)(p.ws + OFF_KWF) + (size_t)(b * 4 + hk) * S_ * 64;
    const u16* Vf = (const u16*)(p.ws + OFF_VWF) + (size_t)(b * 4 + hk) * S_ * 64;
    int lo = t0 - 511; lo = lo < 0 ? 0 : lo;
    attn_stream<2, 1>(Kf, Vf, lo >> 6, ((t0 + 31) >> 6) + 1, nullptr, qr, Ob, m, l, t, twmin, twmin + 7, nullptr, smem);
    l += __shfl_xor(l, 32);
    const float f = gate[2] / l;
#pragma unroll
    for (int d = 0; d < 2; ++d)
#pragma unroll
      for (int e = 0; e < 16; ++e) Ot[d][e] += f * Ob[d][e];
  }
  u16* ao = (u16*)(p.ws + OFF_H) + R * D_ + head * 64;
#pragma unroll
  for (int d = 0; d < 2; ++d)
#pragma unroll
    for (int r = 0; r < 4; ++r)
      *(v2u*)(ao + d * 32 + 8 * r + 4 * h) = mk2(pk2(Ot[d][4 * r], Ot[d][4 * r + 1]), pk2(Ot[d][4 * r + 2], Ot[d][4 * r + 3]));
}

DI size_t kfrag16_chunk(int key, int c  ) { return ((size_t)((((key >> 6) * 8 + ((key >> 4) & 3) * 2 + (c >> 2)) * 64) + (c & 3) * 16 + (key & 15))) * 8; }
DI void pack_k16_task(const u16* __restrict__ src, int ld, int col0, int NH, u16* __restrict__ dst, const float* __restrict__ rope, int task) {
  int t = task & (S_ - 1); int rest = task >> 13; int hs = rest % NH; int b = rest / NH;
  const u16* row = src + (size_t)(b * S_ + t) * ld + col0 + hs * 64;
  v4u c[8];
#pragma unroll
  for (int i = 0; i < 8; ++i) c[i] = *(const v4u*)(row + 8 * i);
  float x1[8], x2[8], o1[8], o2[8];
  unpack8(c[0], x1); unpack8(c[1], x2);
  const float* rt = rope + (size_t)t * 16;
#pragma unroll
  for (int i = 0; i < 8; ++i) { float cs = rt[i], sn = rt[8 + i]; o1[i] = x1[i] * cs - x2[i] * sn; o2[i] = x2[i] * cs + x1[i] * sn; }
  c[0] = pack8(o1); c[1] = pack8(o2);
  u16* d = dst + (size_t)(b * NH + hs) * S_ * 64;
#pragma unroll
  for (int i = 0; i < 8; ++i) *(v4u*)(d + kfrag16_chunk(t, i)) = c[i];
}
DI void pack_v16_task(const u16* __restrict__ src, int ld, int col0, int NH, u16* __restrict__ dst, int task) {
  int ln = task & 63; int s = (task >> 6) & 1; int dvt = (task >> 7) & 7; int rest = task >> 10; int tile = rest & 127; rest >>= 7; int hs = rest % NH; int b = rest / NH;
  const int lq = ln >> 4, dv = dvt * 16 + (ln & 15);
  const u16* base = src + (size_t)(b * S_ + tile * 64 + 32 * s + 4 * lq) * ld + col0 + hs * 128 + dv;
  u16 v[8];
#pragma unroll
  for (int j = 0; j < 8; ++j) { int kk = 16 * (j >> 2) + (j & 3); v[j] = base[(size_t)kk * ld]; }
  v4u o = mk4(v[0] | ((unsigned)v[1] << 16), v[2] | ((unsigned)v[3] << 16), v[4] | ((unsigned)v[5] << 16), v[6] | ((unsigned)v[7] << 16));
  u16* d = dst + (size_t)(b * NH + hs) * S_ * 128;
  *(v4u*)(d + ((size_t)(((tile * 8 + dvt) * 2 + s) * 64 + ln)) * 8) = o;
}
DI bf16x8 pack2x4(const f32x4& a, const f32x4& b) {
  v4u r = mk4(pk2(a[0], a[1]), pk2(a[2], a[3]), pk2(b[0], b[1]), pk2(b[2], b[3]));
  return __builtin_bit_cast(bf16x8, r);
}
DI void diff_attn_item(const Params& p, int item, char* smem) {
  const int tid = get_tid(), lane = tid & 63, l15 = lane & 15, lq = lane >> 4;
  const int wv = __builtin_amdgcn_readfirstlane(tid >> 6);
  const int bhc = item & 31, qt = 63 - (item >> 5), b = bhc >> 4, hc = bhc & 15, t0 = qt * 128;
  const int twmin = t0 + wv * 32;
  const float* rope = (const float*)(p.ws + OFF_ROPE);
  int tq[2]; bf16x8 qf[2][2];
#pragma unroll
  for (int ct = 0; ct < 2; ++ct) {
    tq[ct] = twmin + ct * 16 + l15;
    const u16* qrow = (const u16*)(p.ws + OFF_Q) + ((size_t)b * S_ + tq[ct]) * D_ + hc * 64;
    qf[ct][1] = *(const bf16x8*)(qrow + 32 + lq * 8);
    bf16x8 raw = *(const bf16x8*)(qrow + lq * 8);
    bf16x8 rp = rope_q(qrow, rope + (size_t)tq[ct] * 16, lq & 1);
    qf[ct][0] = lq < 2 ? rp : raw;
  }
  f32x4 O[8][2];
#pragma unroll
  for (int d = 0; d < 8; ++d)
#pragma unroll
    for (int ct = 0; ct < 2; ++ct)
#pragma unroll
      for (int e = 0; e < 4; ++e) O[d][ct][e] = 0.f;
  float m[2] = {-1e30f, -1e30f}, l[2] = {0.f, 0.f};
  const u16* Kf = (const u16*)(p.ws + OFF_SKVK) + (size_t)(b * 16 + hc) * S_ * 64;
  const u16* Vf = (const u16*)(p.ws + OFF_SKVV) + (size_t)(b * 8 + (hc >> 1)) * S_ * 128;
  const int te = 2 * qt + 2;
  constexpr int TILE_B = 24576;
  v4u pre[6];
#define D16_GLOAD(i_)                                                                                  \
  { const u16* kp = Kf + (size_t)(i_) * 4096; const u16* vp = Vf + (size_t)(i_) * 8192;                 \
    _Pragma("unroll") for (int c = 0; c < 2; ++c) pre[c] = *(const v4u*)(kp + (c * 256 + tid) * 8);    \
    _Pragma("unroll") for (int c = 0; c < 4; ++c) pre[2 + c] = *(const v4u*)(vp + (c * 256 + tid) * 8); }
  __syncthreads();
  D16_GLOAD(0)
  int buf = 0;
  for (int i = 0; i < te; ++i) {
    char* tl = smem + buf * TILE_B;
#pragma unroll
    for (int c = 0; c < 6; ++c) *(v4u*)(tl + (c * 256 + tid) * 16) = pre[c];
    __syncthreads();
    if (i + 1 < te) D16_GLOAD(i + 1)
    f32x4 S[4][2];
#pragma unroll
    for (int rt = 0; rt < 4; ++rt)
#pragma unroll
      for (int ct = 0; ct < 2; ++ct)
#pragma unroll
        for (int e = 0; e < 4; ++e) S[rt][ct][e] = 0.f;
    bf16x8 kf[8];
#pragma unroll
    for (int f = 0; f < 8; ++f) kf[f] = *(const bf16x8*)(tl + (f * 64 + lane) * 16);
    __builtin_amdgcn_sched_barrier(0);
#pragma unroll
    for (int rt = 0; rt < 4; ++rt)
#pragma unroll
      for (int ks = 0; ks < 2; ++ks)
#pragma unroll
        for (int ct = 0; ct < 2; ++ct) S[rt][ct] = MFMA16(kf[rt * 2 + ks], qf[ct][ks], S[rt][ct]);
    __builtin_amdgcn_sched_barrier(0);
    bf16x8 vf[8];
#pragma unroll
    for (int f = 0; f < 8; ++f) vf[f] = *(const bf16x8*)(tl + 8192 + (f * 64 + lane) * 16);
    __builtin_amdgcn_sched_barrier(0);
    if (!(i * 64 + 63 <= twmin)) {
#pragma unroll
      for (int rt = 0; rt < 4; ++rt)
#pragma unroll
        for (int ct = 0; ct < 2; ++ct)
#pragma unroll
          for (int e = 0; e < 4; ++e) { const int key = i * 64 + rt * 16 + 4 * lq + e; S[rt][ct][e] = key <= tq[ct] ? S[rt][ct][e] : -INFINITY; }
    }
    float mn[2]; bool grow = false;
#pragma unroll
    for (int ct = 0; ct < 2; ++ct) {
      float mx = fmaxf(fmaxf(S[0][ct][0], S[0][ct][1]), fmaxf(S[0][ct][2], S[0][ct][3]));
#pragma unroll
      for (int rt = 1; rt < 4; ++rt) mx = fmaxf(mx, fmaxf(fmaxf(S[rt][ct][0], S[rt][ct][1]), fmaxf(S[rt][ct][2], S[rt][ct][3])));
      mx = fmaxf(mx, __shfl_xor(mx, 16));
      mx = fmaxf(mx, __shfl_xor(mx, 32));
      mn[ct] = fmaxf(m[ct], mx);
      grow = grow || (mn[ct] > m[ct]);
    }
    if (__any(grow)) {
#pragma unroll
      for (int ct = 0; ct < 2; ++ct) {
        const float f = __builtin_amdgcn_exp2f((m[ct] - mn[ct]) * SC);
        l[ct] *= f;
#pragma unroll
        for (int d = 0; d < 8; ++d)
#pragma unroll
          for (int e = 0; e < 4; ++e) O[d][ct][e] *= f;
      }
    }
    bf16x8 pf[2][2];
#pragma unroll
    for (int ct = 0; ct < 2; ++ct) {
      m[ct] = mn[ct];
      const float nb = -(m[ct] * SC);
      float ls = 0.f;
#pragma unroll
      for (int rt = 0; rt < 4; ++rt)
#pragma unroll
        for (int e = 0; e < 4; ++e) { S[rt][ct][e] = __builtin_amdgcn_exp2f(fmaf(S[rt][ct][e], SC, nb)); ls += S[rt][ct][e]; }
      l[ct] += ls;
      pf[0][ct] = pack2x4(S[0][ct], S[1][ct]);
      pf[1][ct] = pack2x4(S[2][ct], S[3][ct]);
    }
    bf16x8 vg[8];
#pragma unroll
    for (int f = 0; f < 8; ++f) vg[f] = *(const bf16x8*)(tl + 8192 + ((8 + f) * 64 + lane) * 16);
    __builtin_amdgcn_sched_barrier(0);
#pragma unroll
    for (int d = 0; d < 4; ++d)
#pragma unroll
      for (int s = 0; s < 2; ++s)
#pragma unroll
        for (int ct = 0; ct < 2; ++ct) O[d][ct] = MFMA16(vf[d * 2 + s], pf[s][ct], O[d][ct]);
#pragma unroll
    for (int d = 0; d < 4; ++d)
#pragma unroll
      for (int s = 0; s < 2; ++s)
#pragma unroll
        for (int ct = 0; ct < 2; ++ct) O[4 + d][ct] = MFMA16(vg[d * 2 + s], pf[s][ct], O[4 + d][ct]);
    __builtin_amdgcn_sched_barrier(0);
    buf ^= 1;
  }
#pragma unroll
  for (int ct = 0; ct < 2; ++ct) {
    float lt = l[ct];
    lt += __shfl_xor(lt, 16);
    lt += __shfl_xor(lt, 32);
    const float f = 1.f / lt;
    u16* op = (u16*)(p.ws + OFF_KVRAW) + (((size_t)b * S_ + tq[ct]) * 16 + hc) * 128;
#pragma unroll
    for (int d = 0; d < 8; ++d)
      *(v2u*)(op + d * 16 + 4 * lq) = mk2(pk2(O[d][ct][0] * f, O[d][ct][1] * f), pk2(O[d][ct][2] * f, O[d][ct][3] * f));
  }
}

DI void conv_task(const u16* __restrict__ u, u16* __restrict__ act, const float* __restrict__ cw, const float* __restrict__ cbias, int task) {
  const int ck = task % 344, rr = task / 344;
  const int j0 = ck * 8, ts = rr * 16;
  float wg[3][8], wv[3][8], bg[8], bv[8], g1[8], g2[8], v1[8], v2[8];
#pragma unroll
  for (int e = 0; e < 8; ++e) {
#pragma unroll
    for (int tp = 0; tp < 3; ++tp) { wg[tp][e] = cw[tp * FF2 + j0 + e]; wv[tp][e] = cw[tp * FF2 + FF + j0 + e]; }
    bg[e] = cbias[j0 + e]; bv[e] = cbias[FF + j0 + e];
    g1[e] = g2[e] = v1[e] = v2[e] = 0.f;
  }
  if (ts > 0) {
    unpack8(*(const v4u*)(u + (size_t)(ts - 1) * FF2 + j0), g1); unpack8(*(const v4u*)(u + (size_t)(ts - 1) * FF2 + FF + j0), v1);
    unpack8(*(const v4u*)(u + (size_t)(ts - 2) * FF2 + j0), g2); unpack8(*(const v4u*)(u + (size_t)(ts - 2) * FF2 + FF + j0), v2);
  }
#pragma unroll 4
  for (int r = 0; r < 16; ++r) {
    const int t = ts + r;
    float gc[8], vc[8], o[8];
    unpack8(*(const v4u*)(u + (size_t)t * FF2 + j0), gc); unpack8(*(const v4u*)(u + (size_t)t * FF2 + FF + j0), vc);
#pragma unroll
    for (int e = 0; e < 8; ++e) {
      float cgv = bg[e] + wg[0][e] * g2[e] + wg[1][e] * g1[e] + wg[2][e] * gc[e];
      float cvv = bv[e] + wv[0][e] * v2[e] + wv[1][e] * v1[e] + wv[2][e] * vc[e];
      o[e] = cgv / (1.f + __expf(-cgv)) * cvv;
      g2[e] = g1[e]; g1[e] = gc[e]; v2[e] = v1[e]; v1[e] = vc[e];
    }
    *(v4u*)(act + (size_t)t * FF + j0) = pack8(o);
  }
}

DI void diff_comb_row(const Params& p, int j, int layer, int row, int lane) {
  const float* lv = p.in[12] + j * 256;
  float sa = wave_sum(lv[lane] * lv[64 + lane]), sb = wave_sum(lv[128 + lane] * lv[192 + lane]);
  const float lam_init = 0.8f - 0.6f * expf(-0.3f * (float)layer);
  const float lam = expf(sa) - expf(sb) + lam_init;
  const int head = lane >> 3, part = lane & 7;
  const u16* o0 = (const u16*)(p.ws + OFF_KVRAW) + ((size_t)row * 16 + head * 2) * 128 + part * 16;
  const u16* o1 = o0 + 128;
  float a[16], bb[16];
  unpack8(*(const v4u*)o0, a); unpack8(*(const v4u*)(o0 + 8), a + 8);
  unpack8(*(const v4u*)o1, bb); unpack8(*(const v4u*)(o1 + 8), bb + 8);
  float ss = 0.f;
#pragma unroll
  for (int e = 0; e < 16; ++e) { a[e] = a[e] - lam * bb[e]; ss += a[e] * a[e]; }
  ss += __shfl_xor(ss, 1); ss += __shfl_xor(ss, 2); ss += __shfl_xor(ss, 4);
  const float r = rsqrtf(ss * (1.f / 128.f) + 1e-6f) * (1.f - lam_init);
  const float* sg = p.in[13] + j * 128 + part * 16;
#pragma unroll
  for (int e = 0; e < 16; ++e) a[e] = a[e] * r * sg[e];
  u16* dst = (u16*)(p.ws + OFF_H) + (size_t)row * D_ + head * 128 + part * 16;
  *(v4u*)dst = pack8(a); *(v4u*)(dst + 8) = pack8(a + 8);
}


#define XB_TMO      128
#define XB_XCNT(j)  (256  + 64 * (j))
#define XB_XSUB(j)  (1280 + 64 * (j))
#define XB_XGEN(j)  (2304 + 64 * (j))
#define XB_TOP      3328
#define XB_TOPGEN   3392
#define XCD_BAR_WORDS 3456
#define XB_SPIN_CAP (1u << 24)
#define LAS __attribute__((address_space(3)))
DI unsigned xb_ld(unsigned* p)              { return __hip_atomic_load(p, __ATOMIC_RELAXED, __HIP_MEMORY_SCOPE_AGENT); }
DI unsigned xb_add(unsigned* p, unsigned v) { return __hip_atomic_fetch_add(p, v, __ATOMIC_RELAXED, __HIP_MEMORY_SCOPE_AGENT); }
DI unsigned xb_xcc_id() { return (unsigned)__builtin_amdgcn_s_getreg((3 << 11) | 20) & 0xFu; }
#define XB_SPIN(cond, bar) do { unsigned _sp = 0; while (cond) { __builtin_amdgcn_s_sleep(1); \
    if ((++_sp & 255u) == 0u) { if (xb_ld(&(bar)[XB_TMO])) break; if (_sp > XB_SPIN_CAP) { atomicAdd(&(bar)[XB_TMO], 1u); break; } } } } while (0)
struct XcdBarrier { unsigned* bar; unsigned x; volatile LAS unsigned* st; };
DI XcdBarrier xcd_barrier_post(unsigned* bar, volatile LAS unsigned* st) {
  XcdBarrier b; b.bar = bar; b.x = xb_xcc_id(); b.st = st;
  if (__builtin_amdgcn_workitem_id_x() == 0) (void)xb_add(&bar[XB_XCNT(b.x)], 1u);
  return b;
}
DI void xcd_barrier_complete(unsigned* bar, unsigned x, unsigned& nloc, unsigned& nx) {
  const unsigned G = gridDim.x * gridDim.y * gridDim.z;
  unsigned sum, cnt, mine, sp = 0u;
  for (;;) {
    sum = 0u; cnt = 0u; mine = 0u;
#pragma unroll
    for (unsigned j = 0; j < 16; ++j) { const unsigned c = xb_ld(&bar[XB_XCNT(j)]); sum += c; cnt += (c > 0u) ? 1u : 0u; mine = (j == x) ? c : mine; }
    if (sum == G) break;
    __builtin_amdgcn_s_sleep(1);
    if ((++sp & 255u) == 0u) { if (xb_ld(&bar[XB_TMO])) break; if (sp > XB_SPIN_CAP) { atomicAdd(&bar[XB_TMO], 1u); break; } }
  }
  nloc = mine > 0u ? mine : 1u; nx = cnt > 0u ? cnt : 1u;
}
DI void xcd_barrier(const XcdBarrier& b) {
  asm volatile("s_waitcnt vmcnt(0)" ::: "memory");
  __syncthreads();
  if (__builtin_amdgcn_workitem_id_x() == 0) {
    unsigned* bar = b.bar;
    __builtin_amdgcn_s_waitcnt(0);
    unsigned nloc = b.st[0], nx = b.st[1];
    if (nloc == 0u) { xcd_barrier_complete(bar, b.x, nloc, nx); b.st[0] = nloc; b.st[1] = nx; }
    const unsigned old = xb_add(&bar[XB_XSUB(b.x)], 1u);
    const unsigned gen = old / nloc;
    if (old + 1u == (gen + 1u) * nloc) {
      __builtin_amdgcn_fence(__ATOMIC_RELEASE, "agent");
      asm volatile("s_waitcnt vmcnt(0)" ::: "memory");
      const unsigned og = xb_add(&bar[XB_TOP], 1u);
      const unsigned tg = og / nx;
      if (og + 1u == (tg + 1u) * nx) xb_add(&bar[XB_TOPGEN], 1u);
      else XB_SPIN(xb_ld(&bar[XB_TOPGEN]) == tg, bar);
      __builtin_amdgcn_fence(__ATOMIC_ACQUIRE, "agent");
      xb_add(&bar[XB_XGEN(b.x)], 1u);
      asm volatile("s_waitcnt vmcnt(0)" ::: "memory");
    } else {
      XB_SPIN(xb_ld(&bar[XB_XGEN(b.x)]) == gen, bar);
      __builtin_amdgcn_fence(__ATOMIC_ACQUIRE, "agent");
      asm volatile("s_waitcnt vmcnt(0)" ::: "memory");
    }
  }
  __syncthreads();
}

DI bool xcd_tile(int bid, int round, int G, int MT, int NT, int& tm, int& tn) {
  const int mx = MT >> 3, q = (bid >> 3) + (G >> 3) * round;
  if (q >= mx * NT) return false;
  tm = (bid & 7) * mx + q % mx; tn = q / mx;
  return true;
}
DI int snake(int r, int G, int j) { return r * G + ((r & 1) ? (G - 1 - j) : j); }

DI void run_step(const Params& pk, const Step st, char* smem) {
  const int G = gridDim.x, bid = get_bid(), tid = get_tid(), lane = tid & 63, wave = tid >> 6;
  const int L = st.layer;
  size_t z = 0;
  asm volatile("" : "+s"(z));
  Params p;
#pragma unroll
  for (int i = 0; i < 20; ++i) p.in[i] = pk.in[i] + z;
  p.out = pk.out + z;
  p.ws = pk.ws + z;
  char* ws = p.ws;
  float* xcur = p.out;
  switch (st.op) {
  case OP_PREP: {
    const int n_rope = 256, n_cb = 32, n_norm = 4096;
    const int total = N_TR_TILES + n_rope + n_cb + n_norm;
    int tj = 0, tbase = 0;
    for (int w = bid; w < total; w += G) {
      if (w < N_TR_TILES) { transpose_tile(pk, z, w, smem, tj, tbase); continue; }
      int k = w - N_TR_TILES;
      if (k < n_rope) {
        int idx = k * 256 + tid; int t = idx >> 3, i = idx & 7;
        float inv = powf(500000.f, -(float)i / 8.f);
        float ang = (float)t * inv;
        float* rp = (float*)(ws + OFF_ROPE) + (size_t)t * 16;
        rp[i] = cosf(ang); rp[8 + i] = sinf(ang);
        continue;
      }
      k -= n_rope;
      if (k < n_cb) {
        int lkv = k >> 3, j0 = (k & 7) * 32;
        int jj = tid & 31, kg = tid >> 5;
        const float* pe = p.in[5] + lkv * 2048;
        const float* w1 = p.in[6] + (size_t)lkv * 2048 * 256;
        float s = 0.f;
        for (int kk = kg * 256; kk < kg * 256 + 256; ++kk) s += pe[kk] * w1[(size_t)kk * 256 + j0 + jj];
        float* part = (float*)smem;
        __syncthreads();
        part[tid] = s;
        __syncthreads();
        if (tid < 32) { float a = p.in[7][lkv * 256 + j0 + tid]; for (int q = 0; q < 8; ++q) a += part[q * 32 + tid]; ((float*)(ws + OFF_CB))[lkv * 256 + j0 + tid] = a; }
        continue;
      }
      k -= n_cb;
      { int row = k * 4 + wave; prep_row_x(p.in[0] + (size_t)row * D_, (u16*)(ws + OFF_XB) + (size_t)row * D_, (float*)(ws + OFF_SSQ) + (size_t)row * 8, lane); }
    }
  } break;
  case OP_NORM: {
    const float* g = (st.aux ? p.in[2] : p.in[1]) + L * D_;
    for (int k = bid; k < 4096; k += G) { int row = k * 4 + wave; norm_row_bf16(xcur + (size_t)row * D_, g, (u16*)(ws + OFF_H) + (size_t)row * D_, lane); }
  } break;
  case OP_FINAL: {
    const u16* xbp = (const u16*)(ws + OFF_XB);
    for (int k = bid; k < 4096; k += 2 * G) {
      const int k2 = k + G;
      const size_t ra_ = (size_t)(k * 4 + wave) * D_, rc_ = (size_t)((k2 < 4096 ? k2 : k) * 4 + wave) * D_;
      v4u ua[2], uc[2];
#pragma unroll
      for (int q = 0; q < 2; ++q) { ua[q] = ((const v4u*)(xbp + ra_))[q * 64 + lane]; uc[q] = ((const v4u*)(xbp + rc_))[q * 64 + lane]; }
      float fa[16], fc[16];
      unpack8(ua[0], fa); unpack8(ua[1], fa + 8); unpack8(uc[0], fc); unpack8(uc[1], fc + 8);
      float sa = 0.f, sc = 0.f;
#pragma unroll
      for (int e2 = 0; e2 < 16; ++e2) { sa += fa[e2] * fa[e2]; sc += fc[e2] * fc[e2]; }
      sa = wave_sum(sa); sc = wave_sum(sc);
      const float ra = rsqrtf(sa * (1.f / 1024.f) + 1e-6f), rc = rsqrtf(sc * (1.f / 1024.f) + 1e-6f);
#pragma unroll
      for (int q = 0; q < 2; ++q) {
        const int c2 = (q * 64 + lane) * 2;
        const float4 g0 = ((const float4*)p.in[19])[c2], g1 = ((const float4*)p.in[19])[c2 + 1];
        ((float4*)(xcur + ra_))[c2] = make_float4(fa[q * 8] * ra * g0.x, fa[q * 8 + 1] * ra * g0.y, fa[q * 8 + 2] * ra * g0.z, fa[q * 8 + 3] * ra * g0.w);
        ((float4*)(xcur + ra_))[c2 + 1] = make_float4(fa[q * 8 + 4] * ra * g1.x, fa[q * 8 + 5] * ra * g1.y, fa[q * 8 + 6] * ra * g1.z, fa[q * 8 + 7] * ra * g1.w);
        if (k2 < 4096) {
          ((float4*)(xcur + rc_))[c2] = make_float4(fc[q * 8] * rc * g0.x, fc[q * 8 + 1] * rc * g0.y, fc[q * 8 + 2] * rc * g0.z, fc[q * 8 + 3] * rc * g0.w);
          ((float4*)(xcur + rc_))[c2 + 1] = make_float4(fc[q * 8 + 4] * rc * g1.x, fc[q * 8 + 5] * rc * g1.y, fc[q * 8 + 6] * rc * g1.z, fc[q * 8 + 7] * rc * g1.w);
        }
      }
    }
  } break;
  case OP_NSA_IN: {
    ARow af{(const u16*)(ws + OFF_XB), D_};
    EpiStoreT ep{(u16*)(ws + OFF_PROJ), LDP, (const float*)(ws + OFF_SSQ)};
    const u16* Bt = (const u16*)(ws + OFF_WNI) + (size_t)L * LDP * 1024;
    for (int r = 0, tm, tn; xcd_tile(bid, r, G, 128, 11, tm, tn); ++r) gemm_tile(af, Bt, LDP, 1024, tm * 128, tn * 256, ep, smem);
  } break;
  case OP_NSA_PACK: {
    const u16* proj = (const u16*)(ws + OFF_PROJ);
    const float* rope = (const float*)(ws + OFF_ROPE);
    const int n_g = 64, n_k = 2 * 256, n_v = 2 * 2048;
    for (int w = bid; w < n_g + n_k + n_v; w += G) {
      if (w < n_g) {
        int kv = w >> 5, lt = w & 31;
        ACmp af{proj, 1024 + kv * 256};
        EpiGelu ep{(const float*)(ws + OFF_CB) + (L * 2 + kv) * 256, (u16*)(ws + OFF_HID) + (size_t)kv * 4096 * 256};
        gemm_tile(af, (const u16*)(ws + OFF_WP1) + (size_t)(L * 2 + kv) * 256 * 2048, 256, 2048, lt * 128, 0, ep, smem);
        continue;
      }
      int k = w - n_g;
      if (k < n_k) {
        int str = k >> 8, task = (k & 255) * 256 + tid;
        pack_k_task(proj, LDP, 1024 + (str ? 1024 : 512), 4, (u16*)(ws + (str ? OFF_KWF : OFF_KSF)), rope, task);
        continue;
      }
      k -= n_k;
      { int str = k >> 11, task = (k & 2047) * 256 + tid;
        pack_v_task<2>(proj, LDP, 1024 + (str ? 1280 : 768), 4, (u16*)(ws + (str ? OFF_VWF : OFF_VSF)), task); }
    }
  } break;
  case OP_NSA_CMP2: {
    for (int w = bid; w < 64; w += G) {
      int kv = w >> 5, lt = w & 31;
      ARow af{(const u16*)(ws + OFF_HID) + (size_t)kv * 4096 * 256, 256};
      EpiCmpOut ep{(u16*)(ws + OFF_KCF), (u16*)(ws + OFF_VCF), kv};
      gemm_tile(af, (const u16*)(ws + OFF_WP2) + (size_t)(L * 2 + kv) * 64 * 256, 64, 256, lt * 128, 0, ep, smem);
    }
  } break;
  case OP_NSA_ATTN: {
    for (int r = 0;; ++r) { int it = snake(r, G, bid); if (r * G >= 2048) break; if (it < 2048) nsa_attn_item(p, it, smem); }
  } break;
  case OP_OUTPROJ: {
    ARow af{(const u16*)(ws + OFF_H), D_};
    const u16* Bt = L < 2 ? (const u16*)(ws + OFF_WNO) + (size_t)L * 1024 * 1024 : (const u16*)(ws + OFF_WDO) + (size_t)(L - 2) * 1024 * 1024;
    {
      EpiResidT<false> ep{nullptr, nullptr, (u16*)(ws + OFF_XB), (float*)(ws + OFF_SSQ)};
      for (int r = 0, tm, tn; xcd_tile(bid, r, G, 128, 4, tm, tn); ++r) gemm_tile(af, Bt, 1024, 1024, tm * 128, tn * 256, ep, smem);
    }
  } break;
  case OP_FFN1: {
    ARow af{(const u16*)(ws + OFF_XB), D_};
    EpiConvGlu ep{(u16*)(ws + OFF_ACT), (u16*)(ws + OFF_HALO), p.in[16] + (size_t)L * 3 * FF2, p.in[17] + (size_t)L * FF2, (const float*)(ws + OFF_SSQ)};
    const u16* Bt = (const u16*)(ws + OFF_WFI) + (size_t)L * FF2 * 1024;
    for (int r = 0, tm, tn; xcd_tile(bid, r, G, 128, 22, tm, tn); ++r) gemm_tile(af, Bt, FF2, 1024, tm * 128, tn * 256, ep, smem);
  } break;
  case OP_FIX: {
    for (int k = bid; k < 344; k += G)
      ffn_fix_task((const u16*)(ws + OFF_HALO), (u16*)(ws + OFF_ACT), p.in[16] + (size_t)L * 3 * FF2, p.in[17] + (size_t)L * FF2, k * 256 + tid);
  } break;
  case OP_FFN2: {
    ARow af{(const u16*)(ws + OFF_ACT), FF};
    EpiResidT<false> ep{nullptr, nullptr, (u16*)(ws + OFF_XB), (float*)(ws + OFF_SSQ)};
    const u16* Bt = (const u16*)(ws + OFF_WFO) + (size_t)L * 1024 * FF;
    for (int r = 0, tm, tn; xcd_tile(bid, r, G, 128, 4, tm, tn); ++r) {
      for (int q = tid; q < 688; q += 256)
        ffn_fix_task((const u16*)(ws + OFF_HALO), (u16*)(ws + OFF_ACT), p.in[16] + (size_t)L * 3 * FF2, p.in[17] + (size_t)L * FF2, (tm * 2 + q / 344) * 344 + q % 344);
      gemm_tile(af, Bt, 1024, FF, tm * 128, tn * 256, ep, smem);
    }
  } break;
  case OP_KVQ_GEMM: {
    for (int r = 0, tm, tn; xcd_tile(bid, r, G, 128, 12, tm, tn); ++r) {
      if (tn < 8) {
        ARow af{(const u16*)(ws + OFF_XB), D_}; EpiStoreT ep{(u16*)(ws + OFF_KVRAW), 2048, (const float*)(ws + OFF_SSQ)};
        gemm_tile(af, (const u16*)(ws + OFF_WKV), 2048, 1024, tm * 128, tn * 256, ep, smem);
      } else {
        ARow af{(const u16*)(ws + OFF_XB), D_}; EpiStoreT ep{(u16*)(ws + OFF_Q), D_, (const float*)(ws + OFF_SSQ)};
        gemm_tile(af, (const u16*)(ws + OFF_WDQ), 1024, 1024, tm * 128, (tn - 8) * 256, ep, smem);
      }
    }
  } break;
  case OP_DQ_GEMM: {
    ARow af{(const u16*)(ws + OFF_XB), D_}; EpiStoreT ep{(u16*)(ws + OFF_Q), D_, (const float*)(ws + OFF_SSQ)};
    for (int r = 0, tm, tn; xcd_tile(bid, r, G, 128, 4, tm, tn); ++r) gemm_tile(af, (const u16*)(ws + OFF_WDQ) + 1024 * 1024, 1024, 1024, tm * 128, tn * 256, ep, smem);
  } break;
  case OP_KV_PACK: {
    const u16* kvr = (const u16*)(ws + OFF_KVRAW);
    const float* rope = (const float*)(ws + OFF_ROPE);
    const int n_k = 1024, n_v = 8192;
    for (int w = bid; w < n_k + n_v; w += G) {
      if (w < n_k) pack_k16_task(kvr, 2048, 0, 16, (u16*)(ws + OFF_SKVK), rope, w * 256 + tid);
      else pack_v16_task(kvr, 2048, 1024, 8, (u16*)(ws + OFF_SKVV), (w - n_k) * 256 + tid);
    }
  } break;
  case OP_DIFF_ATTN: {
    for (int r = 0;; ++r) { int it = snake(r, G, bid); if (r * G >= 2048) break; if (it < 2048) diff_attn_item(p, it, smem); }
  } break;
  case OP_DIFF_COMB: {
    for (int k = bid; k < 4096; k += G) diff_comb_row(p, L - 2, L, k * 4 + wave, lane);
  } break;
  }
}

__global__ void __launch_bounds__(256, 2) mega(Params p, int s_lo, int s_hi) {
  __shared__ __attribute__((aligned(16))) char smem[73728];
  __shared__ uint4 xb_words;
  cg::grid_group grid = cg::this_grid();
  const bool multi = (s_hi - s_lo) > 1;
  XcdBarrier xb;
  if (multi) {
    if (__builtin_amdgcn_workitem_id_x() == 0) xb_words = make_uint4(0u, 0u, 0u, 0u);
    __syncthreads();
    xb = xcd_barrier_post((unsigned*)(p.ws + OFF_BAR), (volatile LAS unsigned*)&xb_words);
  }
  for (int s = s_lo; s < s_hi; ++s) {
    Step st = g_prog[s];
    run_step(p, st, smem);
    if (s + 1 < s_hi) { if (s_hi > 4096) grid.sync();   xcd_barrier(xb); }
  }
}

extern "C" void kernel_launch(void* const* d_in, const int* in_sizes, int n_in, void* d_out, int out_size, void* d_ws, size_t ws_size,
                              hipStream_t stream) {
  (void)in_sizes; (void)n_in; (void)out_size;
  static int grid_blocks = 0;
  if (!grid_blocks) {
    int dev = 0, cus = 0, per_cu = 0;
    hipGetDevice(&dev);
    hipDeviceGetAttribute(&cus, hipDeviceAttributeMultiprocessorCount, dev);
    hipOccupancyMaxActiveBlocksPerMultiprocessor(&per_cu, mega, 256, 0);
    if (per_cu < 1) per_cu = 1;
    if (per_cu > 2) per_cu = 2;
    grid_blocks = cus * per_cu;
  }
  if (ws_size < WS_NEEDED) { fprintf(stderr, "workspace too small: %zu < %zu\n", ws_size, (size_t)WS_NEEDED); return; }
  Params p{};
  for (int i = 0; i < 20; ++i) p.in[i] = (const float*)d_in[i];
  p.out = (float*)d_out;
  p.ws = (char*)d_ws;
#if ONE_LAUNCH
  hipMemsetAsync((char*)d_ws + OFF_BAR, 0, XCD_BAR_WORDS * 4, stream);
  int lo = 0, hi = N_STEPS;
  void* args[] = {&p, &lo, &hi};
  hipError_t e = hipLaunchCooperativeKernel((void*)mega, dim3(grid_blocks), dim3(256), args, 0, stream);
  if (e != hipSuccess) fprintf(stderr, "cooperative launch failed: %s (grid %d)\n", hipGetErrorString(e), grid_blocks);
#else
  for (int s = 0; s < N_STEPS; ++s) mega<<<grid_blocks, 256, 0, stream>>>(p, s, s + 1);
#endif
}
```

```cpp
#include <hip/hip_runtime.h>
#include <hip/hip_cooperative_groups.h>
#include <math.h>
#include <stdint.h>
#include <stdio.h>
namespace cg = cooperative_groups;

#ifndef ONE_LAUNCH
#define ONE_LAUNCH 1
#endif

typedef unsigned short u16;
typedef __attribute__((ext_vector_type(8))) short bf16x8;
typedef __attribute__((ext_vector_type(16))) float f32x16;
typedef __bf16 bf2_t __attribute__((ext_vector_type(2)));
typedef float f2_t __attribute__((ext_vector_type(2)));
typedef unsigned v4u __attribute__((ext_vector_type(4)));
typedef unsigned v2u __attribute__((ext_vector_type(2)));
#define DI __device__ __forceinline__

#define MFMA(a, b, c) __builtin_amdgcn_mfma_f32_32x32x16_bf16((a), (b), (c), 0, 0, 0)
typedef __attribute__((ext_vector_type(4))) float f32x4;
#define MFMA16(a, b, c) __builtin_amdgcn_mfma_f32_16x16x32_bf16((a), (b), (c), 0, 0, 0)

constexpr int T_ = 16384, S_ = 8192, D_ = 1024;
constexpr int LDP = 2608;
constexpr int FF = 2752, FF2 = 5504;
constexpr float SC = 0.125f * 1.4426950408889634f;

constexpr size_t OFF_WNI = 0;
constexpr size_t OFF_WNO = OFF_WNI + 2ull * 2608 * 1024 * 2;
constexpr size_t OFF_WP1 = OFF_WNO + 2ull * 1024 * 1024 * 2;
constexpr size_t OFF_WP2 = OFF_WP1 + 4ull * 256 * 2048 * 2;
constexpr size_t OFF_WKV = OFF_WP2 + 4ull * 64 * 256 * 2;
constexpr size_t OFF_WDQ = OFF_WKV + 2048ull * 1024 * 2;
constexpr size_t OFF_WDO = OFF_WDQ + 2ull * 1024 * 1024 * 2;
constexpr size_t OFF_WFI = OFF_WDO + 2ull * 1024 * 1024 * 2;
constexpr size_t OFF_WFO = OFF_WFI + 4ull * 5504 * 1024 * 2;
constexpr size_t OFF_ROPE = OFF_WFO + 4ull * 1024 * 2752 * 2;
constexpr size_t OFF_CB = OFF_ROPE + 8192ull * 16 * 4;
constexpr size_t OFF_BAR = OFF_CB + 4096;
constexpr size_t OFF_H = OFF_BAR + 16384;
constexpr size_t OFF_SKVK = OFF_H + (size_t)T_ * 1024 * 2;
constexpr size_t OFF_SKVV = OFF_SKVK + (size_t)T_ * 1024 * 2;
constexpr size_t OFF_XB = OFF_SKVV + (size_t)T_ * 1024 * 2;
constexpr size_t OFF_SSQ = OFF_XB + (size_t)T_ * 1024 * 2;
constexpr size_t OFF_BIG = OFF_SSQ + (size_t)T_ * 8 * 4;
constexpr size_t OFF_PROJ = OFF_BIG;
constexpr size_t OFF_KSF = OFF_PROJ + (size_t)T_ * LDP * 2;
constexpr size_t OFF_KWF = OFF_KSF + (size_t)T_ * 256 * 2;
constexpr size_t OFF_VSF = OFF_KWF + (size_t)T_ * 256 * 2;
constexpr size_t OFF_VWF = OFF_VSF + (size_t)T_ * 256 * 2;
constexpr size_t OFF_HID = OFF_VWF + (size_t)T_ * 256 * 2;
constexpr size_t OFF_KCF = OFF_HID + 2ull * 4096 * 256 * 2;
constexpr size_t OFF_VCF = OFF_KCF + 2ull * 4 * 512 * 64 * 2;
constexpr size_t OFF_ACT = OFF_BIG;
constexpr size_t OFF_HALO = OFF_ACT + (size_t)T_ * 2752 * 2;
constexpr size_t OFF_Q = OFF_BIG;
constexpr size_t OFF_KVRAW = OFF_Q + (size_t)T_ * 1024 * 2;
constexpr size_t WS_NEEDED = OFF_VCF + 2ull * 4 * 512 * 64 * 2;

struct Params {
  const float* in[20];
  float* out;
  char* ws;
};

enum { OP_PREP = 0, OP_NORM, OP_NSA_IN, OP_NSA_PACK, OP_NSA_CMP2, OP_NSA_ATTN, OP_OUTPROJ, OP_FFN1, OP_CONV, OP_FFN2,
       OP_FIX, OP_KVQ_NORM, OP_KVQ_GEMM, OP_KV_PACK, OP_DIFF_ATTN, OP_DIFF_COMB, OP_DQ_GEMM, OP_FINAL };
struct Step { int op, layer, aux; };
#define FFN_STEPS(l) {OP_FFN1, l, 0}, {OP_FFN2, l, 0}
#define NSA_STEPS(l) {OP_NSA_IN, l, 0}, {OP_NSA_PACK, l, 0}, {OP_NSA_CMP2, l, 0}, {OP_NSA_ATTN, l, 0}, {OP_OUTPROJ, l, 0}
__constant__ Step g_prog[] = {
  {OP_PREP, 0, 0},
  NSA_STEPS(0), FFN_STEPS(0),
  NSA_STEPS(1), FFN_STEPS(1),
  {OP_KVQ_GEMM, 2, 0}, {OP_KV_PACK, 2, 0}, {OP_DIFF_ATTN, 2, 0}, {OP_DIFF_COMB, 2, 0}, {OP_OUTPROJ, 2, 0}, FFN_STEPS(2),
  {OP_DQ_GEMM, 3, 0}, {OP_DIFF_ATTN, 3, 0}, {OP_DIFF_COMB, 3, 0}, {OP_OUTPROJ, 3, 0}, FFN_STEPS(3),
  {OP_FINAL, 0, 0},
};
constexpr int N_STEPS = 1 + 7 + 7 + 7 + 6 + 1;

DI int get_tid() { int t = (int)__builtin_amdgcn_workitem_id_x(); asm volatile("" : "+v"(t)); return t; }
DI int get_bid() { int b = (int)__builtin_amdgcn_workgroup_id_x(); asm volatile("" : "+s"(b)); return b; }
DI v4u mk4(unsigned a, unsigned b, unsigned c, unsigned d) { v4u r = {a, b, c, d}; return r; }
DI v2u mk2(unsigned a, unsigned b) { v2u r = {a, b}; return r; }
DI unsigned pk2(float a, float b) { f2_t v = {a, b}; bf2_t r = __builtin_convertvector(v, bf2_t); return __builtin_bit_cast(unsigned, r); }
DI float bflo(unsigned u) { return __uint_as_float(u << 16); }
DI float bfhi(unsigned u) { return __uint_as_float(u & 0xffff0000u); }
DI float bf1(u16 v) { return __uint_as_float((unsigned)v << 16); }
DI u16 f2bf(float x) { return (u16)(pk2(x, 0.f) & 0xffffu); }
DI float wave_sum(float v) {
#pragma unroll
  for (int o = 32; o >= 1; o >>= 1) v += __shfl_xor(v, o);
  return v;
}
DI void unpack8(v4u a, float* f) {
  f[0] = bflo(a.x); f[1] = bfhi(a.x); f[2] = bflo(a.y); f[3] = bfhi(a.y);
  f[4] = bflo(a.z); f[5] = bfhi(a.z); f[6] = bflo(a.w); f[7] = bfhi(a.w);
}
DI v4u pack8(const float* f) { return mk4(pk2(f[0], f[1]), pk2(f[2], f[3]), pk2(f[4], f[5]), pk2(f[6], f[7])); }
DI bf16x8 pack_frag(const f32x16& x, int s) {
  v4u r = mk4(pk2(x[8 * s + 0], x[8 * s + 1]), pk2(x[8 * s + 2], x[8 * s + 3]), pk2(x[8 * s + 4], x[8 * s + 5]), pk2(x[8 * s + 6], x[8 * s + 7]));
  return __builtin_bit_cast(bf16x8, r);
}
DI size_t kfrag_chunk(int key, int c  ) { return ((size_t)(((key >> 5) * 4 + (c >> 1)) * 64 + (c & 1) * 32 + (key & 31))) * 8; }
template <int NDVT> DI size_t vfrag_index(int key, int dv) {
  int tile = key >> 6, s = (key >> 4) & 3, kk = key & 15, h = (kk >> 2) & 1, j = ((kk >> 3) << 2) | (kk & 3);
  return ((size_t)((((tile * NDVT + (dv >> 5)) * 4 + s) * 64) + h * 32 + (dv & 31))) * 8 + j;
}

struct ARow { const u16* base; int ld; DI const u16* operator()(int row, int k) const { return base + (size_t)row * ld + k; } };
struct ACmp {
  const u16* proj; int colbase;
  DI const u16* operator()(int r, int k) const {
    int hk = r & 3, i = (r >> 2) & 511, b = r >> 11; i = i > 510 ? 510 : i;
    return proj + (size_t)(b * S_ + 16 * i + (k >> 6)) * LDP + colbase + hk * 64 + (k & 63);
  }
};
struct EpiStore { static constexpr bool kTileEpi = false; u16* C; int ld; int N;
  DI void operator()(int m, int n, float a, float b, float c, float d) const { if (n < N) *(v2u*)(C + (size_t)m * ld + n) = mk2(pk2(a, b), pk2(c, d)); } };
struct EpiResid { static constexpr bool kTileEpi = false; const float* xin; float* xout;
  DI void operator()(int m, int n, float a, float b, float c, float d) const {
    float4 x = *(const float4*)(xin + (size_t)m * D_ + n); x.x += a; x.y += b; x.z += c; x.w += d; *(float4*)(xout + (size_t)m * D_ + n) = x; } };
DI float gelu_t(float x) { const float t = x * x; const float e = __builtin_amdgcn_exp2f(x * fmaf(t, -0.1029432f, -2.3022082f)); return x * __builtin_amdgcn_rcpf(1.f + e); }
struct EpiGelu { static constexpr bool kTileEpi = false; const float* bias; u16* C;
  DI void operator()(int m, int n, float a, float b, float c, float d) const {
    float4 bb = *(const float4*)(bias + n);
    *(v2u*)(C + (size_t)m * 256 + n) = mk2(pk2(gelu_t(a + bb.x), gelu_t(b + bb.y)), pk2(gelu_t(c + bb.z), gelu_t(d + bb.w))); } };
struct EpiCmpOut { static constexpr bool kTileEpi = false; u16* kcf; u16* vcf; int kv;
  DI void operator()(int m, int n, float a, float b, float c, float d) const {
    if (n >= 64) return;
    int hk = m & 3, i = (m >> 2) & 511, bb = m >> 11;
    if (i == 511) { a = b = c = d = 0.f; }
    size_t sb = (size_t)(bb * 4 + hk) * 512 * 64;
    if (kv == 0) { *(v2u*)(kcf + sb + kfrag_chunk(i, n >> 3) + (n & 7)) = mk2(pk2(a, b), pk2(c, d)); }
    else { vcf[sb + vfrag_index<2>(i, n)] = f2bf(a); vcf[sb + vfrag_index<2>(i, n + 1)] = f2bf(b); vcf[sb + vfrag_index<2>(i, n + 2)] = f2bf(c); vcf[sb + vfrag_index<2>(i, n + 3)] = f2bf(d); }
  } };


DI float rrow(const float* __restrict__ ssq, int m) {
  const float4 a = *(const float4*)(ssq + (size_t)m * 8), b = *(const float4*)(ssq + (size_t)m * 8 + 4);
  return rsqrtf(((a.x + a.y) + (a.z + a.w) + (b.x + b.y) + (b.z + b.w)) * (1.f / 1024.f) + 1e-6f);
}
constexpr int CT_ROW = 264;
struct EpiStoreT { static constexpr bool kTileEpi = true; static constexpr bool kRs = true;
  u16* C; int ld; const float* ssq;
  DI void tile(f32x4 (&acc)[8][4], const float (&rs)[4], int m0, int n0, int N, char* smem) const {
    u16* Ct = (u16*)smem;
    const int tid = get_tid(), lane = tid & 63, wave = tid >> 6, wm = wave & 1, wn = wave >> 1, l15 = lane & 15, lq = lane >> 4;
    __syncthreads();
#pragma unroll
    for (int ni = 0; ni < 8; ++ni)
#pragma unroll
      for (int mi = 0; mi < 4; ++mi) {
        const int m = wm * 64 + mi * 16 + l15, n = wn * 128 + ni * 16 + 4 * lq;
        const float s = rs[mi];
        *(v2u*)(Ct + m * CT_ROW + n) = mk2(pk2(acc[ni][mi][0] * s, acc[ni][mi][1] * s), pk2(acc[ni][mi][2] * s, acc[ni][mi][3] * s));
      }
    __syncthreads();
    const int ch = tid & 31, r0 = tid >> 5;
    if (n0 + ch * 8 < N) {
#pragma unroll
      for (int k = 0; k < 16; ++k) {
        const int m = r0 + 8 * k;
        *(v4u*)(C + (size_t)(m0 + m) * ld + n0 + ch * 8) = *(const v4u*)(Ct + m * CT_ROW + ch * 8);
      }
    }
  } };
constexpr int RT_ROW = 132;
template <bool F32IN>
struct EpiResidT { static constexpr bool kTileEpi = true; static constexpr bool kRs = false;
  const float* xin; float* xout; u16* xb; float* ssq;
  DI void tile(f32x4 (&acc)[8][4], const float (&rs)[4], int m0, int n0, int N, char* smem) const {
    float* Rt = (float*)smem;
    const int tid = get_tid(), lane = tid & 63, wave = tid >> 6, wm = wave & 1, wn = wave >> 1, l15 = lane & 15, lq = lane >> 4;
    const int ch = tid & 31, r0 = tid >> 5;
    if constexpr (!F32IN) {
      for (int pass = 0; pass < 2; ++pass) {
        v2u ur[16];
        const unsigned voff = (unsigned)(r0 * D_ + ch * 4);
        u16* const pbase = xb + (size_t)m0 * D_ + n0 + pass * 128;
#pragma unroll
        for (int k = 0; k < 16; ++k) ur[k] = *(const v2u*)(pbase + (size_t)(8 * k) * D_ + voff);
        __syncthreads();
        if (wn == pass) {
#pragma unroll
          for (int ni = 0; ni < 8; ++ni)
#pragma unroll
            for (int mi = 0; mi < 4; ++mi) {
              const int m = wm * 64 + mi * 16 + l15, n = ni * 16 + 4 * lq;
              *(float4*)(Rt + m * RT_ROW + n) = make_float4(acc[ni][mi][0], acc[ni][mi][1], acc[ni][mi][2], acc[ni][mi][3]);
            }
        }
        __syncthreads();
#pragma unroll
        for (int k = 0; k < 16; ++k) {
          if ((k & 3) == 0) __builtin_amdgcn_sched_barrier(0);
          const int m = r0 + 8 * k;
          float4 x = make_float4(bflo(ur[k].x), bfhi(ur[k].x), bflo(ur[k].y), bfhi(ur[k].y));
          const float4 a = *(const float4*)(Rt + m * RT_ROW + ch * 4);
          x.x += a.x; x.y += a.y; x.z += a.z; x.w += a.w;
          *(v2u*)(pbase + (size_t)(8 * k) * D_ + voff) = mk2(pk2(x.x, x.y), pk2(x.z, x.w));
          float ss = x.x * x.x + x.y * x.y + x.z * x.z + x.w * x.w;
#pragma unroll
          for (int o = 16; o >= 1; o >>= 1) ss += __shfl_xor(ss, o);
          if (ch == 0) ssq[(size_t)(m0 + m) * 8 + ((n0 >> 7) + pass)] = ss;
        }
      }
      return;
    }
    for (int pass = 0; pass < 2; ++pass) {
      float4 xr[8];
#pragma unroll
      for (int k = 0; k < 8; ++k) {
        const size_t o_ = (size_t)(m0 + r0 + 8 * k) * D_ + n0 + pass * 128 + ch * 4;
        if constexpr (F32IN) xr[k] = *(const float4*)(xin + o_);
        else { const v2u u_ = *(const v2u*)(xb + o_); xr[k] = make_float4(bflo(u_.x), bfhi(u_.x), bflo(u_.y), bfhi(u_.y)); }
      }
      __syncthreads();
      if (wn == pass) {
#pragma unroll
        for (int ni = 0; ni < 8; ++ni)
#pragma unroll
          for (int mi = 0; mi < 4; ++mi) {
            const int m = wm * 64 + mi * 16 + l15, n = ni * 16 + 4 * lq;
            *(float4*)(Rt + m * RT_ROW + n) = make_float4(acc[ni][mi][0], acc[ni][mi][1], acc[ni][mi][2], acc[ni][mi][3]);
          }
      }
      __syncthreads();
#pragma unroll 1
      for (int kh = 0; kh < 2; ++kh) {
        if (kh == 1) {
#pragma unroll
          for (int k = 0; k < 8; ++k) {
            const size_t o_ = (size_t)(m0 + r0 + 8 * (8 + k)) * D_ + n0 + pass * 128 + ch * 4;
            if constexpr (F32IN) xr[k] = *(const float4*)(xin + o_);
            else { const v2u u_ = *(const v2u*)(xb + o_); xr[k] = make_float4(bflo(u_.x), bfhi(u_.x), bflo(u_.y), bfhi(u_.y)); }
          }
        }
#pragma unroll
        for (int k = 0; k < 8; ++k) {
          const int m = r0 + 8 * (kh * 8 + k);
          const size_t off = (size_t)(m0 + m) * D_ + n0 + pass * 128 + ch * 4;
          float4 x = xr[k];
          const float4 a = *(const float4*)(Rt + m * RT_ROW + ch * 4);
          x.x += a.x; x.y += a.y; x.z += a.z; x.w += a.w;
          *(v2u*)(xb + off) = mk2(pk2(x.x, x.y), pk2(x.z, x.w));
          float ss = x.x * x.x + x.y * x.y + x.z * x.z + x.w * x.w;
#pragma unroll
          for (int o = 16; o >= 1; o >>= 1) ss += __shfl_xor(ss, o);
          if (ch == 0) ssq[(size_t)(m0 + m) * 8 + ((n0 >> 7) + pass)] = ss;
        }
      }
    }
  } };
constexpr int UT_ROW = 136;
DI float silu_mul(float g, float v) { return g * __builtin_amdgcn_rcpf(1.f + __expf(-g)) * v; }
struct EpiConvGlu { static constexpr bool kTileEpi = true; static constexpr bool kRs = true;
  u16* act; u16* halo; const float* cw; const float* cb; const float* ssq;
  DI void tile(f32x4 (&acc)[8][4], const float (&rs)[4], int m0, int n0, int N, char* smem) const {
    u16* Ut = (u16*)smem;
    const int tid = get_tid(), lane = tid & 63, wave = tid >> 6, wm = wave & 1, wn = wave >> 1, l15 = lane & 15, lq = lane >> 4;
    for (int pass = 0; pass < 2; ++pass) {
    if (n0 + pass * 128 >= N) break;
    const int tm = m0 >> 7, tn = (n0 >> 7) + pass;
    const int c = tid & 7, j0 = tn * 64 + c * 8;
    float wg[3][8], wv[3][8], bg[8], bv[8];
#pragma unroll
    for (int hq = 0; hq < 2; ++hq) {
#pragma unroll
      for (int tp = 0; tp < 3; ++tp) {
        float4 a = *(const float4*)(cw + tp * FF2 + j0 + 4 * hq), b = *(const float4*)(cw + tp * FF2 + FF + j0 + 4 * hq);
        wg[tp][4 * hq] = a.x; wg[tp][4 * hq + 1] = a.y; wg[tp][4 * hq + 2] = a.z; wg[tp][4 * hq + 3] = a.w;
        wv[tp][4 * hq] = b.x; wv[tp][4 * hq + 1] = b.y; wv[tp][4 * hq + 2] = b.z; wv[tp][4 * hq + 3] = b.w;
      }
      float4 a = *(const float4*)(cb + j0 + 4 * hq), b = *(const float4*)(cb + FF + j0 + 4 * hq);
      bg[4 * hq] = a.x; bg[4 * hq + 1] = a.y; bg[4 * hq + 2] = a.z; bg[4 * hq + 3] = a.w;
      bv[4 * hq] = b.x; bv[4 * hq + 1] = b.y; bv[4 * hq + 2] = b.z; bv[4 * hq + 3] = b.w;
    }
    __syncthreads();
    if (wn == pass) {
#pragma unroll
    for (int ni = 0; ni < 8; ++ni)
#pragma unroll
      for (int mi = 0; mi < 4; ++mi) {
        const int m = wm * 64 + mi * 16 + l15, n = ni * 16 + 4 * lq;
        const float s = rs[mi];
        *(v2u*)(Ut + m * UT_ROW + n) = mk2(pk2(acc[ni][mi][0] * s, acc[ni][mi][1] * s), pk2(acc[ni][mi][2] * s, acc[ni][mi][3] * s));
      }
    }
    __syncthreads();
    if (tid < 64) {
      int rr = tid >> 4, c2 = tid & 15, row = rr < 2 ? rr : 124 + rr, n = c2 * 8, half = n >> 6, j = tn * 64 + (n & 63);
      *(v4u*)(halo + ((size_t)((tm * 4 + rr) * 2 + half)) * FF + j) = *(const v4u*)(Ut + row * UT_ROW + n);
    }
#pragma unroll
    for (int k = 0; k < 4; ++k) {
      const int m = (tid >> 3) + 32 * k;
      if (m >= 2) {
        float g0[8], g1[8], g2[8], v0[8], v1[8], v2[8], o[8];
        unpack8(*(const v4u*)(Ut + m * UT_ROW + c * 8), g0); unpack8(*(const v4u*)(Ut + m * UT_ROW + 64 + c * 8), v0);
        unpack8(*(const v4u*)(Ut + (m - 1) * UT_ROW + c * 8), g1); unpack8(*(const v4u*)(Ut + (m - 1) * UT_ROW + 64 + c * 8), v1);
        unpack8(*(const v4u*)(Ut + (m - 2) * UT_ROW + c * 8), g2); unpack8(*(const v4u*)(Ut + (m - 2) * UT_ROW + 64 + c * 8), v2);
#pragma unroll
        for (int e = 0; e < 8; ++e)
          o[e] = silu_mul(bg[e] + wg[0][e] * g2[e] + wg[1][e] * g1[e] + wg[2][e] * g0[e], bv[e] + wv[0][e] * v2[e] + wv[1][e] * v1[e] + wv[2][e] * v0[e]);
        *(v4u*)(act + (size_t)(m0 + m) * FF + j0) = pack8(o);
      }
    }
    }
  } };
DI void ld_halo(const u16* __restrict__ halo, int tm, int rr, int half, int j0, float* f) { unpack8(*(const v4u*)(halo + ((size_t)((tm * 4 + rr) * 2 + half)) * FF + j0), f); }
DI void ffn_fix_task(const u16* __restrict__ halo, u16* __restrict__ act, const float* __restrict__ cw, const float* __restrict__ cb, int task) {
  const int ck = task % 344, rest = task / 344, r = rest & 1, tm = rest >> 1, j0 = ck * 8;
  const bool first = (tm & 63) == 0;
  float g0[8], g1[8], g2[8], v0[8], v1[8], v2[8], o[8];
#pragma unroll
  for (int e = 0; e < 8; ++e) { g1[e] = g2[e] = v1[e] = v2[e] = 0.f; }
  ld_halo(halo, tm, r, 0, j0, g0); ld_halo(halo, tm, r, 1, j0, v0);
  if (r == 1) { ld_halo(halo, tm, 0, 0, j0, g1); ld_halo(halo, tm, 0, 1, j0, v1); if (!first) { ld_halo(halo, tm - 1, 3, 0, j0, g2); ld_halo(halo, tm - 1, 3, 1, j0, v2); } }
  else if (!first) { ld_halo(halo, tm - 1, 3, 0, j0, g1); ld_halo(halo, tm - 1, 3, 1, j0, v1); ld_halo(halo, tm - 1, 2, 0, j0, g2); ld_halo(halo, tm - 1, 2, 1, j0, v2); }
#pragma unroll
  for (int e = 0; e < 8; ++e) {
    float cgv = cb[j0 + e] + cw[j0 + e] * g2[e] + cw[FF2 + j0 + e] * g1[e] + cw[2 * FF2 + j0 + e] * g0[e];
    float cvv = cb[FF + j0 + e] + cw[FF + j0 + e] * v2[e] + cw[FF2 + FF + j0 + e] * v1[e] + cw[2 * FF2 + FF + j0 + e] * v0[e];
    o[e] = silu_mul(cgv, cvv);
  }
  *(v4u*)(act + (size_t)(tm * 128 + r) * FF + j0) = pack8(o);
}

constexpr int G_ST = 24576;
#define GLDS1(gp_, ldsaddr_)                                                                                               \
  { unsigned keep_; const void* g_ = (const void*)(gp_); unsigned la_ = __builtin_amdgcn_readfirstlane(ldsaddr_);          \
    asm volatile("s_mov_b32 %0, m0\n\ts_mov_b32 m0, %2\n\ts_nop 0\n\tglobal_load_lds_dwordx4 %1, off\n\ts_mov_b32 m0, %0" : "=&s"(keep_) : "v"(g_), "s"(la_) : "memory"); }
template <class AF, class EP>
DI void gemm_tile(const AF& af, const u16* __restrict__ Bt, int N, int K, int m0, int n0, const EP& ep, char* smem) {
  const int tid = get_tid(), lane = tid & 63;
  const int wv = __builtin_amdgcn_readfirstlane(tid >> 6);
  const int wm = wv & 1, wn = wv >> 1;
  const int l15 = lane & 15, lq = lane >> 4;
  const unsigned lds0 = (unsigned)(size_t)smem;
  const int drow = lane >> 2, dc = ((lane & 3) ^ ((4 - ((lane >> 4) & 3)) & 3)) * 8;
  const u16* pb[4];
#pragma unroll
  for (int j = 0; j < 4; ++j) { int nb = n0 + (4 * wv + j) * 16 + drow; nb = nb < N ? nb : N - 1; pb[j] = Bt + (size_t)nb * K + dc; }
  f32x4 acc[8][4];
#pragma unroll
  for (int a = 0; a < 8; ++a)
#pragma unroll
    for (int b = 0; b < 4; ++b)
#pragma unroll
      for (int i = 0; i < 4; ++i) acc[a][b][i] = 0.f;
#define G_DMA(kt_, st_)                                                                                     \
  { const unsigned sb_ = lds0 + (unsigned)((st_) * G_ST);                                                   \
    _Pragma("unroll") for (int j = 0; j < 2; ++j) GLDS1(af(m0 + (2 * wv + j) * 16 + drow, (kt_) * 32 + dc), sb_ + (2 * wv + j) * 1024) \
    _Pragma("unroll") for (int j = 0; j < 4; ++j) GLDS1(pb[j] + (kt_) * 32, sb_ + 8192 + (4 * wv + j) * 1024) }
  asm volatile("s_waitcnt vmcnt(0)" ::: "memory");
  __syncthreads();
  const int nk = K >> 5;
  float rsv[4] = {1.f, 1.f, 1.f, 1.f};
  float4 rq[EP::kTileEpi ? 8 : 1];
  if constexpr (EP::kTileEpi) { if constexpr (EP::kRs) {
#pragma unroll
    for (int mi = 0; mi < 4; ++mi) { const float* sp = ep.ssq + (size_t)(m0 + wm * 64 + mi * 16 + l15) * 8; rq[2 * mi] = *(const float4*)sp; rq[2 * mi + 1] = *(const float4*)(sp + 4); }
  } }
  G_DMA(0, 0)
  if (nk > 1) G_DMA(1, 1)
  if constexpr (EP::kTileEpi) { if constexpr (EP::kRs) {
#pragma unroll
    for (int mi = 0; mi < 4; ++mi) { const float4 a = rq[2 * mi], b = rq[2 * mi + 1]; rsv[mi] = rsqrtf(((a.x + a.y) + (a.z + a.w) + (b.x + b.y) + (b.z + b.w)) * (1.f / 1024.f) + 1e-6f); }
  } }
  const int co = (lq ^ ((4 - ((l15 >> 2) & 3)) & 3)) * 16;
  int st = 0;
  for (int kt = 0; kt < nk; ++kt) {
    if (kt + 1 < nk) asm volatile("s_waitcnt vmcnt(6)" ::: "memory"); else asm volatile("s_waitcnt vmcnt(0)" ::: "memory");
    asm volatile("s_waitcnt lgkmcnt(0)" ::: "memory");
    __builtin_amdgcn_s_barrier();
    if (kt + 2 < nk) { const int s2 = st >= 1 ? st - 1 : 2; G_DMA(kt + 2, s2) }
    {
      const char* sbase = smem + st * G_ST;
      const char* pB = sbase + (wm * 64 + l15) * 64 + co;
      const char* pA = sbase + 8192 + (wn * 128 + l15) * 64 + co;
      bf16x8 fb[4], fa[8];
#pragma unroll
      for (int mi = 0; mi < 4; ++mi) fb[mi] = *(const bf16x8*)(pB + mi * 16 * 64);
#pragma unroll
      for (int ni = 0; ni < 8; ++ni) fa[ni] = *(const bf16x8*)(pA + ni * 16 * 64);
      __builtin_amdgcn_sched_barrier(0);
#pragma unroll
      for (int ni = 0; ni < 8; ++ni)
#pragma unroll
        for (int mi = 0; mi < 4; ++mi) acc[ni][mi] = MFMA16(fa[ni], fb[mi], acc[ni][mi]);
      __builtin_amdgcn_sched_barrier(0);
    }
    st = st == 2 ? 0 : st + 1;
  }
  if constexpr (EP::kTileEpi) {
    ep.tile(acc, rsv, m0, n0, N, smem);
  } else {
#pragma unroll
  for (int ni = 0; ni < 8; ++ni)
#pragma unroll
    for (int mi = 0; mi < 4; ++mi) {
      const int m = m0 + wm * 64 + mi * 16 + l15, n = n0 + wn * 128 + ni * 16 + 4 * lq;
      ep(m, n, acc[ni][mi][0], acc[ni][mi][1], acc[ni][mi][2], acc[ni][mi][3]);
    }
  }
}

DI void norm_row_bf16(const float* __restrict__ x, const float* __restrict__ g, u16* __restrict__ dst, int lane) {
  float4 v[4]; float ss = 0.f;
#pragma unroll
  for (int k = 0; k < 4; ++k) { v[k] = ((const float4*)x)[k * 64 + lane]; ss += v[k].x * v[k].x + v[k].y * v[k].y + v[k].z * v[k].z + v[k].w * v[k].w; }
  ss = wave_sum(ss);
  float r = rsqrtf(ss * (1.f / 1024.f) + 1e-6f);
#pragma unroll
  for (int k = 0; k < 4; ++k) {
    float4 gg = ((const float4*)g)[k * 64 + lane];
    ((v2u*)dst)[k * 64 + lane] = mk2(pk2(v[k].x * r * gg.x, v[k].y * r * gg.y), pk2(v[k].z * r * gg.z, v[k].w * r * gg.w));
  }
}
DI void norm_row_f32(float* __restrict__ x, const float* __restrict__ g, int lane) {
  float4 v[4]; float ss = 0.f;
#pragma unroll
  for (int k = 0; k < 4; ++k) { v[k] = ((const float4*)x)[k * 64 + lane]; ss += v[k].x * v[k].x + v[k].y * v[k].y + v[k].z * v[k].z + v[k].w * v[k].w; }
  ss = wave_sum(ss);
  float r = rsqrtf(ss * (1.f / 1024.f) + 1e-6f);
#pragma unroll
  for (int k = 0; k < 4; ++k) {
    float4 gg = ((const float4*)g)[k * 64 + lane];
    ((float4*)x)[k * 64 + lane] = make_float4(v[k].x * r * gg.x, v[k].y * r * gg.y, v[k].z * r * gg.z, v[k].w * r * gg.w);
  }
}


DI void prep_row_x(const float* __restrict__ x, u16* __restrict__ xb, float* __restrict__ ssq, int lane) {
#pragma unroll
  for (int k = 0; k < 4; ++k) {
    const float4 v = ((const float4*)x)[k * 64 + lane];
    ((v2u*)xb)[k * 64 + lane] = mk2(pk2(v.x, v.y), pk2(v.z, v.w));
    float ss = v.x * v.x + v.y * v.y + v.z * v.z + v.w * v.w;
#pragma unroll
    for (int o = 16; o >= 1; o >>= 1) ss += __shfl_xor(ss, o);
    if ((lane & 31) == 0) ssq[2 * k + (lane >> 5)] = ss;
  }
}

struct Job { int in_idx; unsigned src_off; unsigned long long dst_off; int K, N, perm, g_idx, g_off; };
__constant__ Job g_jobs[25] = {
  {15, 0u, OFF_WFI, 1024, 5504, 1, 2, 0},
  {15, 1024u * 5504u, OFF_WFI + 1ull * 5504 * 1024 * 2, 1024, 5504, 1, 2, 1024},
  {15, 2u * 1024u * 5504u, OFF_WFI + 2ull * 5504 * 1024 * 2, 1024, 5504, 1, 2, 2048},
  {15, 3u * 1024u * 5504u, OFF_WFI + 3ull * 5504 * 1024 * 2, 1024, 5504, 1, 2, 3072},
  {18, 0u, OFF_WFO, 2752, 1024, 0, -1, 0},
  {18, 2752u * 1024u, OFF_WFO + 1ull * 1024 * 2752 * 2, 2752, 1024, 0, -1, 0},
  {18, 2u * 2752u * 1024u, OFF_WFO + 2ull * 1024 * 2752 * 2, 2752, 1024, 0, -1, 0},
  {18, 3u * 2752u * 1024u, OFF_WFO + 3ull * 1024 * 2752 * 2, 2752, 1024, 0, -1, 0},
  {3, 0u, OFF_WNI, 1024, 2608, 0, 1, 0},
  {3, 1024u * 2608u, OFF_WNI + 2608ull * 1024 * 2, 1024, 2608, 0, 1, 1024},
  {4, 0u, OFF_WNO, 1024, 1024, 0, -1, 0},
  {4, 1024u * 1024u, OFF_WNO + 1024ull * 1024 * 2, 1024, 1024, 0, -1, 0},
  {6, 0u, OFF_WP1, 2048, 256, 0, -1, 0},
  {6, 2048u * 256u, OFF_WP1 + 1ull * 256 * 2048 * 2, 2048, 256, 0, -1, 0},
  {6, 2u * 2048u * 256u, OFF_WP1 + 2ull * 256 * 2048 * 2, 2048, 256, 0, -1, 0},
  {6, 3u * 2048u * 256u, OFF_WP1 + 3ull * 256 * 2048 * 2, 2048, 256, 0, -1, 0},
  {8, 0u, OFF_WP2, 256, 64, 0, -1, 0},
  {8, 256u * 64u, OFF_WP2 + 1ull * 64 * 256 * 2, 256, 64, 0, -1, 0},
  {8, 2u * 256u * 64u, OFF_WP2 + 2ull * 64 * 256 * 2, 256, 64, 0, -1, 0},
  {8, 3u * 256u * 64u, OFF_WP2 + 3ull * 64 * 256 * 2, 256, 64, 0, -1, 0},
  {10, 0u, OFF_WKV, 1024, 2048, 0, 9, 0},
  {11, 0u, OFF_WDQ, 1024, 1024, 0, 1, 2048},
  {11, 1024u * 1024u, OFF_WDQ + 1024ull * 1024 * 2, 1024, 1024, 0, 1, 3072},
  {14, 0u, OFF_WDO, 1024, 1024, 0, -1, 0},
  {14, 1024u * 1024u, OFF_WDO + 1024ull * 1024 * 2, 1024, 1024, 0, -1, 0},
};
constexpr int N_TR_TILES = 2 * 656 + 2 * 256 + 4 * 128 + 4 * 4 + 512 + 2 * 256 + 2 * 256 + 4 * 1376 + 4 * 688;

DI void transpose_tile(const Params& p, size_t z, int tile, char* smem, int& j, int& base) {
  for (;;) { int nt = (g_jobs[j].K >> 6) * ((g_jobs[j].N + 63) >> 6); if (tile < base + nt) break; base += nt; ++j; }
  const Job jb = g_jobs[j];
  const float* src = p.in[jb.in_idx] + jb.src_off + z;
  u16* dst = (u16*)(p.ws + jb.dst_off + z);
  const int K = jb.K, N = jb.N;
  const int lt = tile - base, ntn = (N + 63) >> 6;
  const int k0 = (lt / ntn) * 64, n0 = (lt % ntn) * 64;
  float* t = (float*)smem;
  const int tid = get_tid();
  __syncthreads();
  {
    const int n4 = (tid & 15) * 4, kq = tid >> 4;
    const bool ok = (n0 + n4) < N;
    float4 v[4];
#pragma unroll
    for (int i = 0; i < 4; ++i) v[i] = ok ? *(const float4*)(src + (size_t)(k0 + kq + 16 * i) * N + n0 + n4) : make_float4(0.f, 0.f, 0.f, 0.f);
#pragma unroll
    for (int i = 0; i < 4; ++i) { float* tp = t + (kq + 16 * i) * 65 + n4; tp[0] = v[i].x; tp[1] = v[i].y; tp[2] = v[i].z; tp[3] = v[i].w; }
  }
  __syncthreads();
#pragma unroll
  for (int i = 0; i < 2; ++i) {
    int c = tid & 7, n = (tid >> 3) + 32 * i;
    if (n0 + n < N) {
      float f[8];
#pragma unroll
      for (int e = 0; e < 8; ++e) f[e] = t[(c * 8 + e) * 65 + n];
      if (jb.g_idx >= 0) {
        const float* gp = p.in[jb.g_idx] + jb.g_off + z + k0 + c * 8;
#pragma unroll
        for (int e = 0; e < 8; ++e) f[e] *= gp[e];
      }
      int nrow = n0 + n;
      if (jb.perm) { int c0 = n0 >= FF ? n0 - FF : n0; nrow = (c0 >> 6) * 128 + (n0 >= FF ? 64 : 0) + n; }
      *(v4u*)(dst + (size_t)nrow * K + k0 + c * 8) = pack8(f);
    }
  }
}

DI void pack_k_task(const u16* __restrict__ src, int ld, int col0, int NH, u16* __restrict__ dst, const float* __restrict__ rope, int task) {
  int t = task & (S_ - 1); int rest = task >> 13; int hs = rest % NH; int b = rest / NH;
  const u16* row = src + (size_t)(b * S_ + t) * ld + col0 + hs * 64;
  v4u c[8];
#pragma unroll
  for (int i = 0; i < 8; ++i) c[i] = *(const v4u*)(row + 8 * i);
  float x1[8], x2[8], o1[8], o2[8];
  unpack8(c[0], x1); unpack8(c[1], x2);
  const float* rt = rope + (size_t)t * 16;
#pragma unroll
  for (int i = 0; i < 8; ++i) { float cs = rt[i], sn = rt[8 + i]; o1[i] = x1[i] * cs - x2[i] * sn; o2[i] = x2[i] * cs + x1[i] * sn; }
  c[0] = pack8(o1); c[1] = pack8(o2);
  u16* d = dst + (size_t)(b * NH + hs) * S_ * 64;
#pragma unroll
  for (int i = 0; i < 8; ++i) *(v4u*)(d + kfrag_chunk(t, i)) = c[i];
}
template <int NDVT>
DI void pack_v_task(const u16* __restrict__ src, int ld, int col0, int NH, u16* __restrict__ dst, int task) {
  int ln = task & 63; int s = (task >> 6) & 3; int rest = task >> 8; int dvt = rest % NDVT; rest /= NDVT; int tile = rest & 127; rest >>= 7; int hs = rest % NH; int b = rest / NH;
  int h = ln >> 5, dv = dvt * 32 + (ln & 31);
  const u16* base = src + (size_t)(b * S_ + tile * 64 + 16 * s + 4 * h) * ld + col0 + hs * (32 * NDVT) + dv;
  u16 v[8];
#pragma unroll
  for (int j = 0; j < 8; ++j) { int kk = 8 * (j >> 2) + (j & 3); v[j] = base[(size_t)kk * ld]; }
  v4u o = mk4(v[0] | ((unsigned)v[1] << 16), v[2] | ((unsigned)v[3] << 16), v[4] | ((unsigned)v[5] << 16), v[6] | ((unsigned)v[7] << 16));
  u16* d = dst + (size_t)(b * NH + hs) * S_ * (32 * NDVT);
  *(v4u*)(d + ((size_t)(((tile * NDVT + dvt) * 4 + s) * 64 + ln)) * 8) = o;
}

DI bf16x8 rope_q(const u16* __restrict__ qrow, const float* __restrict__ rt, int h) {
  v4u a = *(const v4u*)qrow, b = *(const v4u*)(qrow + 8);
  float x1[8], x2[8], o[8];
  unpack8(a, x1); unpack8(b, x2);
#pragma unroll
  for (int i = 0; i < 8; ++i) { float cs = rt[i], sn = rt[8 + i]; o[i] = h == 0 ? (x1[i] * cs - x2[i] * sn) : (x2[i] * cs + x1[i] * sn); }
  v4u r = pack8(o);
  return __builtin_bit_cast(bf16x8, r);
}

template <int NDVT, int MODE>
DI void attn_stream(const u16* __restrict__ Kf, const u16* __restrict__ Vf, int tb, int te, const unsigned* umask,
                    const bf16x8 (&q)[4], f32x16 (&O)[NDVT], float& m, float& l, int t, int tmin, int tmax, const unsigned* selw, char* lds) {
  constexpr int NCH = 2 + NDVT;
  constexpr int TILE_B = NCH * 4096;
  const int tid = get_tid(), lane = tid & 63, h = lane >> 5;
  v4u pre[NCH];
#define ATT_VALID(i_) (MODE != 2 || ((umask[(i_) >> 5] >> ((i_) & 31)) & 1u))
#define ATT_GLOAD(i_)                                                                                   \
  {                                                                                                     \
    const u16* kp = Kf + (size_t)(i_) * 4096;                                                           \
    const u16* vp = Vf + (size_t)(i_) * (2048 * NDVT);                                                  \
    _Pragma("unroll") for (int c = 0; c < 2; ++c) pre[c] = *(const v4u*)(kp + (c * 256 + tid) * 8);   \
    _Pragma("unroll") for (int c = 0; c < NDVT; ++c) pre[2 + c] = *(const v4u*)(vp + (c * 256 + tid) * 8); \
  }
  int i = tb;
  while (i < te && !ATT_VALID(i)) ++i;
  __syncthreads();
  if (i < te) ATT_GLOAD(i)
  int buf = 0;
  while (i < te) {
    char* tl = lds + buf * TILE_B;
#pragma unroll
    for (int c = 0; c < NCH; ++c) *(v4u*)(tl + (c * 256 + tid) * 16) = pre[c];
    __syncthreads();
    int nx = i + 1;
    while (nx < te && !ATT_VALID(nx)) ++nx;
    if (nx < te) ATT_GLOAD(nx)
    bool tok_ok = true;
    if (MODE == 2) tok_ok = (selw[i >> 5] >> (i & 31)) & 1u;
    if (MODE != 2 || __any(tok_ok)) {
    f32x16 S0, S1;
#pragma unroll
    for (int e = 0; e < 16; ++e) { S0[e] = 0.f; S1[e] = 0.f; }
    bf16x8 kf[8];
#pragma unroll
    for (int j = 0; j < 8; ++j) kf[j] = *(const bf16x8*)(tl + (j * 64 + lane) * 16);
    __builtin_amdgcn_sched_barrier(0);
#pragma unroll
    for (int s = 0; s < 4; ++s) { S0 = MFMA(kf[s], q[s], S0); S1 = MFMA(kf[4 + s], q[s], S1); }
    __builtin_amdgcn_sched_barrier(0);
    bf16x8 vf[8];
#pragma unroll
    for (int j = 0; j < 8; ++j) vf[j] = *(const bf16x8*)(tl + 8192 + (j * 64 + lane) * 16);
    __builtin_amdgcn_sched_barrier(0);
    bool full = (i * 64 + 63 <= tmin);
    if (MODE == 1) full = full && (i * 64 > tmax - 512);
    if (!full) {
      const int kb = i * 64 + 4 * h;
#pragma unroll
      for (int e = 0; e < 16; ++e) {
        int k0 = kb + 8 * (e >> 2) + (e & 3), k1 = k0 + 32;
        bool v0 = (k0 <= t), v1 = (k1 <= t);
        if (MODE == 1) { v0 = v0 && (k0 > t - 512); v1 = v1 && (k1 > t - 512); }
        S0[e] = v0 ? S0[e] : -INFINITY; S1[e] = v1 ? S1[e] : -INFINITY;
      }
    }
    float mx = fmaxf(S0[0], S1[0]);
#pragma unroll
    for (int e = 1; e < 16; ++e) mx = fmaxf(mx, fmaxf(S0[e], S1[e]));
    if (MODE == 2) mx = tok_ok ? mx : -INFINITY;
    mx = fmaxf(mx, __shfl_xor(mx, 32));
    float mnew = fmaxf(m, mx);
    if (__any(mnew > m)) {
      float f = __builtin_amdgcn_exp2f((m - mnew) * SC);
      l *= f;
#pragma unroll
      for (int d = 0; d < NDVT; ++d)
#pragma unroll
        for (int e = 0; e < 16; ++e) O[d][e] *= f;
    }
    m = mnew;
    const float nb = (MODE == 2 && !tok_ok) ? -INFINITY : -(m * SC);
    float ls = 0.f;
#pragma unroll
    for (int e = 0; e < 16; ++e) {
      S0[e] = __builtin_amdgcn_exp2f(fmaf(S0[e], SC, nb));
      S1[e] = __builtin_amdgcn_exp2f(fmaf(S1[e], SC, nb));
      ls += S0[e] + S1[e];
    }
    l += ls;
    bf16x8 pf[4];
    pf[0] = pack_frag(S0, 0); pf[1] = pack_frag(S0, 1); pf[2] = pack_frag(S1, 0); pf[3] = pack_frag(S1, 1);
    if constexpr (NDVT == 4) {
      bf16x8 vg[8];
#pragma unroll
      for (int j = 0; j < 8; ++j) vg[j] = *(const bf16x8*)(tl + 8192 + ((8 + j) * 64 + lane) * 16);
      __builtin_amdgcn_sched_barrier(0);
#pragma unroll
      for (int d = 0; d < 2; ++d)
#pragma unroll
        for (int s = 0; s < 4; ++s) O[d] = MFMA(vf[d * 4 + s], pf[s], O[d]);
#pragma unroll
      for (int d = 0; d < 2; ++d)
#pragma unroll
        for (int s = 0; s < 4; ++s) O[2 + d] = MFMA(vg[d * 4 + s], pf[s], O[2 + d]);
    } else {
#pragma unroll
      for (int d = 0; d < 2; ++d)
#pragma unroll
        for (int s = 0; s < 4; ++s) O[d] = MFMA(vf[d * 4 + s], pf[s], O[d]);
    }
    __builtin_amdgcn_sched_barrier(0);
    }
    i = nx; buf ^= 1;
  }
}

constexpr int LDS_IMP = 32768, LDS_SELW = 49152, LDS_UMASK = 49152 + 512;
DI void nsa_attn_item(const Params& p, int item, char* smem) {
  const int tid = get_tid(), lane = tid & 63, w = tid >> 6, n = lane & 31, h = lane >> 5;
  const int bh = item & 7, qt = 255 - (item >> 3), b = bh >> 2, hk = bh & 3, t0 = qt * 32, cur = t0 >> 6;
  const int tokl = w * 8 + (n >> 2), g = n & 3, t = t0 + tokl, head = hk * 4 + g;
  const int twmin = t0 + __builtin_amdgcn_readfirstlane(w) * 8;
  const size_t R = (size_t)b * S_ + t;
  const u16* proj = (const u16*)(p.ws + OFF_PROJ);
  const float* rope = (const float*)(p.ws + OFF_ROPE);
  const u16* qrow = proj + R * LDP + head * 64;
  bf16x8 q[4], qr0;
#pragma unroll
  for (int s = 0; s < 4; ++s) q[s] = *(const bf16x8*)(qrow + 16 * s + 8 * h);
  qr0 = rope_q(qrow, rope + (size_t)t * 16, h);
  float gate[3];
#pragma unroll
  for (int j = 0; j < 3; ++j) { float x = bf1(proj[R * LDP + 2560 + head * 3 + j]); gate[j] = 1.f / (1.f + __expf(-x)); }
  float* imp = (float*)(smem + LDS_IMP) + w * 1024;
  unsigned* selw_all = (unsigned*)(smem + LDS_SELW);
  unsigned* umask = (unsigned*)(smem + LDS_UMASK);
  __syncthreads();
#pragma unroll
  for (int i = 0; i < 16; ++i) imp[i * 64 + lane] = 0.f;
  if (tid < 4) umask[tid] = 0u;
  __syncthreads();

  f32x16 Ot[2], Ob[2];
  {
    const int ncmax = (t0 >> 4) + 1;
    const int ntile = (ncmax + 63) >> 6;
    const u16* Kc = (const u16*)(p.ws + OFF_KCF) + (size_t)(b * 4 + hk) * 512 * 64;
    const u16* Vc = (const u16*)(p.ws + OFF_VCF) + (size_t)(b * 4 + hk) * 512 * 64;
    float m = -1e30f, l = 0.f;
    bf16x8 kc[8], kn[8];
#pragma unroll
    for (int j = 0; j < 8; ++j) kc[j] = *(const bf16x8*)(Kc + (j * 64 + lane) * 8);
    for (int i = 0; i < ntile; ++i) {
      const int inx = i + 1 < ntile ? i + 1 : i;
#pragma unroll
      for (int j = 0; j < 8; ++j) kn[j] = *(const bf16x8*)(Kc + (size_t)inx * 4096 + (j * 64 + lane) * 8);
      f32x16 S0, S1;
#pragma unroll
      for (int e = 0; e < 16; ++e) { S0[e] = 0.f; S1[e] = 0.f; }
#pragma unroll
      for (int s = 0; s < 4; ++s) { S0 = MFMA(kc[s], q[s], S0); S1 = MFMA(kc[4 + s], q[s], S1); }
#pragma unroll
      for (int j = 0; j < 8; ++j) kc[j] = kn[j];
      const int cb = i * 64 + 4 * h;
      float mx = -INFINITY;
#pragma unroll
      for (int e = 0; e < 16; ++e) {
        int c0 = cb + 8 * (e >> 2) + (e & 3), c1 = c0 + 32;
        S0[e] = (16 * c0 + 31 <= t) ? S0[e] : -INFINITY; S1[e] = (16 * c1 + 31 <= t) ? S1[e] : -INFINITY;
        mx = fmaxf(mx, fmaxf(S0[e], S1[e]));
      }
      mx = fmaxf(mx, __shfl_xor(mx, 32));
      float mnew = fmaxf(m, mx);
      l *= __builtin_amdgcn_exp2f((m - mnew) * SC);
      m = mnew;
      const float msc = m * SC;
      float ls = 0.f;
#pragma unroll
      for (int e = 0; e < 16; ++e) ls += __builtin_amdgcn_exp2f(fmaf(S0[e], SC, -msc)) + __builtin_amdgcn_exp2f(fmaf(S1[e], SC, -msc));
      l += ls;
    }
    l += __shfl_xor(l, 32);
    const float invl = l > 0.f ? 1.f / l : 0.f;
    const float msc = m * SC;
#pragma unroll
    for (int d = 0; d < 2; ++d)
#pragma unroll
      for (int e = 0; e < 16; ++e) Ob[d][e] = 0.f;
    float* impt = imp + (n >> 2) * 128;
#pragma unroll
    for (int j = 0; j < 8; ++j) kc[j] = *(const bf16x8*)(Kc + (j * 64 + lane) * 8);
    for (int i = 0; i < ntile; ++i) {
      const int inx = i + 1 < ntile ? i + 1 : i;
      bf16x8 vc[8];
#pragma unroll
      for (int j = 0; j < 8; ++j) vc[j] = *(const bf16x8*)(Vc + (size_t)i * 4096 + (j * 64 + lane) * 8);
#pragma unroll
      for (int j = 0; j < 8; ++j) kn[j] = *(const bf16x8*)(Kc + (size_t)inx * 4096 + (j * 64 + lane) * 8);
      f32x16 S0, S1;
#pragma unroll
      for (int e = 0; e < 16; ++e) { S0[e] = 0.f; S1[e] = 0.f; }
#pragma unroll
      for (int s = 0; s < 4; ++s) { S0 = MFMA(kc[s], q[s], S0); S1 = MFMA(kc[4 + s], q[s], S1); }
#pragma unroll
      for (int j = 0; j < 8; ++j) kc[j] = kn[j];
      const int cb = i * 64 + 4 * h;
#pragma unroll
      for (int e = 0; e < 16; ++e) {
        int c0 = cb + 8 * (e >> 2) + (e & 3), c1 = c0 + 32;
        S0[e] = (16 * c0 + 31 <= t) ? __builtin_amdgcn_exp2f(fmaf(S0[e], SC, -msc)) * invl : 0.f;
        S1[e] = (16 * c1 + 31 <= t) ? __builtin_amdgcn_exp2f(fmaf(S1[e], SC, -msc)) * invl : 0.f;
      }
#pragma unroll
      for (int rt = 0; rt < 2; ++rt)
#pragma unroll
        for (int r = 0; r < 4; ++r) {
          float a0 = rt == 0 ? S0[4 * r] : S1[4 * r], a1 = rt == 0 ? S0[4 * r + 1] : S1[4 * r + 1];
          float a2 = rt == 0 ? S0[4 * r + 2] : S1[4 * r + 2], a3 = rt == 0 ? S0[4 * r + 3] : S1[4 * r + 3];
          float A = (a0 + a1) + (a2 + a3), L = a3;
          A += __shfl_xor(A, 1); L += __shfl_xor(L, 1);
          A += __shfl_xor(A, 2); L += __shfl_xor(L, 2);
          int nb = i * 16 + rt * 8 + 2 * r + h;
          if (g == 0) { atomicAdd(&impt[nb], A); if (nb + 1 < 128) atomicAdd(&impt[nb + 1], L); }
        }
      bf16x8 pf[4];
      pf[0] = pack_frag(S0, 0); pf[1] = pack_frag(S0, 1); pf[2] = pack_frag(S1, 0); pf[3] = pack_frag(S1, 1);
#pragma unroll
      for (int d = 0; d < 2; ++d)
#pragma unroll
        for (int s = 0; s < 4; ++s) Ob[d] = MFMA(vc[d * 4 + s], pf[s], Ob[d]);
    }
#pragma unroll
    for (int d = 0; d < 2; ++d)
#pragma unroll
      for (int e = 0; e < 16; ++e) Ot[d][e] = gate[0] * Ob[d][e];
  }
  {
    const int hi = cur - 2;
    for (int tk = 0; tk < 8; ++tk) {
      const float* ip = imp + tk * 128;
      const int n0 = lane, n1 = lane + 64;
      bool s0, s1;
      if (hi > 13) {
        const unsigned k0 = (n0 >= 1 && n0 <= hi) ? (__float_as_uint(ip[n0]) + 1u) : 0u;
        const unsigned k1 = (n1 <= hi) ? (__float_as_uint(ip[n1]) + 1u) : 0u;
        unsigned prefix = 0u;
        for (int bit = 31; bit >= 0; --bit) {
          const unsigned trial = prefix | (1u << bit);
          const int cnt = __popcll(__ballot(k0 >= trial)) + __popcll(__ballot(k1 >= trial));
          if (cnt >= 13) prefix = trial;
        }
        const unsigned long long g0 = __ballot(k0 > prefix), g1 = __ballot(k1 > prefix);
        const unsigned long long e0 = __ballot(k0 == prefix), e1 = __ballot(k1 == prefix);
        const int extra = 13 - (__popcll(g0) + __popcll(g1));
        const unsigned long long below = (1ull << lane) - 1ull;
        const int r0 = __popcll(e0 & below), r1 = __popcll(e0) + __popcll(e1 & below);
        const bool t0 = (k0 > prefix) || (k0 == prefix && r0 < extra);
        const bool t1 = (k1 > prefix) || (k1 == prefix && r1 < extra);
        s0 = (n0 == 0) || (n0 <= cur && n0 >= cur - 1) || t0;
        s1 = (n1 <= cur && n1 >= cur - 1) || t1;
      } else { s0 = n0 <= cur; s1 = n1 <= cur; }
      unsigned long long b0 = __ballot(s0), b1 = __ballot(s1);
      if (lane == 0) {
        unsigned* sw = selw_all + (w * 8 + tk) * 4;
        sw[0] = (unsigned)b0; sw[1] = (unsigned)(b0 >> 32); sw[2] = (unsigned)b1; sw[3] = (unsigned)(b1 >> 32);
        atomicOr(&umask[0], (unsigned)b0); atomicOr(&umask[1], (unsigned)(b0 >> 32));
        atomicOr(&umask[2], (unsigned)b1); atomicOr(&umask[3], (unsigned)(b1 >> 32));
      }
    }
  }
  __syncthreads();
  bf16x8 qr[4] = {qr0, q[1], q[2], q[3]};
  {
    float m = -1e30f, l = 0.f;
#pragma unroll
    for (int d = 0; d < 2; ++d)
#pragma unroll
      for (int e = 0; e < 16; ++e) Ob[d][e] = 0.f;
    const u16* Kf = (const u16*)(p.ws + OFF_KSF) + (size_t)(b * 4 + hk) * S_ * 64;
    const u16* Vf = (const u16*)(p.ws + OFF_VSF) + (size_t)(b * 4 + hk) * S_ * 64;
    attn_stream<2, 2>(Kf, Vf, 0, cur + 1, umask, qr, Ob, m, l, t, twmin, twmin + 7, selw_all + tokl * 4, smem);
    l += __shfl_xor(l, 32);
    const float f = gate[1] / l;
#pragma unroll
    for (int d = 0; d < 2; ++d)
#pragma unroll
      for (int e = 0; e < 16; ++e) Ot[d][e] += f * Ob[d][e];
  }
  {
    float m = -1e30f, l = 0.f;
#pragma unroll
    for (int d = 0; d < 2; ++d)
#pragma unroll
      for (int e = 0; e < 16; ++e) Ob[d][e] = 0.f;
    const u16* Kf = (const u16*)(p.ws + OFF_KWF) + (size_t)(b * 4 + hk) * S_ * 64;
    const u16* Vf = (const u16*)(p.ws + OFF_VWF) + (size_t)(b * 4 + hk) * S_ * 64;
    int lo = t0 - 511; lo = lo < 0 ? 0 : lo;
    attn_stream<2, 1>(Kf, Vf, lo >> 6, ((t0 + 31) >> 6) + 1, nullptr, qr, Ob, m, l, t, twmin, twmin + 7, nullptr, smem);
    l += __shfl_xor(l, 32);
    const float f = gate[2] / l;
#pragma unroll
    for (int d = 0; d < 2; ++d)
#pragma unroll
      for (int e = 0; e < 16; ++e) Ot[d][e] += f * Ob[d][e];
  }
  u16* ao = (u16*)(p.ws + OFF_H) + R * D_ + head * 64;
#pragma unroll
  for (int d = 0; d < 2; ++d)
#pragma unroll
    for (int r = 0; r < 4; ++r)
      *(v2u*)(ao + d * 32 + 8 * r + 4 * h) = mk2(pk2(Ot[d][4 * r], Ot[d][4 * r + 1]), pk2(Ot[d][4 * r + 2], Ot[d][4 * r + 3]));
}

DI size_t kfrag16_chunk(int key, int c  ) { return ((size_t)((((key >> 6) * 8 + ((key >> 4) & 3) * 2 + (c >> 2)) * 64) + (c & 3) * 16 + (key & 15))) * 8; }
DI void pack_k16_task(const u16* __restrict__ src, int ld, int col0, int NH, u16* __restrict__ dst, const float* __restrict__ rope, int task) {
  int t = task & (S_ - 1); int rest = task >> 13; int hs = rest % NH; int b = rest / NH;
  const u16* row = src + (size_t)(b * S_ + t) * ld + col0 + hs * 64;
  v4u c[8];
#pragma unroll
  for (int i = 0; i < 8; ++i) c[i] = *(const v4u*)(row + 8 * i);
  float x1[8], x2[8], o1[8], o2[8];
  unpack8(c[0], x1); unpack8(c[1], x2);
  const float* rt = rope + (size_t)t * 16;
#pragma unroll
  for (int i = 0; i < 8; ++i) { float cs = rt[i], sn = rt[8 + i]; o1[i] = x1[i] * cs - x2[i] * sn; o2[i] = x2[i] * cs + x1[i] * sn; }
  c[0] = pack8(o1); c[1] = pack8(o2);
  u16* d = dst + (size_t)(b * NH + hs) * S_ * 64;
#pragma unroll
  for (int i = 0; i < 8; ++i) *(v4u*)(d + kfrag16_chunk(t, i)) = c[i];
}
DI void pack_v16_task(const u16* __restrict__ src, int ld, int col0, int NH, u16* __restrict__ dst, int task) {
  int ln = task & 63; int s = (task >> 6) & 1; int dvt = (task >> 7) & 7; int rest = task >> 10; int tile = rest & 127; rest >>= 7; int hs = rest % NH; int b = rest / NH;
  const int lq = ln >> 4, dv = dvt * 16 + (ln & 15);
  const u16* base = src + (size_t)(b * S_ + tile * 64 + 32 * s + 4 * lq) * ld + col0 + hs * 128 + dv;
  u16 v[8];
#pragma unroll
  for (int j = 0; j < 8; ++j) { int kk = 16 * (j >> 2) + (j & 3); v[j] = base[(size_t)kk * ld]; }
  v4u o = mk4(v[0] | ((unsigned)v[1] << 16), v[2] | ((unsigned)v[3] << 16), v[4] | ((unsigned)v[5] << 16), v[6] | ((unsigned)v[7] << 16));
  u16* d = dst + (size_t)(b * NH + hs) * S_ * 128;
  *(v4u*)(d + ((size_t)(((tile * 8 + dvt) * 2 + s) * 64 + ln)) * 8) = o;
}
DI bf16x8 pack2x4(const f32x4& a, const f32x4& b) {
  v4u r = mk4(pk2(a[0], a[1]), pk2(a[2], a[3]), pk2(b[0], b[1]), pk2(b[2], b[3]));
  return __builtin_bit_cast(bf16x8, r);
}
DI void diff_attn_item(const Params& p, int item, char* smem) {
  const int tid = get_tid(), lane = tid & 63, l15 = lane & 15, lq = lane >> 4;
  const int wv = __builtin_amdgcn_readfirstlane(tid >> 6);
  const int bhc = item & 31, qt = 63 - (item >> 5), b = bhc >> 4, hc = bhc & 15, t0 = qt * 128;
  const int twmin = t0 + wv * 32;
  const float* rope = (const float*)(p.ws + OFF_ROPE);
  int tq[2]; bf16x8 qf[2][2];
#pragma unroll
  for (int ct = 0; ct < 2; ++ct) {
    tq[ct] = twmin + ct * 16 + l15;
    const u16* qrow = (const u16*)(p.ws + OFF_Q) + ((size_t)b * S_ + tq[ct]) * D_ + hc * 64;
    qf[ct][1] = *(const bf16x8*)(qrow + 32 + lq * 8);
    bf16x8 raw = *(const bf16x8*)(qrow + lq * 8);
    bf16x8 rp = rope_q(qrow, rope + (size_t)tq[ct] * 16, lq & 1);
    qf[ct][0] = lq < 2 ? rp : raw;
  }
  f32x4 O[8][2];
#pragma unroll
  for (int d = 0; d < 8; ++d)
#pragma unroll
    for (int ct = 0; ct < 2; ++ct)
#pragma unroll
      for (int e = 0; e < 4; ++e) O[d][ct][e] = 0.f;
  float m[2] = {-1e30f, -1e30f}, l[2] = {0.f, 0.f};
  const u16* Kf = (const u16*)(p.ws + OFF_SKVK) + (size_t)(b * 16 + hc) * S_ * 64;
  const u16* Vf = (const u16*)(p.ws + OFF_SKVV) + (size_t)(b * 8 + (hc >> 1)) * S_ * 128;
  const int te = 2 * qt + 2;
  constexpr int TILE_B = 24576;
  v4u pre[6];
#define D16_GLOAD(i_)                                                                                  \
  { const u16* kp = Kf + (size_t)(i_) * 4096; const u16* vp = Vf + (size_t)(i_) * 8192;                 \
    _Pragma("unroll") for (int c = 0; c < 2; ++c) pre[c] = *(const v4u*)(kp + (c * 256 + tid) * 8);    \
    _Pragma("unroll") for (int c = 0; c < 4; ++c) pre[2 + c] = *(const v4u*)(vp + (c * 256 + tid) * 8); }
  __syncthreads();
  D16_GLOAD(0)
  int buf = 0;
  for (int i = 0; i < te; ++i) {
    char* tl = smem + buf * TILE_B;
#pragma unroll
    for (int c = 0; c < 6; ++c) *(v4u*)(tl + (c * 256 + tid) * 16) = pre[c];
    __syncthreads();
    if (i + 1 < te) D16_GLOAD(i + 1)
    f32x4 S[4][2];
#pragma unroll
    for (int rt = 0; rt < 4; ++rt)
#pragma unroll
      for (int ct = 0; ct < 2; ++ct)
#pragma unroll
        for (int e = 0; e < 4; ++e) S[rt][ct][e] = 0.f;
    bf16x8 kf[8];
#pragma unroll
    for (int f = 0; f < 8; ++f) kf[f] = *(const bf16x8*)(tl + (f * 64 + lane) * 16);
    __builtin_amdgcn_sched_barrier(0);
#pragma unroll
    for (int rt = 0; rt < 4; ++rt)
#pragma unroll
      for (int ks = 0; ks < 2; ++ks)
#pragma unroll
        for (int ct = 0; ct < 2; ++ct) S[rt][ct] = MFMA16(kf[rt * 2 + ks], qf[ct][ks], S[rt][ct]);
    __builtin_amdgcn_sched_barrier(0);
    bf16x8 vf[8];
#pragma unroll
    for (int f = 0; f < 8; ++f) vf[f] = *(const bf16x8*)(tl + 8192 + (f * 64 + lane) * 16);
    __builtin_amdgcn_sched_barrier(0);
    if (!(i * 64 + 63 <= twmin)) {
#pragma unroll
      for (int rt = 0; rt < 4; ++rt)
#pragma unroll
        for (int ct = 0; ct < 2; ++ct)
#pragma unroll
          for (int e = 0; e < 4; ++e) { const int key = i * 64 + rt * 16 + 4 * lq + e; S[rt][ct][e] = key <= tq[ct] ? S[rt][ct][e] : -INFINITY; }
    }
    float mn[2]; bool grow = false;
#pragma unroll
    for (int ct = 0; ct < 2; ++ct) {
      float mx = fmaxf(fmaxf(S[0][ct][0], S[0][ct][1]), fmaxf(S[0][ct][2], S[0][ct][3]));
#pragma unroll
      for (int rt = 1; rt < 4; ++rt) mx = fmaxf(mx, fmaxf(fmaxf(S[rt][ct][0], S[rt][ct][1]), fmaxf(S[rt][ct][2], S[rt][ct][3])));
      mx = fmaxf(mx, __shfl_xor(mx, 16));
      mx = fmaxf(mx, __shfl_xor(mx, 32));
      mn[ct] = fmaxf(m[ct], mx);
      grow = grow || (mn[ct] > m[ct]);
    }
    if (__any(grow)) {
#pragma unroll
      for (int ct = 0; ct < 2; ++ct) {
        const float f = __builtin_amdgcn_exp2f((m[ct] - mn[ct]) * SC);
        l[ct] *= f;
#pragma unroll
        for (int d = 0; d < 8; ++d)
#pragma unroll
          for (int e = 0; e < 4; ++e) O[d][ct][e] *= f;
      }
    }
    bf16x8 pf[2][2];
#pragma unroll
    for (int ct = 0; ct < 2; ++ct) {
      m[ct] = mn[ct];
      const float nb = -(m[ct] * SC);
      float ls = 0.f;
#pragma unroll
      for (int rt = 0; rt < 4; ++rt)
#pragma unroll
        for (int e = 0; e < 4; ++e) { S[rt][ct][e] = __builtin_amdgcn_exp2f(fmaf(S[rt][ct][e], SC, nb)); ls += S[rt][ct][e]; }
      l[ct] += ls;
      pf[0][ct] = pack2x4(S[0][ct], S[1][ct]);
      pf[1][ct] = pack2x4(S[2][ct], S[3][ct]);
    }
    bf16x8 vg[8];
#pragma unroll
    for (int f = 0; f < 8; ++f) vg[f] = *(const bf16x8*)(tl + 8192 + ((8 + f) * 64 + lane) * 16);
    __builtin_amdgcn_sched_barrier(0);
#pragma unroll
    for (int d = 0; d < 4; ++d)
#pragma unroll
      for (int s = 0; s < 2; ++s)
#pragma unroll
        for (int ct = 0; ct < 2; ++ct) O[d][ct] = MFMA16(vf[d * 2 + s], pf[s][ct], O[d][ct]);
#pragma unroll
    for (int d = 0; d < 4; ++d)
#pragma unroll
      for (int s = 0; s < 2; ++s)
#pragma unroll
        for (int ct = 0; ct < 2; ++ct) O[4 + d][ct] = MFMA16(vg[d * 2 + s], pf[s][ct], O[4 + d][ct]);
    __builtin_amdgcn_sched_barrier(0);
    buf ^= 1;
  }
#pragma unroll
  for (int ct = 0; ct < 2; ++ct) {
    float lt = l[ct];
    lt += __shfl_xor(lt, 16);
    lt += __shfl_xor(lt, 32);
    const float f = 1.f / lt;
    u16* op = (u16*)(p.ws + OFF_KVRAW) + (((size_t)b * S_ + tq[ct]) * 16 + hc) * 128;
#pragma unroll
    for (int d = 0; d < 8; ++d)
      *(v2u*)(op + d * 16 + 4 * lq) = mk2(pk2(O[d][ct][0] * f, O[d][ct][1] * f), pk2(O[d][ct][2] * f, O[d][ct][3] * f));
  }
}

DI void conv_task(const u16* __restrict__ u, u16* __restrict__ act, const float* __restrict__ cw, const float* __restrict__ cbias, int task) {
  const int ck = task % 344, rr = task / 344;
  const int j0 = ck * 8, ts = rr * 16;
  float wg[3][8], wv[3][8], bg[8], bv[8], g1[8], g2[8], v1[8], v2[8];
#pragma unroll
  for (int e = 0; e < 8; ++e) {
#pragma unroll
    for (int tp = 0; tp < 3; ++tp) { wg[tp][e] = cw[tp * FF2 + j0 + e]; wv[tp][e] = cw[tp * FF2 + FF + j0 + e]; }
    bg[e] = cbias[j0 + e]; bv[e] = cbias[FF + j0 + e];
    g1[e] = g2[e] = v1[e] = v2[e] = 0.f;
  }
  if (ts > 0) {
    unpack8(*(const v4u*)(u + (size_t)(ts - 1) * FF2 + j0), g1); unpack8(*(const v4u*)(u + (size_t)(ts - 1) * FF2 + FF + j0), v1);
    unpack8(*(const v4u*)(u + (size_t)(ts - 2) * FF2 + j0), g2); unpack8(*(const v4u*)(u + (size_t)(ts - 2) * FF2 + FF + j0), v2);
  }
#pragma unroll 4
  for (int r = 0; r < 16; ++r) {
    const int t = ts + r;
    float gc[8], vc[8], o[8];
    unpack8(*(const v4u*)(u + (size_t)t * FF2 + j0), gc); unpack8(*(const v4u*)(u + (size_t)t * FF2 + FF + j0), vc);
#pragma unroll
    for (int e = 0; e < 8; ++e) {
      float cgv = bg[e] + wg[0][e] * g2[e] + wg[1][e] * g1[e] + wg[2][e] * gc[e];
      float cvv = bv[e] + wv[0][e] * v2[e] + wv[1][e] * v1[e] + wv[2][e] * vc[e];
      o[e] = cgv / (1.f + __expf(-cgv)) * cvv;
      g2[e] = g1[e]; g1[e] = gc[e]; v2[e] = v1[e]; v1[e] = vc[e];
    }
    *(v4u*)(act + (size_t)t * FF + j0) = pack8(o);
  }
}

DI void diff_comb_row(const Params& p, int j, int layer, int row, int lane) {
  const float* lv = p.in[12] + j * 256;
  float sa = wave_sum(lv[lane] * lv[64 + lane]), sb = wave_sum(lv[128 + lane] * lv[192 + lane]);
  const float lam_init = 0.8f - 0.6f * expf(-0.3f * (float)layer);
  const float lam = expf(sa) - expf(sb) + lam_init;
  const int head = lane >> 3, part = lane & 7;
  const u16* o0 = (const u16*)(p.ws + OFF_KVRAW) + ((size_t)row * 16 + head * 2) * 128 + part * 16;
  const u16* o1 = o0 + 128;
  float a[16], bb[16];
  unpack8(*(const v4u*)o0, a); unpack8(*(const v4u*)(o0 + 8), a + 8);
  unpack8(*(const v4u*)o1, bb); unpack8(*(const v4u*)(o1 + 8), bb + 8);
  float ss = 0.f;
#pragma unroll
  for (int e = 0; e < 16; ++e) { a[e] = a[e] - lam * bb[e]; ss += a[e] * a[e]; }
  ss += __shfl_xor(ss, 1); ss += __shfl_xor(ss, 2); ss += __shfl_xor(ss, 4);
  const float r = rsqrtf(ss * (1.f / 128.f) + 1e-6f) * (1.f - lam_init);
  const float* sg = p.in[13] + j * 128 + part * 16;
#pragma unroll
  for (int e = 0; e < 16; ++e) a[e] = a[e] * r * sg[e];
  u16* dst = (u16*)(p.ws + OFF_H) + (size_t)row * D_ + head * 128 + part * 16;
  *(v4u*)dst = pack8(a); *(v4u*)(dst + 8) = pack8(a + 8);
}


#define XB_TMO      128
#define XB_XCNT(j)  (256  + 64 * (j))
#define XB_XSUB(j)  (1280 + 64 * (j))
#define XB_XGEN(j)  (2304 + 64 * (j))
#define XB_TOP      3328
#define XB_TOPGEN   3392
#define XCD_BAR_WORDS 3456
#define XB_SPIN_CAP (1u << 24)
#define LAS __attribute__((address_space(3)))
DI unsigned xb_ld(unsigned* p)              { return __hip_atomic_load(p, __ATOMIC_RELAXED, __HIP_MEMORY_SCOPE_AGENT); }
DI unsigned xb_add(unsigned* p, unsigned v) { return __hip_atomic_fetch_add(p, v, __ATOMIC_RELAXED, __HIP_MEMORY_SCOPE_AGENT); }
DI unsigned xb_xcc_id() { return (unsigned)__builtin_amdgcn_s_getreg((3 << 11) | 20) & 0xFu; }
#define XB_SPIN(cond, bar) do { unsigned _sp = 0; while (cond) { __builtin_amdgcn_s_sleep(1); \
    if ((++_sp & 255u) == 0u) { if (xb_ld(&(bar)[XB_TMO])) break; if (_sp > XB_SPIN_CAP) { atomicAdd(&(bar)[XB_TMO], 1u); break; } } } } while (0)
struct XcdBarrier { unsigned* bar; unsigned x; volatile LAS unsigned* st; };
DI XcdBarrier xcd_barrier_post(unsigned* bar, volatile LAS unsigned* st) {
  XcdBarrier b; b.bar = bar; b.x = xb_xcc_id(); b.st = st;
  if (__builtin_amdgcn_workitem_id_x() == 0) (void)xb_add(&bar[XB_XCNT(b.x)], 1u);
  return b;
}
DI void xcd_barrier_complete(unsigned* bar, unsigned x, unsigned& nloc, unsigned& nx) {
  const unsigned G = gridDim.x * gridDim.y * gridDim.z;
  unsigned sum, cnt, mine, sp = 0u;
  for (;;) {
    sum = 0u; cnt = 0u; mine = 0u;
#pragma unroll
    for (unsigned j = 0; j < 16; ++j) { const unsigned c = xb_ld(&bar[XB_XCNT(j)]); sum += c; cnt += (c > 0u) ? 1u : 0u; mine = (j == x) ? c : mine; }
    if (sum == G) break;
    __builtin_amdgcn_s_sleep(1);
    if ((++sp & 255u) == 0u) { if (xb_ld(&bar[XB_TMO])) break; if (sp > XB_SPIN_CAP) { atomicAdd(&bar[XB_TMO], 1u); break; } }
  }
  nloc = mine > 0u ? mine : 1u; nx = cnt > 0u ? cnt : 1u;
}
DI void xcd_barrier(const XcdBarrier& b) {
  asm volatile("s_waitcnt vmcnt(0)" ::: "memory");
  __syncthreads();
  if (__builtin_amdgcn_workitem_id_x() == 0) {
    unsigned* bar = b.bar;
    __builtin_amdgcn_s_waitcnt(0);
    unsigned nloc = b.st[0], nx = b.st[1];
    if (nloc == 0u) { xcd_barrier_complete(bar, b.x, nloc, nx); b.st[0] = nloc; b.st[1] = nx; }
    const unsigned old = xb_add(&bar[XB_XSUB(b.x)], 1u);
    const unsigned gen = old / nloc;
    if (old + 1u == (gen + 1u) * nloc) {
      __builtin_amdgcn_fence(__ATOMIC_RELEASE, "agent");
      asm volatile("s_waitcnt vmcnt(0)" ::: "memory");
      const unsigned og = xb_add(&bar[XB_TOP], 1u);
      const unsigned tg = og / nx;
      if (og + 1u == (tg + 1u) * nx) xb_add(&bar[XB_TOPGEN], 1u);
      else XB_SPIN(xb_ld(&bar[XB_TOPGEN]) == tg, bar);
      __builtin_amdgcn_fence(__ATOMIC_ACQUIRE, "agent");
      xb_add(&bar[XB_XGEN(b.x)], 1u);
      asm volatile("s_waitcnt vmcnt(0)" ::: "memory");
    } else {
      XB_SPIN(xb_ld(&bar[XB_XGEN(b.x)]) == gen, bar);
      __builtin_amdgcn_fence(__ATOMIC_ACQUIRE, "agent");
      asm volatile("s_waitcnt vmcnt(0)" ::: "memory");
    }
  }
  __syncthreads();
}

DI bool xcd_tile(int bid, int round, int G, int MT, int NT, int& tm, int& tn) {
  const int mx = MT >> 3, q = (bid >> 3) + (G >> 3) * round;
  if (q >= mx * NT) return false;
  tm = (bid & 7) * mx + q % mx; tn = q / mx;
  return true;
}
DI int snake(int r, int G, int j) { return r * G + ((r & 1) ? (G - 1 - j) : j); }

DI void run_step(const Params& pk, const Step st, char* smem) {
  const int G = gridDim.x, bid = get_bid(), tid = get_tid(), lane = tid & 63, wave = tid >> 6;
  const int L = st.layer;
  size_t z = 0;
  asm volatile("" : "+s"(z));
  Params p;
#pragma unroll
  for (int i = 0; i < 20; ++i) p.in[i] = pk.in[i] + z;
  p.out = pk.out + z;
  p.ws = pk.ws + z;
  char* ws = p.ws;
  float* xcur = p.out;
  switch (st.op) {
  case OP_PREP: {
    const int n_rope = 256, n_cb = 32, n_norm = 4096;
    const int total = N_TR_TILES + n_rope + n_cb + n_norm;
    int tj = 0, tbase = 0;
    for (int w = bid; w < total; w += G) {
      if (w < N_TR_TILES) { transpose_tile(pk, z, w, smem, tj, tbase); continue; }
      int k = w - N_TR_TILES;
      if (k < n_rope) {
        int idx = k * 256 + tid; int t = idx >> 3, i = idx & 7;
        float inv = powf(500000.f, -(float)i / 8.f);
        float ang = (float)t * inv;
        float* rp = (float*)(ws + OFF_ROPE) + (size_t)t * 16;
        rp[i] = cosf(ang); rp[8 + i] = sinf(ang);
        continue;
      }
      k -= n_rope;
      if (k < n_cb) {
        int lkv = k >> 3, j0 = (k & 7) * 32;
        int jj = tid & 31, kg = tid >> 5;
        const float* pe = p.in[5] + lkv * 2048;
        const float* w1 = p.in[6] + (size_t)lkv * 2048 * 256;
        float s = 0.f;
        for (int kk = kg * 256; kk < kg * 256 + 256; ++kk) s += pe[kk] * w1[(size_t)kk * 256 + j0 + jj];
        float* part = (float*)smem;
        __syncthreads();
        part[tid] = s;
        __syncthreads();
        if (tid < 32) { float a = p.in[7][lkv * 256 + j0 + tid]; for (int q = 0; q < 8; ++q) a += part[q * 32 + tid]; ((float*)(ws + OFF_CB))[lkv * 256 + j0 + tid] = a; }
        continue;
      }
      k -= n_cb;
      { int row = k * 4 + wave; prep_row_x(p.in[0] + (size_t)row * D_, (u16*)(ws + OFF_XB) + (size_t)row * D_, (float*)(ws + OFF_SSQ) + (size_t)row * 8, lane); }
    }
  } break;
  case OP_NORM: {
    const float* g = (st.aux ? p.in[2] : p.in[1]) + L * D_;
    for (int k = bid; k < 4096; k += G) { int row = k * 4 + wave; norm_row_bf16(xcur + (size_t)row * D_, g, (u16*)(ws + OFF_H) + (size_t)row * D_, lane); }
  } break;
  case OP_FINAL: {
    const u16* xbp = (const u16*)(ws + OFF_XB);
    for (int k = bid; k < 4096; k += 2 * G) {
      const int k2 = k + G;
      const size_t ra_ = (size_t)(k * 4 + wave) * D_, rc_ = (size_t)((k2 < 4096 ? k2 : k) * 4 + wave) * D_;
      v4u ua[2], uc[2];
#pragma unroll
      for (int q = 0; q < 2; ++q) { ua[q] = ((const v4u*)(xbp + ra_))[q * 64 + lane]; uc[q] = ((const v4u*)(xbp + rc_))[q * 64 + lane]; }
      float fa[16], fc[16];
      unpack8(ua[0], fa); unpack8(ua[1], fa + 8); unpack8(uc[0], fc); unpack8(uc[1], fc + 8);
      float sa = 0.f, sc = 0.f;
#pragma unroll
      for (int e2 = 0; e2 < 16; ++e2) { sa += fa[e2] * fa[e2]; sc += fc[e2] * fc[e2]; }
      sa = wave_sum(sa); sc = wave_sum(sc);
      const float ra = rsqrtf(sa * (1.f / 1024.f) + 1e-6f), rc = rsqrtf(sc * (1.f / 1024.f) + 1e-6f);
#pragma unroll
      for (int q = 0; q < 2; ++q) {
        const int c2 = (q * 64 + lane) * 2;
        const float4 g0 = ((const float4*)p.in[19])[c2], g1 = ((const float4*)p.in[19])[c2 + 1];
        ((float4*)(xcur + ra_))[c2] = make_float4(fa[q * 8] * ra * g0.x, fa[q * 8 + 1] * ra * g0.y, fa[q * 8 + 2] * ra * g0.z, fa[q * 8 + 3] * ra * g0.w);
        ((float4*)(xcur + ra_))[c2 + 1] = make_float4(fa[q * 8 + 4] * ra * g1.x, fa[q * 8 + 5] * ra * g1.y, fa[q * 8 + 6] * ra * g1.z, fa[q * 8 + 7] * ra * g1.w);
        if (k2 < 4096) {
          ((float4*)(xcur + rc_))[c2] = make_float4(fc[q * 8] * rc * g0.x, fc[q * 8 + 1] * rc * g0.y, fc[q * 8 + 2] * rc * g0.z, fc[q * 8 + 3] * rc * g0.w);
          ((float4*)(xcur + rc_))[c2 + 1] = make_float4(fc[q * 8 + 4] * rc * g1.x, fc[q * 8 + 5] * rc * g1.y, fc[q * 8 + 6] * rc * g1.z, fc[q * 8 + 7] * rc * g1.w);
        }
      }
    }
  } break;
  case OP_NSA_IN: {
    ARow af{(const u16*)(ws + OFF_XB), D_};
    EpiStoreT ep{(u16*)(ws + OFF_PROJ), LDP, (const float*)(ws + OFF_SSQ)};
    const u16* Bt = (const u16*)(ws + OFF_WNI) + (size_t)L * LDP * 1024;
    for (int r = 0, tm, tn; xcd_tile(bid, r, G, 128, 11, tm, tn); ++r) gemm_tile(af, Bt, LDP, 1024, tm * 128, tn * 256, ep, smem);
  } break;
  case OP_NSA_PACK: {
    const u16* proj = (const u16*)(ws + OFF_PROJ);
    const float* rope = (const float*)(ws + OFF_ROPE);
    const int n_g = 64, n_k = 2 * 256, n_v = 2 * 2048;
    for (int w = bid; w < n_g + n_k + n_v; w += G) {
      if (w < n_g) {
        int kv = w >> 5, lt = w & 31;
        ACmp af{proj, 1024 + kv * 256};
        EpiGelu ep{(const float*)(ws + OFF_CB) + (L * 2 + kv) * 256, (u16*)(ws + OFF_HID) + (size_t)kv * 4096 * 256};
        gemm_tile(af, (const u16*)(ws + OFF_WP1) + (size_t)(L * 2 + kv) * 256 * 2048, 256, 2048, lt * 128, 0, ep, smem);
        continue;
      }
      int k = w - n_g;
      if (k < n_k) {
        int str = k >> 8, task = (k & 255) * 256 + tid;
        pack_k_task(proj, LDP, 1024 + (str ? 1024 : 512), 4, (u16*)(ws + (str ? OFF_KWF : OFF_KSF)), rope, task);
        continue;
      }
      k -= n_k;
      { int str = k >> 11, task = (k & 2047) * 256 + tid;
        pack_v_task<2>(proj, LDP, 1024 + (str ? 1280 : 768), 4, (u16*)(ws + (str ? OFF_VWF : OFF_VSF)), task); }
    }
  } break;
  case OP_NSA_CMP2: {
    for (int w = bid; w < 64; w += G) {
      int kv = w >> 5, lt = w & 31;
      ARow af{(const u16*)(ws + OFF_HID) + (size_t)kv * 4096 * 256, 256};
      EpiCmpOut ep{(u16*)(ws + OFF_KCF), (u16*)(ws + OFF_VCF), kv};
      gemm_tile(af, (const u16*)(ws + OFF_WP2) + (size_t)(L * 2 + kv) * 64 * 256, 64, 256, lt * 128, 0, ep, smem);
    }
  } break;
  case OP_NSA_ATTN: {
    for (int r = 0;; ++r) { int it = snake(r, G, bid); if (r * G >= 2048) break; if (it < 2048) nsa_attn_item(p, it, smem); }
  } break;
  case OP_OUTPROJ: {
    ARow af{(const u16*)(ws + OFF_H), D_};
    const u16* Bt = L < 2 ? (const u16*)(ws + OFF_WNO) + (size_t)L * 1024 * 1024 : (const u16*)(ws + OFF_WDO) + (size_t)(L - 2) * 1024 * 1024;
    {
      EpiResidT<false> ep{nullptr, nullptr, (u16*)(ws + OFF_XB), (float*)(ws + OFF_SSQ)};
      for (int r = 0, tm, tn; xcd_tile(bid, r, G, 128, 4, tm, tn); ++r) gemm_tile(af, Bt, 1024, 1024, tm * 128, tn * 256, ep, smem);
    }
  } break;
  case OP_FFN1: {
    ARow af{(const u16*)(ws + OFF_XB), D_};
    EpiConvGlu ep{(u16*)(ws + OFF_ACT), (u16*)(ws + OFF_HALO), p.in[16] + (size_t)L * 3 * FF2, p.in[17] + (size_t)L * FF2, (const float*)(ws + OFF_SSQ)};
    const u16* Bt = (const u16*)(ws + OFF_WFI) + (size_t)L * FF2 * 1024;
    for (int r = 0, tm, tn; xcd_tile(bid, r, G, 128, 22, tm, tn); ++r) gemm_tile(af, Bt, FF2, 1024, tm * 128, tn * 256, ep, smem);
  } break;
  case OP_FIX: {
    for (int k = bid; k < 344; k += G)
      ffn_fix_task((const u16*)(ws + OFF_HALO), (u16*)(ws + OFF_ACT), p.in[16] + (size_t)L * 3 * FF2, p.in[17] + (size_t)L * FF2, k * 256 + tid);
  } break;
  case OP_FFN2: {
    ARow af{(const u16*)(ws + OFF_ACT), FF};
    EpiResidT<false> ep{nullptr, nullptr, (u16*)(ws + OFF_XB), (float*)(ws + OFF_SSQ)};
    const u16* Bt = (const u16*)(ws + OFF_WFO) + (size_t)L * 1024 * FF;
    for (int r = 0, tm, tn; xcd_tile(bid, r, G, 128, 4, tm, tn); ++r) {
      for (int q = tid; q < 688; q += 256)
        ffn_fix_task((const u16*)(ws + OFF_HALO), (u16*)(ws + OFF_ACT), p.in[16] + (size_t)L * 3 * FF2, p.in[17] + (size_t)L * FF2, (tm * 2 + q / 344) * 344 + q % 344);
      gemm_tile(af, Bt, 1024, FF, tm * 128, tn * 256, ep, smem);
    }
  } break;
  case OP_KVQ_GEMM: {
    for (int r = 0, tm, tn; xcd_tile(bid, r, G, 128, 12, tm, tn); ++r) {
      if (tn < 8) {
        ARow af{(const u16*)(ws + OFF_XB), D_}; EpiStoreT ep{(u16*)(ws + OFF_KVRAW), 2048, (const float*)(ws + OFF_SSQ)};
        gemm_tile(af, (const u16*)(ws + OFF_WKV), 2048, 1024, tm * 128, tn * 256, ep, smem);
      } else {
        ARow af{(const u16*)(ws + OFF_XB), D_}; EpiStoreT ep{(u16*)(ws + OFF_Q), D_, (const float*)(ws + OFF_SSQ)};
        gemm_tile(af, (const u16*)(ws + OFF_WDQ), 1024, 1024, tm * 128, (tn - 8) * 256, ep, smem);
      }
    }
  } break;
  case OP_DQ_GEMM: {
    ARow af{(const u16*)(ws + OFF_XB), D_}; EpiStoreT ep{(u16*)(ws + OFF_Q), D_, (const float*)(ws + OFF_SSQ)};
    for (int r = 0, tm, tn; xcd_tile(bid, r, G, 128, 4, tm, tn); ++r) gemm_tile(af, (const u16*)(ws + OFF_WDQ) + 1024 * 1024, 1024, 1024, tm * 128, tn * 256, ep, smem);
  } break;
  case OP_KV_PACK: {
    const u16* kvr = (const u16*)(ws + OFF_KVRAW);
    const float* rope = (const float*)(ws + OFF_ROPE);
    const int n_k = 1024, n_v = 8192;
    for (int w = bid; w < n_k + n_v; w += G) {
      if (w < n_k) pack_k16_task(kvr, 2048, 0, 16, (u16*)(ws + OFF_SKVK), rope, w * 256 + tid);
      else pack_v16_task(kvr, 2048, 1024, 8, (u16*)(ws + OFF_SKVV), (w - n_k) * 256 + tid);
    }
  } break;
  case OP_DIFF_ATTN: {
    for (int r = 0;; ++r) { int it = snake(r, G, bid); if (r * G >= 2048) break; if (it < 2048) diff_attn_item(p, it, smem); }
  } break;
  case OP_DIFF_COMB: {
    for (int k = bid; k < 4096; k += G) diff_comb_row(p, L - 2, L, k * 4 + wave, lane);
  } break;
  }
}

__global__ void __launch_bounds__(256, 2) mega(Params p, int s_lo, int s_hi) {
  __shared__ __attribute__((aligned(16))) char smem[73728];
  __shared__ uint4 xb_words;
  cg::grid_group grid = cg::this_grid();
  const bool multi = (s_hi - s_lo) > 1;
  XcdBarrier xb;
  if (multi) {
    if (__builtin_amdgcn_workitem_id_x() == 0) xb_words = make_uint4(0u, 0u, 0u, 0u);
    __syncthreads();
    xb = xcd_barrier_post((unsigned*)(p.ws + OFF_BAR), (volatile LAS unsigned*)&xb_words);
  }
  for (int s = s_lo; s < s_hi; ++s) {
    Step st = g_prog[s];
    run_step(p, st, smem);
    if (s + 1 < s_hi) { if (s_hi > 4096) grid.sync();   xcd_barrier(xb); }
  }
}

extern "C" void kernel_launch(void* const* d_in, const int* in_sizes, int n_in, void* d_out, int out_size, void* d_ws, size_t ws_size,
                              hipStream_t stream) {
  (void)in_sizes; (void)n_in; (void)out_size;
  static int grid_blocks = 0;
  if (!grid_blocks) {
    int dev = 0, cus = 0, per_cu = 0;
    hipGetDevice(&dev);
    hipDeviceGetAttribute(&cus, hipDeviceAttributeMultiprocessorCount, dev);
    hipOccupancyMaxActiveBlocksPerMultiprocessor(&per_cu, mega, 256, 0);
    if (per_cu < 1) per_cu = 1;
    if (per_cu > 2) per_cu = 2;
    grid_blocks = cus * per_cu;
  }
  if (ws_size < WS_NEEDED) { fprintf(stderr, "workspace too small: %zu < %zu\n", ws_size, (size_t)WS_NEEDED); return; }
  Params p{};
  for (int i = 0; i < 20; ++i) p.in[i] = (const float*)d_in[i];
  p.out = (float*)d_out;
  p.ws = (char*)d_ws;
#if ONE_LAUNCH
  hipMemsetAsync((char*)d_ws + OFF_BAR, 0, XCD_BAR_WORDS * 4, stream);
  int lo = 0, hi = N_STEPS;
  void* args[] = {&p, &lo, &hi};
  hipError_t e = hipLaunchCooperativeKernel((void*)mega, dim3(grid_blocks), dim3(256), args, 0, stream);
  if (e != hipSuccess) fprintf(stderr, "cooperative launch failed: %s (grid %d)\n", hipGetErrorString(e), grid_blocks);
#else
  for (int s = 0; s < N_STEPS; ++s) mega<<<grid_blocks, 256, 0, stream>>>(p, s, s + 1);
#endif
}
```

```cpp
#include <hip/hip_runtime.h>
#include <hip/hip_cooperative_groups.h>
#include <math.h>
#include <stdint.h>
#include <stdio.h>
namespace cg = cooperative_groups;

#ifndef ONE_LAUNCH
#define ONE_LAUNCH 1
#endif

typedef unsigned short u16;
typedef __attribute__((ext_vector_type(8))) short bf16x8;
typedef __attribute__((ext_vector_type(16))) float f32x16;
typedef __bf16 bf2_t __attribute__((ext_vector_type(2)));
typedef float f2_t __attribute__((ext_vector_type(2)));
typedef unsigned v4u __attribute__((ext_vector_type(4)));
typedef unsigned v2u __attribute__((ext_vector_type(2)));
#define DI __device__ __forceinline__

#define MFMA(a, b, c) __builtin_amdgcn_mfma_f32_32x32x16_bf16((a), (b), (c), 0, 0, 0)
typedef __attribute__((ext_vector_type(4))) float f32x4;
#define MFMA16(a, b, c) __builtin_amdgcn_mfma_f32_16x16x32_bf16((a), (b), (c), 0, 0, 0)

constexpr int T_ = 16384, S_ = 8192, D_ = 1024;
constexpr int LDP = 2608;
constexpr int FF = 2752, FF2 = 5504;
constexpr float SC = 0.125f * 1.4426950408889634f;

constexpr size_t OFF_WNI = 0;
constexpr size_t OFF_WNO = OFF_WNI + 2ull * 2608 * 1024 * 2;
constexpr size_t OFF_WP1 = OFF_WNO + 2ull * 1024 * 1024 * 2;
constexpr size_t OFF_WP2 = OFF_WP1 + 4ull * 256 * 2048 * 2;
constexpr size_t OFF_WKV = OFF_WP2 + 4ull * 64 * 256 * 2;
constexpr size_t OFF_WDQ = OFF_WKV + 2048ull * 1024 * 2;
constexpr size_t OFF_WDO = OFF_WDQ + 2ull * 1024 * 1024 * 2;
constexpr size_t OFF_WFI = OFF_WDO + 2ull * 1024 * 1024 * 2;
constexpr size_t OFF_WFO = OFF_WFI + 4ull * 5504 * 1024 * 2;
constexpr size_t OFF_ROPE = OFF_WFO + 4ull * 1024 * 2752 * 2;
constexpr size_t OFF_CB = OFF_ROPE + 8192ull * 16 * 4;
constexpr size_t OFF_BAR = OFF_CB + 4096;
constexpr size_t OFF_H = OFF_BAR + 16384;
constexpr size_t OFF_SKVK = OFF_H + (size_t)T_ * 1024 * 2;
constexpr size_t OFF_SKVV = OFF_SKVK + (size_t)T_ * 1024 * 2;
constexpr size_t OFF_XB = OFF_SKVV + (size_t)T_ * 1024 * 2;
constexpr size_t OFF_SSQ = OFF_XB + (size_t)T_ * 1024 * 2;
constexpr size_t OFF_BIG = OFF_SSQ + (size_t)T_ * 8 * 4;
constexpr size_t OFF_PROJ = OFF_BIG;
constexpr size_t OFF_KSF = OFF_PROJ + (size_t)T_ * LDP * 2;
constexpr size_t OFF_KWF = OFF_KSF + (size_t)T_ * 256 * 2;
constexpr size_t OFF_VSF = OFF_KWF + (size_t)T_ * 256 * 2;
constexpr size_t OFF_VWF = OFF_VSF + (size_t)T_ * 256 * 2;
constexpr size_t OFF_HID = OFF_VWF + (size_t)T_ * 256 * 2;
constexpr size_t OFF_KCF = OFF_HID + 2ull * 4096 * 256 * 2;
constexpr size_t OFF_VCF = OFF_KCF + 2ull * 4 * 512 * 64 * 2;
constexpr size_t OFF_ACT = OFF_BIG;
constexpr size_t OFF_HALO = OFF_ACT + (size_t)T_ * 2752 * 2;
constexpr size_t OFF_Q = OFF_BIG;
constexpr size_t OFF_KVRAW = OFF_Q + (size_t)T_ * 1024 * 2;
constexpr size_t WS_NEEDED = OFF_VCF + 2ull * 4 * 512 * 64 * 2;

struct Params {
  const float* in[20];
  float* out;
  char* ws;
};

enum { OP_PREP = 0, OP_NORM, OP_NSA_IN, OP_NSA_PACK, OP_NSA_CMP2, OP_NSA_ATTN, OP_OUTPROJ, OP_FFN1, OP_CONV, OP_FFN2,
       OP_FIX, OP_KVQ_NORM, OP_KVQ_GEMM, OP_KV_PACK, OP_DIFF_ATTN, OP_DIFF_COMB, OP_DQ_GEMM, OP_FINAL };
struct Step { int op, layer, aux; };
#define FFN_STEPS(l) {OP_FFN1, l, 0}, {OP_FFN2, l, 0}
#define NSA_STEPS(l) {OP_NSA_IN, l, 0}, {OP_NSA_PACK, l, 0}, {OP_NSA_ATTN, l, 0}, {OP_OUTPROJ, l, 0}
__constant__ Step g_prog[] = {
  {OP_PREP, 0, 0},
  NSA_STEPS(0), FFN_STEPS(0),
  NSA_STEPS(1), FFN_STEPS(1),
  {OP_KVQ_GEMM, 2, 0}, {OP_KV_PACK, 2, 0}, {OP_DIFF_ATTN, 2, 0}, {OP_DIFF_COMB, 2, 0}, {OP_OUTPROJ, 2, 0}, FFN_STEPS(2),
  {OP_DQ_GEMM, 3, 0}, {OP_DIFF_ATTN, 3, 0}, {OP_DIFF_COMB, 3, 0}, {OP_OUTPROJ, 3, 0}, FFN_STEPS(3),
  {OP_FINAL, 0, 0},
};
constexpr int N_STEPS = 1 + 6 + 6 + 7 + 6 + 1;

DI int get_tid() { int t = (int)__builtin_amdgcn_workitem_id_x(); asm volatile("" : "+v"(t)); return t; }
DI int get_bid() { int b = (int)__builtin_amdgcn_workgroup_id_x(); asm volatile("" : "+s"(b)); return b; }
DI v4u mk4(unsigned a, unsigned b, unsigned c, unsigned d) { v4u r = {a, b, c, d}; return r; }
DI v2u mk2(unsigned a, unsigned b) { v2u r = {a, b}; return r; }
DI unsigned pk2(float a, float b) { f2_t v = {a, b}; bf2_t r = __builtin_convertvector(v, bf2_t); return __builtin_bit_cast(unsigned, r); }
DI float bflo(unsigned u) { return __uint_as_float(u << 16); }
DI float bfhi(unsigned u) { return __uint_as_float(u & 0xffff0000u); }
DI float bf1(u16 v) { return __uint_as_float((unsigned)v << 16); }
DI u16 f2bf(float x) { return (u16)(pk2(x, 0.f) & 0xffffu); }
DI float wave_sum(float v) {
#pragma unroll
  for (int o = 32; o >= 1; o >>= 1) v += __shfl_xor(v, o);
  return v;
}
DI void unpack8(v4u a, float* f) {
  f[0] = bflo(a.x); f[1] = bfhi(a.x); f[2] = bflo(a.y); f[3] = bfhi(a.y);
  f[4] = bflo(a.z); f[5] = bfhi(a.z); f[6] = bflo(a.w); f[7] = bfhi(a.w);
}
DI v4u pack8(const float* f) { return mk4(pk2(f[0], f[1]), pk2(f[2], f[3]), pk2(f[4], f[5]), pk2(f[6], f[7])); }
DI bf16x8 pack_frag(const f32x16& x, int s) {
  v4u r = mk4(pk2(x[8 * s + 0], x[8 * s + 1]), pk2(x[8 * s + 2], x[8 * s + 3]), pk2(x[8 * s + 4], x[8 * s + 5]), pk2(x[8 * s + 6], x[8 * s + 7]));
  return __builtin_bit_cast(bf16x8, r);
}
DI size_t kfrag_chunk(int key, int c  ) { return ((size_t)(((key >> 5) * 4 + (c >> 1)) * 64 + (c & 1) * 32 + (key & 31))) * 8; }
template <int NDVT> DI size_t vfrag_index(int key, int dv) {
  int tile = key >> 6, s = (key >> 4) & 3, kk = key & 15, h = (kk >> 2) & 1, j = ((kk >> 3) << 2) | (kk & 3);
  return ((size_t)((((tile * NDVT + (dv >> 5)) * 4 + s) * 64) + h * 32 + (dv & 31))) * 8 + j;
}

struct ARow { const u16* base; int ld; DI const u16* operator()(int row, int k) const { return base + (size_t)row * ld + k; } };
struct ACmp {
  const u16* proj; int colbase;
  DI const u16* operator()(int r, int k) const {
    int hk = r & 3, i = (r >> 2) & 511, b = r >> 11; i = i > 510 ? 510 : i;
    return proj + (size_t)(b * S_ + 16 * i + (k >> 6)) * LDP + colbase + hk * 64 + (k & 63);
  }
};
struct EpiStore { static constexpr bool kTileEpi = false; u16* C; int ld; int N;
  DI void operator()(int m, int n, float a, float b, float c, float d) const { if (n < N) *(v2u*)(C + (size_t)m * ld + n) = mk2(pk2(a, b), pk2(c, d)); } };
struct EpiResid { static constexpr bool kTileEpi = false; const float* xin; float* xout;
  DI void operator()(int m, int n, float a, float b, float c, float d) const {
    float4 x = *(const float4*)(xin + (size_t)m * D_ + n); x.x += a; x.y += b; x.z += c; x.w += d; *(float4*)(xout + (size_t)m * D_ + n) = x; } };
DI float gelu_t(float x) { const float t = x * x; const float e = __builtin_amdgcn_exp2f(x * fmaf(t, -0.1029432f, -2.3022082f)); return x * __builtin_amdgcn_rcpf(1.f + e); }
struct EpiGelu { static constexpr bool kTileEpi = false; const float* bias; u16* C;
  DI void operator()(int m, int n, float a, float b, float c, float d) const {
    float4 bb = *(const float4*)(bias + n);
    *(v2u*)(C + (size_t)m * 256 + n) = mk2(pk2(gelu_t(a + bb.x), gelu_t(b + bb.y)), pk2(gelu_t(c + bb.z), gelu_t(d + bb.w))); } };
struct EpiCmpOut { static constexpr bool kTileEpi = false; u16* kcf; u16* vcf; int kv;
  DI void operator()(int m, int n, float a, float b, float c, float d) const {
    if (n >= 64) return;
    int hk = m & 3, i = (m >> 2) & 511, bb = m >> 11;
    if (i == 511) { a = b = c = d = 0.f; }
    size_t sb = (size_t)(bb * 4 + hk) * 512 * 64;
    if (kv == 0) { *(v2u*)(kcf + sb + kfrag_chunk(i, n >> 3) + (n & 7)) = mk2(pk2(a, b), pk2(c, d)); }
    else { vcf[sb + vfrag_index<2>(i, n)] = f2bf(a); vcf[sb + vfrag_index<2>(i, n + 1)] = f2bf(b); vcf[sb + vfrag_index<2>(i, n + 2)] = f2bf(c); vcf[sb + vfrag_index<2>(i, n + 3)] = f2bf(d); }
  } };


struct EpiCmpFused { static constexpr bool kTileEpi = true; static constexpr bool kRs = false;
  const float* bias; const u16* W2T; u16* kcf; u16* vcf; int kv;
  DI void tile(f32x4 (&acc)[8][4], const float (&rs)[4], int m0, int n0, int N, char* smem) const {
    u16* Ht = (u16*)smem;
    const int tid = get_tid(), lane = tid & 63, wave = tid >> 6, wm = wave & 1, wn = wave >> 1, l15 = lane & 15, lq = lane >> 4;
    __syncthreads();
#pragma unroll
    for (int ni = 0; ni < 8; ++ni) {
      const int n = wn * 128 + ni * 16 + 4 * lq;
      const float4 bb = *(const float4*)(bias + n);
#pragma unroll
      for (int mi = 0; mi < 4; ++mi) {
        const int m = wm * 64 + mi * 16 + l15;
        *(v2u*)(Ht + m * 264 + n) = mk2(pk2(gelu_t(acc[ni][mi][0] + bb.x), gelu_t(acc[ni][mi][1] + bb.y)), pk2(gelu_t(acc[ni][mi][2] + bb.z), gelu_t(acc[ni][mi][3] + bb.w)));
      }
    }
    __syncthreads();
    f32x4 a2[4][2];
#pragma unroll
    for (int nj = 0; nj < 4; ++nj)
#pragma unroll
      for (int mi = 0; mi < 2; ++mi)
#pragma unroll
        for (int i = 0; i < 4; ++i) a2[nj][mi][i] = 0.f;
#pragma unroll
    for (int ks = 0; ks < 8; ++ks) {
      bf16x8 fb[2], fa[4];
#pragma unroll
      for (int mi = 0; mi < 2; ++mi) fb[mi] = *(const bf16x8*)(Ht + (wave * 32 + mi * 16 + l15) * 264 + ks * 32 + lq * 8);
#pragma unroll
      for (int nj = 0; nj < 4; ++nj) fa[nj] = *(const bf16x8*)(W2T + (nj * 16 + l15) * 256 + ks * 32 + lq * 8);
#pragma unroll
      for (int nj = 0; nj < 4; ++nj)
#pragma unroll
        for (int mi = 0; mi < 2; ++mi) a2[nj][mi] = MFMA16(fa[nj], fb[mi], a2[nj][mi]);
    }
    EpiCmpOut out{kcf, vcf, kv};
#pragma unroll
    for (int nj = 0; nj < 4; ++nj)
#pragma unroll
      for (int mi = 0; mi < 2; ++mi)
        out(m0 + wave * 32 + mi * 16 + l15, nj * 16 + 4 * lq, a2[nj][mi][0], a2[nj][mi][1], a2[nj][mi][2], a2[nj][mi][3]);
  } };

DI float rrow(const float* __restrict__ ssq, int m) {
  const float4 a = *(const float4*)(ssq + (size_t)m * 8), b = *(const float4*)(ssq + (size_t)m * 8 + 4);
  return rsqrtf(((a.x + a.y) + (a.z + a.w) + (b.x + b.y) + (b.z + b.w)) * (1.f / 1024.f) + 1e-6f);
}
constexpr int CT_ROW = 264;
struct EpiStoreT { static constexpr bool kTileEpi = true; static constexpr bool kRs = true;
  u16* C; int ld; const float* ssq;
  DI void tile(f32x4 (&acc)[8][4], const float (&rs)[4], int m0, int n0, int N, char* smem) const {
    u16* Ct = (u16*)smem;
    const int tid = get_tid(), lane = tid & 63, wave = tid >> 6, wm = wave & 1, wn = wave >> 1, l15 = lane & 15, lq = lane >> 4;
    __syncthreads();
#pragma unroll
    for (int ni = 0; ni < 8; ++ni)
#pragma unroll
      for (int mi = 0; mi < 4; ++mi) {
        const int m = wm * 64 + mi * 16 + l15, n = wn * 128 + ni * 16 + 4 * lq;
        const float s = rs[mi];
        *(v2u*)(Ct + m * CT_ROW + n) = mk2(pk2(acc[ni][mi][0] * s, acc[ni][mi][1] * s), pk2(acc[ni][mi][2] * s, acc[ni][mi][3] * s));
      }
    __syncthreads();
    const int ch = tid & 31, r0 = tid >> 5;
    if (n0 + ch * 8 < N) {
#pragma unroll
      for (int k = 0; k < 16; ++k) {
        const int m = r0 + 8 * k;
        *(v4u*)(C + (size_t)(m0 + m) * ld + n0 + ch * 8) = *(const v4u*)(Ct + m * CT_ROW + ch * 8);
      }
    }
  } };
constexpr int RT_ROW = 132;
template <bool F32IN>
struct EpiResidT { static constexpr bool kTileEpi = true; static constexpr bool kRs = false;
  const float* xin; float* xout; u16* xb; float* ssq;
  DI void tile(f32x4 (&acc)[8][4], const float (&rs)[4], int m0, int n0, int N, char* smem) const {
    float* Rt = (float*)smem;
    const int tid = get_tid(), lane = tid & 63, wave = tid >> 6, wm = wave & 1, wn = wave >> 1, l15 = lane & 15, lq = lane >> 4;
    const int ch = tid & 31, r0 = tid >> 5;
    if constexpr (!F32IN) {
      for (int pass = 0; pass < 2; ++pass) {
        v2u ur[16];
        const unsigned voff = (unsigned)(r0 * D_ + ch * 4);
        u16* const pbase = xb + (size_t)m0 * D_ + n0 + pass * 128;
#pragma unroll
        for (int k = 0; k < 16; ++k) ur[k] = *(const v2u*)(pbase + (size_t)(8 * k) * D_ + voff);
        __syncthreads();
        if (wn == pass) {
#pragma unroll
          for (int ni = 0; ni < 8; ++ni)
#pragma unroll
            for (int mi = 0; mi < 4; ++mi) {
              const int m = wm * 64 + mi * 16 + l15, n = ni * 16 + 4 * lq;
              *(float4*)(Rt + m * RT_ROW + n) = make_float4(acc[ni][mi][0], acc[ni][mi][1], acc[ni][mi][2], acc[ni][mi][3]);
            }
        }
        __syncthreads();
#pragma unroll
        for (int k = 0; k < 16; ++k) {
          if ((k & 3) == 0) __builtin_amdgcn_sched_barrier(0);
          const int m = r0 + 8 * k;
          float4 x = make_float4(bflo(ur[k].x), bfhi(ur[k].x), bflo(ur[k].y), bfhi(ur[k].y));
          const float4 a = *(const float4*)(Rt + m * RT_ROW + ch * 4);
          x.x += a.x; x.y += a.y; x.z += a.z; x.w += a.w;
          *(v2u*)(pbase + (size_t)(8 * k) * D_ + voff) = mk2(pk2(x.x, x.y), pk2(x.z, x.w));
          float ss = x.x * x.x + x.y * x.y + x.z * x.z + x.w * x.w;
#pragma unroll
          for (int o = 16; o >= 1; o >>= 1) ss += __shfl_xor(ss, o);
          if (ch == 0) ssq[(size_t)(m0 + m) * 8 + ((n0 >> 7) + pass)] = ss;
        }
      }
      return;
    }
    for (int pass = 0; pass < 2; ++pass) {
      float4 xr[8];
#pragma unroll
      for (int k = 0; k < 8; ++k) {
        const size_t o_ = (size_t)(m0 + r0 + 8 * k) * D_ + n0 + pass * 128 + ch * 4;
        if constexpr (F32IN) xr[k] = *(const float4*)(xin + o_);
        else { const v2u u_ = *(const v2u*)(xb + o_); xr[k] = make_float4(bflo(u_.x), bfhi(u_.x), bflo(u_.y), bfhi(u_.y)); }
      }
      __syncthreads();
      if (wn == pass) {
#pragma unroll
        for (int ni = 0; ni < 8; ++ni)
#pragma unroll
          for (int mi = 0; mi < 4; ++mi) {
            const int m = wm * 64 + mi * 16 + l15, n = ni * 16 + 4 * lq;
            *(float4*)(Rt + m * RT_ROW + n) = make_float4(acc[ni][mi][0], acc[ni][mi][1], acc[ni][mi][2], acc[ni][mi][3]);
          }
      }
      __syncthreads();
#pragma unroll 1
      for (int kh = 0; kh < 2; ++kh) {
        if (kh == 1) {
#pragma unroll
          for (int k = 0; k < 8; ++k) {
            const size_t o_ = (size_t)(m0 + r0 + 8 * (8 + k)) * D_ + n0 + pass * 128 + ch * 4;
            if constexpr (F32IN) xr[k] = *(const float4*)(xin + o_);
            else { const v2u u_ = *(const v2u*)(xb + o_); xr[k] = make_float4(bflo(u_.x), bfhi(u_.x), bflo(u_.y), bfhi(u_.y)); }
          }
        }
#pragma unroll
        for (int k = 0; k < 8; ++k) {
          const int m = r0 + 8 * (kh * 8 + k);
          const size_t off = (size_t)(m0 + m) * D_ + n0 + pass * 128 + ch * 4;
          float4 x = xr[k];
          const float4 a = *(const float4*)(Rt + m * RT_ROW + ch * 4);
          x.x += a.x; x.y += a.y; x.z += a.z; x.w += a.w;
          *(v2u*)(xb + off) = mk2(pk2(x.x, x.y), pk2(x.z, x.w));
          float ss = x.x * x.x + x.y * x.y + x.z * x.z + x.w * x.w;
#pragma unroll
          for (int o = 16; o >= 1; o >>= 1) ss += __shfl_xor(ss, o);
          if (ch == 0) ssq[(size_t)(m0 + m) * 8 + ((n0 >> 7) + pass)] = ss;
        }
      }
    }
  } };
constexpr int UT_ROW = 136;
DI float silu_mul(float g, float v) { return g * __builtin_amdgcn_rcpf(1.f + __expf(-g)) * v; }
struct EpiConvGlu { static constexpr bool kTileEpi = true; static constexpr bool kRs = true;
  u16* act; u16* halo; const float* cw; const float* cb; const float* ssq;
  DI void tile(f32x4 (&acc)[8][4], const float (&rs)[4], int m0, int n0, int N, char* smem) const {
    u16* Ut = (u16*)smem;
    const int tid = get_tid(), lane = tid & 63, wave = tid >> 6, wm = wave & 1, wn = wave >> 1, l15 = lane & 15, lq = lane >> 4;
    for (int pass = 0; pass < 2; ++pass) {
    if (n0 + pass * 128 >= N) break;
    const int tm = m0 >> 7, tn = (n0 >> 7) + pass;
    const int c = tid & 7, j0 = tn * 64 + c * 8;
    float wg[3][8], wv[3][8], bg[8], bv[8];
#pragma unroll
    for (int hq = 0; hq < 2; ++hq) {
#pragma unroll
      for (int tp = 0; tp < 3; ++tp) {
        float4 a = *(const float4*)(cw + tp * FF2 + j0 + 4 * hq), b = *(const float4*)(cw + tp * FF2 + FF + j0 + 4 * hq);
        wg[tp][4 * hq] = a.x; wg[tp][4 * hq + 1] = a.y; wg[tp][4 * hq + 2] = a.z; wg[tp][4 * hq + 3] = a.w;
        wv[tp][4 * hq] = b.x; wv[tp][4 * hq + 1] = b.y; wv[tp][4 * hq + 2] = b.z; wv[tp][4 * hq + 3] = b.w;
      }
      float4 a = *(const float4*)(cb + j0 + 4 * hq), b = *(const float4*)(cb + FF + j0 + 4 * hq);
      bg[4 * hq] = a.x; bg[4 * hq + 1] = a.y; bg[4 * hq + 2] = a.z; bg[4 * hq + 3] = a.w;
      bv[4 * hq] = b.x; bv[4 * hq + 1] = b.y; bv[4 * hq + 2] = b.z; bv[4 * hq + 3] = b.w;
    }
    __syncthreads();
    if (wn == pass) {
#pragma unroll
    for (int ni = 0; ni < 8; ++ni)
#pragma unroll
      for (int mi = 0; mi < 4; ++mi) {
        const int m = wm * 64 + mi * 16 + l15, n = ni * 16 + 4 * lq;
        const float s = rs[mi];
        *(v2u*)(Ut + m * UT_ROW + n) = mk2(pk2(acc[ni][mi][0] * s, acc[ni][mi][1] * s), pk2(acc[ni][mi][2] * s, acc[ni][mi][3] * s));
      }
    }
    __syncthreads();
    if (tid < 64) {
      int rr = tid >> 4, c2 = tid & 15, row = rr < 2 ? rr : 124 + rr, n = c2 * 8, half = n >> 6, j = tn * 64 + (n & 63);
      *(v4u*)(halo + ((size_t)((tm * 4 + rr) * 2 + half)) * FF + j) = *(const v4u*)(Ut + row * UT_ROW + n);
    }
#pragma unroll
    for (int k = 0; k < 4; ++k) {
      const int m = (tid >> 3) + 32 * k;
      if (m >= 2) {
        float g0[8], g1[8], g2[8], v0[8], v1[8], v2[8], o[8];
        unpack8(*(const v4u*)(Ut + m * UT_ROW + c * 8), g0); unpack8(*(const v4u*)(Ut + m * UT_ROW + 64 + c * 8), v0);
        unpack8(*(const v4u*)(Ut + (m - 1) * UT_ROW + c * 8), g1); unpack8(*(const v4u*)(Ut + (m - 1) * UT_ROW + 64 + c * 8), v1);
        unpack8(*(const v4u*)(Ut + (m - 2) * UT_ROW + c * 8), g2); unpack8(*(const v4u*)(Ut + (m - 2) * UT_ROW + 64 + c * 8), v2);
#pragma unroll
        for (int e = 0; e < 8; ++e)
          o[e] = silu_mul(bg[e] + wg[0][e] * g2[e] + wg[1][e] * g1[e] + wg[2][e] * g0[e], bv[e] + wv[0][e] * v2[e] + wv[1][e] * v1[e] + wv[2][e] * v0[e]);
        *(v4u*)(act + (size_t)(m0 + m) * FF + j0) = pack8(o);
      }
    }
    }
  } };
DI void ld_halo(const u16* __restrict__ halo, int tm, int rr, int half, int j0, float* f) { unpack8(*(const v4u*)(halo + ((size_t)((tm * 4 + rr) * 2 + half)) * FF + j0), f); }
DI void ffn_fix_task(const u16* __restrict__ halo, u16* __restrict__ act, const float* __restrict__ cw, const float* __restrict__ cb, int task) {
  const int ck = task % 344, rest = task / 344, r = rest & 1, tm = rest >> 1, j0 = ck * 8;
  const bool first = (tm & 63) == 0;
  float g0[8], g1[8], g2[8], v0[8], v1[8], v2[8], o[8];
#pragma unroll
  for (int e = 0; e < 8; ++e) { g1[e] = g2[e] = v1[e] = v2[e] = 0.f; }
  ld_halo(halo, tm, r, 0, j0, g0); ld_halo(halo, tm, r, 1, j0, v0);
  if (r == 1) { ld_halo(halo, tm, 0, 0, j0, g1); ld_halo(halo, tm, 0, 1, j0, v1); if (!first) { ld_halo(halo, tm - 1, 3, 0, j0, g2); ld_halo(halo, tm - 1, 3, 1, j0, v2); } }
  else if (!first) { ld_halo(halo, tm - 1, 3, 0, j0, g1); ld_halo(halo, tm - 1, 3, 1, j0, v1); ld_halo(halo, tm - 1, 2, 0, j0, g2); ld_halo(halo, tm - 1, 2, 1, j0, v2); }
#pragma unroll
  for (int e = 0; e < 8; ++e) {
    float cgv = cb[j0 + e] + cw[j0 + e] * g2[e] + cw[FF2 + j0 + e] * g1[e] + cw[2 * FF2 + j0 + e] * g0[e];
    float cvv = cb[FF + j0 + e] + cw[FF + j0 + e] * v2[e] + cw[FF2 + FF + j0 + e] * v1[e] + cw[2 * FF2 + FF + j0 + e] * v0[e];
    o[e] = silu_mul(cgv, cvv);
  }
  *(v4u*)(act + (size_t)(tm * 128 + r) * FF + j0) = pack8(o);
}

constexpr int G_ST = 24576;
#define GLDS1(gp_, ldsaddr_)                                                                                               \
  { unsigned keep_; const void* g_ = (const void*)(gp_); unsigned la_ = __builtin_amdgcn_readfirstlane(ldsaddr_);          \
    asm volatile("s_mov_b32 %0, m0\n\ts_mov_b32 m0, %2\n\ts_nop 0\n\tglobal_load_lds_dwordx4 %1, off\n\ts_mov_b32 m0, %0" : "=&s"(keep_) : "v"(g_), "s"(la_) : "memory"); }
template <class AF, class EP>
DI void gemm_tile(const AF& af, const u16* __restrict__ Bt, int N, int K, int m0, int n0, const EP& ep, char* smem) {
  const int tid = get_tid(), lane = tid & 63;
  const int wv = __builtin_amdgcn_readfirstlane(tid >> 6);
  const int wm = wv & 1, wn = wv >> 1;
  const int l15 = lane & 15, lq = lane >> 4;
  const unsigned lds0 = (unsigned)(size_t)smem;
  const int drow = lane >> 2, dc = ((lane & 3) ^ ((4 - ((lane >> 4) & 3)) & 3)) * 8;
  const u16* pb[4];
#pragma unroll
  for (int j = 0; j < 4; ++j) { int nb = n0 + (4 * wv + j) * 16 + drow; nb = nb < N ? nb : N - 1; pb[j] = Bt + (size_t)nb * K + dc; }
  f32x4 acc[8][4];
#pragma unroll
  for (int a = 0; a < 8; ++a)
#pragma unroll
    for (int b = 0; b < 4; ++b)
#pragma unroll
      for (int i = 0; i < 4; ++i) acc[a][b][i] = 0.f;
#define G_DMA(kt_, st_)                                                                                     \
  { const unsigned sb_ = lds0 + (unsigned)((st_) * G_ST);                                                   \
    _Pragma("unroll") for (int j = 0; j < 2; ++j) GLDS1(af(m0 + (2 * wv + j) * 16 + drow, (kt_) * 32 + dc), sb_ + (2 * wv + j) * 1024) \
    _Pragma("unroll") for (int j = 0; j < 4; ++j) GLDS1(pb[j] + (kt_) * 32, sb_ + 8192 + (4 * wv + j) * 1024) }
  asm volatile("s_waitcnt vmcnt(0)" ::: "memory");
  __syncthreads();
  const int nk = K >> 5;
  float rsv[4] = {1.f, 1.f, 1.f, 1.f};
  float4 rq[EP::kTileEpi ? 8 : 1];
  if constexpr (EP::kTileEpi) { if constexpr (EP::kRs) {
#pragma unroll
    for (int mi = 0; mi < 4; ++mi) { const float* sp = ep.ssq + (size_t)(m0 + wm * 64 + mi * 16 + l15) * 8; rq[2 * mi] = *(const float4*)sp; rq[2 * mi + 1] = *(const float4*)(sp + 4); }
  } }
  G_DMA(0, 0)
  if (nk > 1) G_DMA(1, 1)
  if constexpr (EP::kTileEpi) { if constexpr (EP::kRs) {
#pragma unroll
    for (int mi = 0; mi < 4; ++mi) { const float4 a = rq[2 * mi], b = rq[2 * mi + 1]; rsv[mi] = rsqrtf(((a.x + a.y) + (a.z + a.w) + (b.x + b.y) + (b.z + b.w)) * (1.f / 1024.f) + 1e-6f); }
  } }
  const int co = (lq ^ ((4 - ((l15 >> 2) & 3)) & 3)) * 16;
  int st = 0;
  for (int kt = 0; kt < nk; ++kt) {
    if (kt + 1 < nk) asm volatile("s_waitcnt vmcnt(6)" ::: "memory"); else asm volatile("s_waitcnt vmcnt(0)" ::: "memory");
    asm volatile("s_waitcnt lgkmcnt(0)" ::: "memory");
    __builtin_amdgcn_s_barrier();
    if (kt + 2 < nk) { const int s2 = st >= 1 ? st - 1 : 2; G_DMA(kt + 2, s2) }
    {
      const char* sbase = smem + st * G_ST;
      const char* pB = sbase + (wm * 64 + l15) * 64 + co;
      const char* pA = sbase + 8192 + (wn * 128 + l15) * 64 + co;
      bf16x8 fb[4], fa[8];
#pragma unroll
      for (int mi = 0; mi < 4; ++mi) fb[mi] = *(const bf16x8*)(pB + mi * 16 * 64);
#pragma unroll
      for (int ni = 0; ni < 8; ++ni) fa[ni] = *(const bf16x8*)(pA + ni * 16 * 64);
      __builtin_amdgcn_sched_barrier(0);
#pragma unroll
      for (int ni = 0; ni < 8; ++ni)
#pragma unroll
        for (int mi = 0; mi < 4; ++mi) acc[ni][mi] = MFMA16(fa[ni], fb[mi], acc[ni][mi]);
      __builtin_amdgcn_sched_barrier(0);
    }
    st = st == 2 ? 0 : st + 1;
  }
  if constexpr (EP::kTileEpi) {
    ep.tile(acc, rsv, m0, n0, N, smem);
  } else {
#pragma unroll
  for (int ni = 0; ni < 8; ++ni)
#pragma unroll
    for (int mi = 0; mi < 4; ++mi) {
      const int m = m0 + wm * 64 + mi * 16 + l15, n = n0 + wn * 128 + ni * 16 + 4 * lq;
      ep(m, n, acc[ni][mi][0], acc[ni][mi][1], acc[ni][mi][2], acc[ni][mi][3]);
    }
  }
}

DI void norm_row_bf16(const float* __restrict__ x, const float* __restrict__ g, u16* __restrict__ dst, int lane) {
  float4 v[4]; float ss = 0.f;
#pragma unroll
  for (int k = 0; k < 4; ++k) { v[k] = ((const float4*)x)[k * 64 + lane]; ss += v[k].x * v[k].x + v[k].y * v[k].y + v[k].z * v[k].z + v[k].w * v[k].w; }
  ss = wave_sum(ss);
  float r = rsqrtf(ss * (1.f / 1024.f) + 1e-6f);
#pragma unroll
  for (int k = 0; k < 4; ++k) {
    float4 gg = ((const float4*)g)[k * 64 + lane];
    ((v2u*)dst)[k * 64 + lane] = mk2(pk2(v[k].x * r * gg.x, v[k].y * r * gg.y), pk2(v[k].z * r * gg.z, v[k].w * r * gg.w));
  }
}
DI void norm_row_f32(float* __restrict__ x, const float* __restrict__ g, int lane) {
  float4 v[4]; float ss = 0.f;
#pragma unroll
  for (int k = 0; k < 4; ++k) { v[k] = ((const float4*)x)[k * 64 + lane]; ss += v[k].x * v[k].x + v[k].y * v[k].y + v[k].z * v[k].z + v[k].w * v[k].w; }
  ss = wave_sum(ss);
  float r = rsqrtf(ss * (1.f / 1024.f) + 1e-6f);
#pragma unroll
  for (int k = 0; k < 4; ++k) {
    float4 gg = ((const float4*)g)[k * 64 + lane];
    ((float4*)x)[k * 64 + lane] = make_float4(v[k].x * r * gg.x, v[k].y * r * gg.y, v[k].z * r * gg.z, v[k].w * r * gg.w);
  }
}


DI void prep_row_x(const float* __restrict__ x, u16* __restrict__ xb, float* __restrict__ ssq, int lane) {
#pragma unroll
  for (int k = 0; k < 4; ++k) {
    const float4 v = ((const float4*)x)[k * 64 + lane];
    ((v2u*)xb)[k * 64 + lane] = mk2(pk2(v.x, v.y), pk2(v.z, v.w));
    float ss = v.x * v.x + v.y * v.y + v.z * v.z + v.w * v.w;
#pragma unroll
    for (int o = 16; o >= 1; o >>= 1) ss += __shfl_xor(ss, o);
    if ((lane & 31) == 0) ssq[2 * k + (lane >> 5)] = ss;
  }
}

struct Job { int in_idx; unsigned src_off; unsigned long long dst_off; int K, N, perm, g_idx, g_off; };
__constant__ Job g_jobs[25] = {
  {15, 0u, OFF_WFI, 1024, 5504, 1, 2, 0},
  {15, 1024u * 5504u, OFF_WFI + 1ull * 5504 * 1024 * 2, 1024, 5504, 1, 2, 1024},
  {15, 2u * 1024u * 5504u, OFF_WFI + 2ull * 5504 * 1024 * 2, 1024, 5504, 1, 2, 2048},
  {15, 3u * 1024u * 5504u, OFF_WFI + 3ull * 5504 * 1024 * 2, 1024, 5504, 1, 2, 3072},
  {18, 0u, OFF_WFO, 2752, 1024, 0, -1, 0},
  {18, 2752u * 1024u, OFF_WFO + 1ull * 1024 * 2752 * 2, 2752, 1024, 0, -1, 0},
  {18, 2u * 2752u * 1024u, OFF_WFO + 2ull * 1024 * 2752 * 2, 2752, 1024, 0, -1, 0},
  {18, 3u * 2752u * 1024u, OFF_WFO + 3ull * 1024 * 2752 * 2, 2752, 1024, 0, -1, 0},
  {3, 0u, OFF_WNI, 1024, 2608, 0, 1, 0},
  {3, 1024u * 2608u, OFF_WNI + 2608ull * 1024 * 2, 1024, 2608, 0, 1, 1024},
  {4, 0u, OFF_WNO, 1024, 1024, 0, -1, 0},
  {4, 1024u * 1024u, OFF_WNO + 1024ull * 1024 * 2, 1024, 1024, 0, -1, 0},
  {6, 0u, OFF_WP1, 2048, 256, 0, -1, 0},
  {6, 2048u * 256u, OFF_WP1 + 1ull * 256 * 2048 * 2, 2048, 256, 0, -1, 0},
  {6, 2u * 2048u * 256u, OFF_WP1 + 2ull * 256 * 2048 * 2, 2048, 256, 0, -1, 0},
  {6, 3u * 2048u * 256u, OFF_WP1 + 3ull * 256 * 2048 * 2, 2048, 256, 0, -1, 0},
  {8, 0u, OFF_WP2, 256, 64, 0, -1, 0},
  {8, 256u * 64u, OFF_WP2 + 1ull * 64 * 256 * 2, 256, 64, 0, -1, 0},
  {8, 2u * 256u * 64u, OFF_WP2 + 2ull * 64 * 256 * 2, 256, 64, 0, -1, 0},
  {8, 3u * 256u * 64u, OFF_WP2 + 3ull * 64 * 256 * 2, 256, 64, 0, -1, 0},
  {10, 0u, OFF_WKV, 1024, 2048, 0, 9, 0},
  {11, 0u, OFF_WDQ, 1024, 1024, 0, 1, 2048},
  {11, 1024u * 1024u, OFF_WDQ + 1024ull * 1024 * 2, 1024, 1024, 0, 1, 3072},
  {14, 0u, OFF_WDO, 1024, 1024, 0, -1, 0},
  {14, 1024u * 1024u, OFF_WDO + 1024ull * 1024 * 2, 1024, 1024, 0, -1, 0},
};
constexpr int N_TR_TILES = 2 * 656 + 2 * 256 + 4 * 128 + 4 * 4 + 512 + 2 * 256 + 2 * 256 + 4 * 1376 + 4 * 688;

DI void transpose_tile(const Params& p, size_t z, int tile, char* smem, int& j, int& base) {
  for (;;) { int nt = (g_jobs[j].K >> 6) * ((g_jobs[j].N + 63) >> 6); if (tile < base + nt) break; base += nt; ++j; }
  const Job jb = g_jobs[j];
  const float* src = p.in[jb.in_idx] + jb.src_off + z;
  u16* dst = (u16*)(p.ws + jb.dst_off + z);
  const int K = jb.K, N = jb.N;
  const int lt = tile - base, ntn = (N + 63) >> 6;
  const int k0 = (lt / ntn) * 64, n0 = (lt % ntn) * 64;
  float* t = (float*)smem;
  const int tid = get_tid();
  __syncthreads();
  {
    const int n4 = (tid & 15) * 4, kq = tid >> 4;
    const bool ok = (n0 + n4) < N;
    float4 v[4];
#pragma unroll
    for (int i = 0; i < 4; ++i) v[i] = ok ? *(const float4*)(src + (size_t)(k0 + kq + 16 * i) * N + n0 + n4) : make_float4(0.f, 0.f, 0.f, 0.f);
#pragma unroll
    for (int i = 0; i < 4; ++i) { float* tp = t + (kq + 16 * i) * 65 + n4; tp[0] = v[i].x; tp[1] = v[i].y; tp[2] = v[i].z; tp[3] = v[i].w; }
  }
  __syncthreads();
#pragma unroll
  for (int i = 0; i < 2; ++i) {
    int c = tid & 7, n = (tid >> 3) + 32 * i;
    if (n0 + n < N) {
      float f[8];
#pragma unroll
      for (int e = 0; e < 8; ++e) f[e] = t[(c * 8 + e) * 65 + n];
      if (jb.g_idx >= 0) {
        const float* gp = p.in[jb.g_idx] + jb.g_off + z + k0 + c * 8;
#pragma unroll
        for (int e = 0; e < 8; ++e) f[e] *= gp[e];
      }
      int nrow = n0 + n;
      if (jb.perm) { int c0 = n0 >= FF ? n0 - FF : n0; nrow = (c0 >> 6) * 128 + (n0 >= FF ? 64 : 0) + n; }
      *(v4u*)(dst + (size_t)nrow * K + k0 + c * 8) = pack8(f);
    }
  }
}

DI void pack_k_task(const u16* __restrict__ src, int ld, int col0, int NH, u16* __restrict__ dst, const float* __restrict__ rope, int task) {
  int t = task & (S_ - 1); int rest = task >> 13; int hs = rest % NH; int b = rest / NH;
  const u16* row = src + (size_t)(b * S_ + t) * ld + col0 + hs * 64;
  v4u c[8];
#pragma unroll
  for (int i = 0; i < 8; ++i) c[i] = *(const v4u*)(row + 8 * i);
  float x1[8], x2[8], o1[8], o2[8];
  unpack8(c[0], x1); unpack8(c[1], x2);
  const float* rt = rope + (size_t)t * 16;
#pragma unroll
  for (int i = 0; i < 8; ++i) { float cs = rt[i], sn = rt[8 + i]; o1[i] = x1[i] * cs - x2[i] * sn; o2[i] = x2[i] * cs + x1[i] * sn; }
  c[0] = pack8(o1); c[1] = pack8(o2);
  u16* d = dst + (size_t)(b * NH + hs) * S_ * 64;
#pragma unroll
  for (int i = 0; i < 8; ++i) *(v4u*)(d + kfrag_chunk(t, i)) = c[i];
}
template <int NDVT>
DI void pack_v_task(const u16* __restrict__ src, int ld, int col0, int NH, u16* __restrict__ dst, int task) {
  int ln = task & 63; int s = (task >> 6) & 3; int rest = task >> 8; int dvt = rest % NDVT; rest /= NDVT; int tile = rest & 127; rest >>= 7; int hs = rest % NH; int b = rest / NH;
  int h = ln >> 5, dv = dvt * 32 + (ln & 31);
  const u16* base = src + (size_t)(b * S_ + tile * 64 + 16 * s + 4 * h) * ld + col0 + hs * (32 * NDVT) + dv;
  u16 v[8];
#pragma unroll
  for (int j = 0; j < 8; ++j) { int kk = 8 * (j >> 2) + (j & 3); v[j] = base[(size_t)kk * ld]; }
  v4u o = mk4(v[0] | ((unsigned)v[1] << 16), v[2] | ((unsigned)v[3] << 16), v[4] | ((unsigned)v[5] << 16), v[6] | ((unsigned)v[7] << 16));
  u16* d = dst + (size_t)(b * NH + hs) * S_ * (32 * NDVT);
  *(v4u*)(d + ((size_t)(((tile * NDVT + dvt) * 4 + s) * 64 + ln)) * 8) = o;
}

DI bf16x8 rope_q(const u16* __restrict__ qrow, const float* __restrict__ rt, int h) {
  v4u a = *(const v4u*)qrow, b = *(const v4u*)(qrow + 8);
  float x1[8], x2[8], o[8];
  unpack8(a, x1); unpack8(b, x2);
#pragma unroll
  for (int i = 0; i < 8; ++i) { float cs = rt[i], sn = rt[8 + i]; o[i] = h == 0 ? (x1[i] * cs - x2[i] * sn) : (x2[i] * cs + x1[i] * sn); }
  v4u r = pack8(o);
  return __builtin_bit_cast(bf16x8, r);
}

template <int NDVT, int MODE>
DI void attn_stream(const u16* __restrict__ Kf, const u16* __restrict__ Vf, int tb, int te, const unsigned* umask,
                    const bf16x8 (&q)[4], f32x16 (&O)[NDVT], float& m, float& l, int t, int tmin, int tmax, const unsigned* selw, char* lds) {
  constexpr int NCH = 2 + NDVT;
  constexpr int TILE_B = NCH * 4096;
  const int tid = get_tid(), lane = tid & 63, h = lane >> 5;
  v4u pre[NCH];
#define ATT_VALID(i_) (MODE != 2 || ((umask[(i_) >> 5] >> ((i_) & 31)) & 1u))
#define ATT_GLOAD(i_)                                                                                   \
  {                                                                                                     \
    const u16* kp = Kf + (size_t)(i_) * 4096;                                                           \
    const u16* vp = Vf + (size_t)(i_) * (2048 * NDVT);                                                  \
    _Pragma("unroll") for (int c = 0; c < 2; ++c) pre[c] = *(const v4u*)(kp + (c * 256 + tid) * 8);   \
    _Pragma("unroll") for (int c = 0; c < NDVT; ++c) pre[2 + c] = *(const v4u*)(vp + (c * 256 + tid) * 8); \
  }
  int i = tb;
  while (i < te && !ATT_VALID(i)) ++i;
  __syncthreads();
  if (i < te) ATT_GLOAD(i)
  int buf = 0;
  while (i < te) {
    char* tl = lds + buf * TILE_B;
#pragma unroll
    for (int c = 0; c < NCH; ++c) *(v4u*)(tl + (c * 256 + tid) * 16) = pre[c];
    __syncthreads();
    int nx = i + 1;
    while (nx < te && !ATT_VALID(nx)) ++nx;
    if (nx < te) ATT_GLOAD(nx)
    bool tok_ok = true;
    if (MODE == 2) tok_ok = (selw[i >> 5] >> (i & 31)) & 1u;
    if (MODE != 2 || __any(tok_ok)) {
    f32x16 S0, S1;
#pragma unroll
    for (int e = 0; e < 16; ++e) { S0[e] = 0.f; S1[e] = 0.f; }
    bf16x8 kf[8];
#pragma unroll
    for (int j = 0; j < 8; ++j) kf[j] = *(const bf16x8*)(tl + (j * 64 + lane) * 16);
    __builtin_amdgcn_sched_barrier(0);
#pragma unroll
    for (int s = 0; s < 4; ++s) { S0 = MFMA(kf[s], q[s], S0); S1 = MFMA(kf[4 + s], q[s], S1); }
    __builtin_amdgcn_sched_barrier(0);
    bf16x8 vf[8];
#pragma unroll
    for (int j = 0; j < 8; ++j) vf[j] = *(const bf16x8*)(tl + 8192 + (j * 64 + lane) * 16);
    __builtin_amdgcn_sched_barrier(0);
    bool full = (i * 64 + 63 <= tmin);
    if (MODE == 1) full = full && (i * 64 > tmax - 512);
    if (!full) {
      const int kb = i * 64 + 4 * h;
#pragma unroll
      for (int e = 0; e < 16; ++e) {
        int k0 = kb + 8 * (e >> 2) + (e & 3), k1 = k0 + 32;
        bool v0 = (k0 <= t), v1 = (k1 <= t);
        if (MODE == 1) { v0 = v0 && (k0 > t - 512); v1 = v1 && (k1 > t - 512); }
        S0[e] = v0 ? S0[e] : -INFINITY; S1[e] = v1 ? S1[e] : -INFINITY;
      }
    }
    float mx = fmaxf(S0[0], S1[0]);
#pragma unroll
    for (int e = 1; e < 16; ++e) mx = fmaxf(mx, fmaxf(S0[e], S1[e]));
    if (MODE == 2) mx = tok_ok ? mx : -INFINITY;
    mx = fmaxf(mx, __shfl_xor(mx, 32));
    float mnew = fmaxf(m, mx);
    if (__any(mnew > m)) {
      float f = __builtin_amdgcn_exp2f((m - mnew) * SC);
      l *= f;
#pragma unroll
      for (int d = 0; d < NDVT; ++d)
#pragma unroll
        for (int e = 0; e < 16; ++e) O[d][e] *= f;
    }
    m = mnew;
    const float nb = (MODE == 2 && !tok_ok) ? -INFINITY : -(m * SC);
    float ls = 0.f;
#pragma unroll
    for (int e = 0; e < 16; ++e) {
      S0[e] = __builtin_amdgcn_exp2f(fmaf(S0[e], SC, nb));
      S1[e] = __builtin_amdgcn_exp2f(fmaf(S1[e], SC, nb));
      ls += S0[e] + S1[e];
    }
    l += ls;
    bf16x8 pf[4];
    pf[0] = pack_frag(S0, 0); pf[1] = pack_frag(S0, 1); pf[2] = pack_frag(S1, 0); pf[3] = pack_frag(S1, 1);
    if constexpr (NDVT == 4) {
      bf16x8 vg[8];
#pragma unroll
      for (int j = 0; j < 8; ++j) vg[j] = *(const bf16x8*)(tl + 8192 + ((8 + j) * 64 + lane) * 16);
      __builtin_amdgcn_sched_barrier(0);
#pragma unroll
      for (int d = 0; d < 2; ++d)
#pragma unroll
        for (int s = 0; s < 4; ++s) O[d] = MFMA(vf[d * 4 + s], pf[s], O[d]);
#pragma unroll
      for (int d = 0; d < 2; ++d)
#pragma unroll
        for (int s = 0; s < 4; ++s) O[2 + d] = MFMA(vg[d * 4 + s], pf[s], O[2 + d]);
    } else {
#pragma unroll
      for (int d = 0; d < 2; ++d)
#pragma unroll
        for (int s = 0; s < 4; ++s) O[d] = MFMA(vf[d * 4 + s], pf[s], O[d]);
    }
    __builtin_amdgcn_sched_barrier(0);
    }
    i = nx; buf ^= 1;
  }
}

constexpr int LDS_IMP = 32768, LDS_SELW = 49152, LDS_UMASK = 49152 + 512;
DI void nsa_attn_item(const Params& p, int item, char* smem) {
  const int tid = get_tid(), lane = tid & 63, w = tid >> 6, n = lane & 31, h = lane >> 5;
  const int bh = item & 7, qt = 255 - (item >> 3), b = bh >> 2, hk = bh & 3, t0 = qt * 32, cur = t0 >> 6;
  const int tokl = w * 8 + (n >> 2), g = n & 3, t = t0 + tokl, head = hk * 4 + g;
  const int twmin = t0 + __builtin_amdgcn_readfirstlane(w) * 8;
  const size_t R = (size_t)b * S_ + t;
  const u16* proj = (const u16*)(p.ws + OFF_PROJ);
  const float* rope = (const float*)(p.ws + OFF_ROPE);
  const u16* qrow = proj + R * LDP + head * 64;
  bf16x8 q[4], qr0;
#pragma unroll
  for (int s = 0; s < 4; ++s) q[s] = *(const bf16x8*)(qrow + 16 * s + 8 * h);
  qr0 = rope_q(qrow, rope + (size_t)t * 16, h);
  float gate[3];
#pragma unroll
  for (int j = 0; j < 3; ++j) { float x = bf1(proj[R * LDP + 2560 + head * 3 + j]); gate[j] = 1.f / (1.f + __expf(-x)); }
  float* imp = (float*)(smem + LDS_IMP) + w * 1024;
  unsigned* selw_all = (unsigned*)(smem + LDS_SELW);
  unsigned* umask = (unsigned*)(smem + LDS_UMASK);
  __syncthreads();
#pragma unroll
  for (int i = 0; i < 16; ++i) imp[i * 64 + lane] = 0.f;
  if (tid < 4) umask[tid] = 0u;
  __syncthreads();

  f32x16 Ot[2], Ob[2];
  {
    const int ncmax = (t0 >> 4) + 1;
    const int ntile = (ncmax + 63) >> 6;
    const u16* Kc = (const u16*)(p.ws + OFF_KCF) + (size_t)(b * 4 + hk) * 512 * 64;
    const u16* Vc = (const u16*)(p.ws + OFF_VCF) + (size_t)(b * 4 + hk) * 512 * 64;
    float m = -1e30f, l = 0.f;
    bf16x8 kc[8], kn[8];
#pragma unroll
    for (int j = 0; j < 8; ++j) kc[j] = *(const bf16x8*)(Kc + (j * 64 + lane) * 8);
    for (int i = 0; i < ntile; ++i) {
      const int inx = i + 1 < ntile ? i + 1 : i;
#pragma unroll
      for (int j = 0; j < 8; ++j) kn[j] = *(const bf16x8*)(Kc + (size_t)inx * 4096 + (j * 64 + lane) * 8);
      f32x16 S0, S1;
#pragma unroll
      for (int e = 0; e < 16; ++e) { S0[e] = 0.f; S1[e] = 0.f; }
#pragma unroll
      for (int s = 0; s < 4; ++s) { S0 = MFMA(kc[s], q[s], S0); S1 = MFMA(kc[4 + s], q[s], S1); }
#pragma unroll
      for (int j = 0; j < 8; ++j) kc[j] = kn[j];
      const int cb = i * 64 + 4 * h;
      float mx = -INFINITY;
#pragma unroll
      for (int e = 0; e < 16; ++e) {
        int c0 = cb + 8 * (e >> 2) + (e & 3), c1 = c0 + 32;
        S0[e] = (16 * c0 + 31 <= t) ? S0[e] : -INFINITY; S1[e] = (16 * c1 + 31 <= t) ? S1[e] : -INFINITY;
        mx = fmaxf(mx, fmaxf(S0[e], S1[e]));
      }
      mx = fmaxf(mx, __shfl_xor(mx, 32));
      float mnew = fmaxf(m, mx);
      l *= __builtin_amdgcn_exp2f((m - mnew) * SC);
      m = mnew;
      const float msc = m * SC;
      float ls = 0.f;
#pragma unroll
      for (int e = 0; e < 16; ++e) ls += __builtin_amdgcn_exp2f(fmaf(S0[e], SC, -msc)) + __builtin_amdgcn_exp2f(fmaf(S1[e], SC, -msc));
      l += ls;
    }
    l += __shfl_xor(l, 32);
    const float invl = l > 0.f ? 1.f / l : 0.f;
    const float msc = m * SC;
#pragma unroll
    for (int d = 0; d < 2; ++d)
#pragma unroll
      for (int e = 0; e < 16; ++e) Ob[d][e] = 0.f;
    float* impt = imp + (n >> 2) * 128;
#pragma unroll
    for (int j = 0; j < 8; ++j) kc[j] = *(const bf16x8*)(Kc + (j * 64 + lane) * 8);
    for (int i = 0; i < ntile; ++i) {
      const int inx = i + 1 < ntile ? i + 1 : i;
      bf16x8 vc[8];
#pragma unroll
      for (int j = 0; j < 8; ++j) vc[j] = *(const bf16x8*)(Vc + (size_t)i * 4096 + (j * 64 + lane) * 8);
#pragma unroll
      for (int j = 0; j < 8; ++j) kn[j] = *(const bf16x8*)(Kc + (size_t)inx * 4096 + (j * 64 + lane) * 8);
      f32x16 S0, S1;
#pragma unroll
      for (int e = 0; e < 16; ++e) { S0[e] = 0.f; S1[e] = 0.f; }
#pragma unroll
      for (int s = 0; s < 4; ++s) { S0 = MFMA(kc[s], q[s], S0); S1 = MFMA(kc[4 + s], q[s], S1); }
#pragma unroll
      for (int j = 0; j < 8; ++j) kc[j] = kn[j];
      const int cb = i * 64 + 4 * h;
#pragma unroll
      for (int e = 0; e < 16; ++e) {
        int c0 = cb + 8 * (e >> 2) + (e & 3), c1 = c0 + 32;
        S0[e] = (16 * c0 + 31 <= t) ? __builtin_amdgcn_exp2f(fmaf(S0[e], SC, -msc)) * invl : 0.f;
        S1[e] = (16 * c1 + 31 <= t) ? __builtin_amdgcn_exp2f(fmaf(S1[e], SC, -msc)) * invl : 0.f;
      }
#pragma unroll
      for (int rt = 0; rt < 2; ++rt)
#pragma unroll
        for (int r = 0; r < 4; ++r) {
          float a0 = rt == 0 ? S0[4 * r] : S1[4 * r], a1 = rt == 0 ? S0[4 * r + 1] : S1[4 * r + 1];
          float a2 = rt == 0 ? S0[4 * r + 2] : S1[4 * r + 2], a3 = rt == 0 ? S0[4 * r + 3] : S1[4 * r + 3];
          float A = (a0 + a1) + (a2 + a3), L = a3;
          A += __shfl_xor(A, 1); L += __shfl_xor(L, 1);
          A += __shfl_xor(A, 2); L += __shfl_xor(L, 2);
          int nb = i * 16 + rt * 8 + 2 * r + h;
          if (g == 0) { atomicAdd(&impt[nb], A); if (nb + 1 < 128) atomicAdd(&impt[nb + 1], L); }
        }
      bf16x8 pf[4];
      pf[0] = pack_frag(S0, 0); pf[1] = pack_frag(S0, 1); pf[2] = pack_frag(S1, 0); pf[3] = pack_frag(S1, 1);
#pragma unroll
      for (int d = 0; d < 2; ++d)
#pragma unroll
        for (int s = 0; s < 4; ++s) Ob[d] = MFMA(vc[d * 4 + s], pf[s], Ob[d]);
    }
#pragma unroll
    for (int d = 0; d < 2; ++d)
#pragma unroll
      for (int e = 0; e < 16; ++e) Ot[d][e] = gate[0] * Ob[d][e];
  }
  {
    const int hi = cur - 2;
    for (int tk = 0; tk < 8; ++tk) {
      const float* ip = imp + tk * 128;
      const int n0 = lane, n1 = lane + 64;
      bool s0, s1;
      if (hi > 13) {
        const unsigned k0 = (n0 >= 1 && n0 <= hi) ? (__float_as_uint(ip[n0]) + 1u) : 0u;
        const unsigned k1 = (n1 <= hi) ? (__float_as_uint(ip[n1]) + 1u) : 0u;
        unsigned prefix = 0u;
        for (int bit = 31; bit >= 0; --bit) {
          const unsigned trial = prefix | (1u << bit);
          const int cnt = __popcll(__ballot(k0 >= trial)) + __popcll(__ballot(k1 >= trial));
          if (cnt >= 13) prefix = trial;
        }
        const unsigned long long g0 = __ballot(k0 > prefix), g1 = __ballot(k1 > prefix);
        const unsigned long long e0 = __ballot(k0 == prefix), e1 = __ballot(k1 == prefix);
        const int extra = 13 - (__popcll(g0) + __popcll(g1));
        const unsigned long long below = (1ull << lane) - 1ull;
        const int r0 = __popcll(e0 & below), r1 = __popcll(e0) + __popcll(e1 & below);
        const bool t0 = (k0 > prefix) || (k0 == prefix && r0 < extra);
        const bool t1 = (k1 > prefix) || (k1 == prefix && r1 < extra);
        s0 = (n0 == 0) || (n0 <= cur && n0 >= cur - 1) || t0;
        s1 = (n1 <= cur && n1 >= cur - 1) || t1;
      } else { s0 = n0 <= cur; s1 = n1 <= cur; }
      unsigned long long b0 = __ballot(s0), b1 = __ballot(s1);
      if (lane == 0) {
        unsigned* sw = selw_all + (w * 8 + tk) * 4;
        sw[0] = (unsigned)b0; sw[1] = (unsigned)(b0 >> 32); sw[2] = (unsigned)b1; sw[3] = (unsigned)(b1 >> 32);
        atomicOr(&umask[0], (unsigned)b0); atomicOr(&umask[1], (unsigned)(b0 >> 32));
        atomicOr(&umask[2], (unsigned)b1); atomicOr(&umask[3], (unsigned)(b1 >> 32));
      }
    }
  }
  __syncthreads();
  bf16x8 qr[4] = {qr0, q[1], q[2], q[3]};
  {
    float m = -1e30f, l = 0.f;
#pragma unroll
    for (int d = 0; d < 2; ++d)
#pragma unroll
      for (int e = 0; e < 16; ++e) Ob[d][e] = 0.f;
    const u16* Kf = (const u16*)(p.ws + OFF_KSF) + (size_t)(b * 4 + hk) * S_ * 64;
    const u16* Vf = (const u16*)(p.ws + OFF_VSF) + (size_t)(b * 4 + hk) * S_ * 64;
    attn_stream<2, 2>(Kf, Vf, 0, cur + 1, umask, qr, Ob, m, l, t, twmin, twmin + 7, selw_all + tokl * 4, smem);
    l += __shfl_xor(l, 32);
    const float f = gate[1] / l;
#pragma unroll
    for (int d = 0; d < 2; ++d)
#pragma unroll
      for (int e = 0; e < 16; ++e) Ot[d][e] += f * Ob[d][e];
  }
  {
    float m = -1e30f, l = 0.f;
#pragma unroll
    for (int d = 0; d < 2; ++d)
#pragma unroll
      for (int e = 0; e < 16; ++e) Ob[d][e] = 0.f;
    const u16* Kf = (const u16*)(p.ws + OFF_KWF) + (size_t)(b * 4 + hk) * S_ * 64;
    const u16* Vf = (const u16*)(p.ws + OFF_VWF) + (size_t)(b * 4 + hk) * S_ * 64;
    int lo = t0 - 511; lo = lo < 0 ? 0 : lo;
    attn_stream<2, 1>(Kf, Vf, lo >> 6, ((t0 + 31) >> 6) + 1, nullptr, qr, Ob, m, l, t, twmin, twmin + 7, nullptr, smem);
    l += __shfl_xor(l, 32);
    const float f = gate[2] / l;
#pragma unroll
    for (int d = 0; d < 2; ++d)
#pragma unroll
      for (int e = 0; e < 16; ++e) Ot[d][e] += f * Ob[d][e];
  }
  u16* ao = (u16*)(p.ws + OFF_H) + R * D_ + head * 64;
#pragma unroll
  for (int d = 0; d < 2; ++d)
#pragma unroll
    for (int r = 0; r < 4; ++r)
      *(v2u*)(ao + d * 32 + 8 * r + 4 * h) = mk2(pk2(Ot[d][4 * r], Ot[d][4 * r + 1]), pk2(Ot[d][4 * r + 2], Ot[d][4 * r + 3]));
}

DI size_t kfrag16_chunk(int key, int c  ) { return ((size_t)((((key >> 6) * 8 + ((key >> 4) & 3) * 2 + (c >> 2)) * 64) + (c & 3) * 16 + (key & 15))) * 8; }
DI void pack_k16_task(const u16* __restrict__ src, int ld, int col0, int NH, u16* __restrict__ dst, const float* __restrict__ rope, int task) {
  int t = task & (S_ - 1); int rest = task >> 13; int hs = rest % NH; int b = rest / NH;
  const u16* row = src + (size_t)(b * S_ + t) * ld + col0 + hs * 64;
  v4u c[8];
#pragma unroll
  for (int i = 0; i < 8; ++i) c[i] = *(const v4u*)(row + 8 * i);
  float x1[8], x2[8], o1[8], o2[8];
  unpack8(c[0], x1); unpack8(c[1], x2);
  const float* rt = rope + (size_t)t * 16;
#pragma unroll
  for (int i = 0; i < 8; ++i) { float cs = rt[i], sn = rt[8 + i]; o1[i] = x1[i] * cs - x2[i] * sn; o2[i] = x2[i] * cs + x1[i] * sn; }
  c[0] = pack8(o1); c[1] = pack8(o2);
  u16* d = dst + (size_t)(b * NH + hs) * S_ * 64;
#pragma unroll
  for (int i = 0; i < 8; ++i) *(v4u*)(d + kfrag16_chunk(t, i)) = c[i];
}
DI void pack_v16_task(const u16* __restrict__ src, int ld, int col0, int NH, u16* __restrict__ dst, int task) {
  int ln = task & 63; int s = (task >> 6) & 1; int dvt = (task >> 7) & 7; int rest = task >> 10; int tile = rest & 127; rest >>= 7; int hs = rest % NH; int b = rest / NH;
  const int lq = ln >> 4, dv = dvt * 16 + (ln & 15);
  const u16* base = src + (size_t)(b * S_ + tile * 64 + 32 * s + 4 * lq) * ld + col0 + hs * 128 + dv;
  u16 v[8];
#pragma unroll
  for (int j = 0; j < 8; ++j) { int kk = 16 * (j >> 2) + (j & 3); v[j] = base[(size_t)kk * ld]; }
  v4u o = mk4(v[0] | ((unsigned)v[1] << 16), v[2] | ((unsigned)v[3] << 16), v[4] | ((unsigned)v[5] << 16), v[6] | ((unsigned)v[7] << 16));
  u16* d = dst + (size_t)(b * NH + hs) * S_ * 128;
  *(v4u*)(d + ((size_t)(((tile * 8 + dvt) * 2 + s) * 64 + ln)) * 8) = o;
}
DI bf16x8 pack2x4(const f32x4& a, const f32x4& b) {
  v4u r = mk4(pk2(a[0], a[1]), pk2(a[2], a[3]), pk2(b[0], b[1]), pk2(b[2], b[3]));
  return __builtin_bit_cast(bf16x8, r);
}
DI void diff_attn_item(const Params& p, int item, char* smem) {
  const int tid = get_tid(), lane = tid & 63, l15 = lane & 15, lq = lane >> 4;
  const int wv = __builtin_amdgcn_readfirstlane(tid >> 6);
  const int bhc = item & 31, qt = 63 - (item >> 5), b = bhc >> 4, hc = bhc & 15, t0 = qt * 128;
  const int twmin = t0 + wv * 32;
  const float* rope = (const float*)(p.ws + OFF_ROPE);
  int tq[2]; bf16x8 qf[2][2];
#pragma unroll
  for (int ct = 0; ct < 2; ++ct) {
    tq[ct] = twmin + ct * 16 + l15;
    const u16* qrow = (const u16*)(p.ws + OFF_Q) + ((size_t)b * S_ + tq[ct]) * D_ + hc * 64;
    qf[ct][1] = *(const bf16x8*)(qrow + 32 + lq * 8);
    bf16x8 raw = *(const bf16x8*)(qrow + lq * 8);
    bf16x8 rp = rope_q(qrow, rope + (size_t)tq[ct] * 16, lq & 1);
    qf[ct][0] = lq < 2 ? rp : raw;
  }
  f32x4 O[8][2];
#pragma unroll
  for (int d = 0; d < 8; ++d)
#pragma unroll
    for (int ct = 0; ct < 2; ++ct)
#pragma unroll
      for (int e = 0; e < 4; ++e) O[d][ct][e] = 0.f;
  float m[2] = {-1e30f, -1e30f}, l[2] = {0.f, 0.f};
  const u16* Kf = (const u16*)(p.ws + OFF_SKVK) + (size_t)(b * 16 + hc) * S_ * 64;
  const u16* Vf = (const u16*)(p.ws + OFF_SKVV) + (size_t)(b * 8 + (hc >> 1)) * S_ * 128;
  const int te = 2 * qt + 2;
  constexpr int TILE_B = 24576;
  v4u pre[6];
#define D16_GLOAD(i_)                                                                                  \
  { const u16* kp = Kf + (size_t)(i_) * 4096; const u16* vp = Vf + (size_t)(i_) * 8192;                 \
    _Pragma("unroll") for (int c = 0; c < 2; ++c) pre[c] = *(const v4u*)(kp + (c * 256 + tid) * 8);    \
    _Pragma("unroll") for (int c = 0; c < 4; ++c) pre[2 + c] = *(const v4u*)(vp + (c * 256 + tid) * 8); }
  __syncthreads();
  D16_GLOAD(0)
  int buf = 0;
  for (int i = 0; i < te; ++i) {
    char* tl = smem + buf * TILE_B;
#pragma unroll
    for (int c = 0; c < 6; ++c) *(v4u*)(tl + (c * 256 + tid) * 16) = pre[c];
    __syncthreads();
    if (i + 1 < te) D16_GLOAD(i + 1)
    f32x4 S[4][2];
#pragma unroll
    for (int rt = 0; rt < 4; ++rt)
#pragma unroll
      for (int ct = 0; ct < 2; ++ct)
#pragma unroll
        for (int e = 0; e < 4; ++e) S[rt][ct][e] = 0.f;
    bf16x8 kf[8];
#pragma unroll
    for (int f = 0; f < 8; ++f) kf[f] = *(const bf16x8*)(tl + (f * 64 + lane) * 16);
    __builtin_amdgcn_sched_barrier(0);
#pragma unroll
    for (int rt = 0; rt < 4; ++rt)
#pragma unroll
      for (int ks = 0; ks < 2; ++ks)
#pragma unroll
        for (int ct = 0; ct < 2; ++ct) S[rt][ct] = MFMA16(kf[rt * 2 + ks], qf[ct][ks], S[rt][ct]);
    __builtin_amdgcn_sched_barrier(0);
    bf16x8 vf[8];
#pragma unroll
    for (int f = 0; f < 8; ++f) vf[f] = *(const bf16x8*)(tl + 8192 + (f * 64 + lane) * 16);
    __builtin_amdgcn_sched_barrier(0);
    if (!(i * 64 + 63 <= twmin)) {
#pragma unroll
      for (int rt = 0; rt < 4; ++rt)
#pragma unroll
        for (int ct = 0; ct < 2; ++ct)
#pragma unroll
          for (int e = 0; e < 4; ++e) { const int key = i * 64 + rt * 16 + 4 * lq + e; S[rt][ct][e] = key <= tq[ct] ? S[rt][ct][e] : -INFINITY; }
    }
    float mn[2]; bool grow = false;
#pragma unroll
    for (int ct = 0; ct < 2; ++ct) {
      float mx = fmaxf(fmaxf(S[0][ct][0], S[0][ct][1]), fmaxf(S[0][ct][2], S[0][ct][3]));
#pragma unroll
      for (int rt = 1; rt < 4; ++rt) mx = fmaxf(mx, fmaxf(fmaxf(S[rt][ct][0], S[rt][ct][1]), fmaxf(S[rt][ct][2], S[rt][ct][3])));
      mx = fmaxf(mx, __shfl_xor(mx, 16));
      mx = fmaxf(mx, __shfl_xor(mx, 32));
      mn[ct] = fmaxf(m[ct], mx);
      grow = grow || (mn[ct] > m[ct]);
    }
    if (__any(grow)) {
#pragma unroll
      for (int ct = 0; ct < 2; ++ct) {
        const float f = __builtin_amdgcn_exp2f((m[ct] - mn[ct]) * SC);
        l[ct] *= f;
#pragma unroll
        for (int d = 0; d < 8; ++d)
#pragma unroll
          for (int e = 0; e < 4; ++e) O[d][ct][e] *= f;
      }
    }
    bf16x8 pf[2][2];
#pragma unroll
    for (int ct = 0; ct < 2; ++ct) {
      m[ct] = mn[ct];
      const float nb = -(m[ct] * SC);
      float ls = 0.f;
#pragma unroll
      for (int rt = 0; rt < 4; ++rt)
#pragma unroll
        for (int e = 0; e < 4; ++e) { S[rt][ct][e] = __builtin_amdgcn_exp2f(fmaf(S[rt][ct][e], SC, nb)); ls += S[rt][ct][e]; }
      l[ct] += ls;
      pf[0][ct] = pack2x4(S[0][ct], S[1][ct]);
      pf[1][ct] = pack2x4(S[2][ct], S[3][ct]);
    }
    bf16x8 vg[8];
#pragma unroll
    for (int f = 0; f < 8; ++f) vg[f] = *(const bf16x8*)(tl + 8192 + ((8 + f) * 64 + lane) * 16);
    __builtin_amdgcn_sched_barrier(0);
#pragma unroll
    for (int d = 0; d < 4; ++d)
#pragma unroll
      for (int s = 0; s < 2; ++s)
#pragma unroll
        for (int ct = 0; ct < 2; ++ct) O[d][ct] = MFMA16(vf[d * 2 + s], pf[s][ct], O[d][ct]);
#pragma unroll
    for (int d = 0; d < 4; ++d)
#pragma unroll
      for (int s = 0; s < 2; ++s)
#pragma unroll
        for (int ct = 0; ct < 2; ++ct) O[4 + d][ct] = MFMA16(vg[d * 2 + s], pf[s][ct], O[4 + d][ct]);
    __builtin_amdgcn_sched_barrier(0);
    buf ^= 1;
  }
#pragma unroll
  for (int ct = 0; ct < 2; ++ct) {
    float lt = l[ct];
    lt += __shfl_xor(lt, 16);
    lt += __shfl_xor(lt, 32);
    const float f = 1.f / lt;
    u16* op = (u16*)(p.ws + OFF_KVRAW) + (((size_t)b * S_ + tq[ct]) * 16 + hc) * 128;
#pragma unroll
    for (int d = 0; d < 8; ++d)
      *(v2u*)(op + d * 16 + 4 * lq) = mk2(pk2(O[d][ct][0] * f, O[d][ct][1] * f), pk2(O[d][ct][2] * f, O[d][ct][3] * f));
  }
}

DI void conv_task(const u16* __restrict__ u, u16* __restrict__ act, const float* __restrict__ cw, const float* __restrict__ cbias, int task) {
  const int ck = task % 344, rr = task / 344;
  const int j0 = ck * 8, ts = rr * 16;
  float wg[3][8], wv[3][8], bg[8], bv[8], g1[8], g2[8], v1[8], v2[8];
#pragma unroll
  for (int e = 0; e < 8; ++e) {
#pragma unroll
    for (int tp = 0; tp < 3; ++tp) { wg[tp][e] = cw[tp * FF2 + j0 + e]; wv[tp][e] = cw[tp * FF2 + FF + j0 + e]; }
    bg[e] = cbias[j0 + e]; bv[e] = cbias[FF + j0 + e];
    g1[e] = g2[e] = v1[e] = v2[e] = 0.f;
  }
  if (ts > 0) {
    unpack8(*(const v4u*)(u + (size_t)(ts - 1) * FF2 + j0), g1); unpack8(*(const v4u*)(u + (size_t)(ts - 1) * FF2 + FF + j0), v1);
    unpack8(*(const v4u*)(u + (size_t)(ts - 2) * FF2 + j0), g2); unpack8(*(const v4u*)(u + (size_t)(ts - 2) * FF2 + FF + j0), v2);
  }
#pragma unroll 4
  for (int r = 0; r < 16; ++r) {
    const int t = ts + r;
    float gc[8], vc[8], o[8];
    unpack8(*(const v4u*)(u + (size_t)t * FF2 + j0), gc); unpack8(*(const v4u*)(u + (size_t)t * FF2 + FF + j0), vc);
#pragma unroll
    for (int e = 0; e < 8; ++e) {
      float cgv = bg[e] + wg[0][e] * g2[e] + wg[1][e] * g1[e] + wg[2][e] * gc[e];
      float cvv = bv[e] + wv[0][e] * v2[e] + wv[1][e] * v1[e] + wv[2][e] * vc[e];
      o[e] = cgv / (1.f + __expf(-cgv)) * cvv;
      g2[e] = g1[e]; g1[e] = gc[e]; v2[e] = v1[e]; v1[e] = vc[e];
    }
    *(v4u*)(act + (size_t)t * FF + j0) = pack8(o);
  }
}

DI void diff_comb_row(const Params& p, int j, int layer, int row, int lane) {
  const float* lv = p.in[12] + j * 256;
  float sa = wave_sum(lv[lane] * lv[64 + lane]), sb = wave_sum(lv[128 + lane] * lv[192 + lane]);
  const float lam_init = 0.8f - 0.6f * expf(-0.3f * (float)layer);
  const float lam = expf(sa) - expf(sb) + lam_init;
  const int head = lane >> 3, part = lane & 7;
  const u16* o0 = (const u16*)(p.ws + OFF_KVRAW) + ((size_t)row * 16 + head * 2) * 128 + part * 16;
  const u16* o1 = o0 + 128;
  float a[16], bb[16];
  unpack8(*(const v4u*)o0, a); unpack8(*(const v4u*)(o0 + 8), a + 8);
  unpack8(*(const v4u*)o1, bb); unpack8(*(const v4u*)(o1 + 8), bb + 8);
  float ss = 0.f;
#pragma unroll
  for (int e = 0; e < 16; ++e) { a[e] = a[e] - lam * bb[e]; ss += a[e] * a[e]; }
  ss += __shfl_xor(ss, 1); ss += __shfl_xor(ss, 2); ss += __shfl_xor(ss, 4);
  const float r = rsqrtf(ss * (1.f / 128.f) + 1e-6f) * (1.f - lam_init);
  const float* sg = p.in[13] + j * 128 + part * 16;
#pragma unroll
  for (int e = 0; e < 16; ++e) a[e] = a[e] * r * sg[e];
  u16* dst = (u16*)(p.ws + OFF_H) + (size_t)row * D_ + head * 128 + part * 16;
  *(v4u*)dst = pack8(a); *(v4u*)(dst + 8) = pack8(a + 8);
}


#define XB_TMO      128
#define XB_XCNT(j)  (256  + 64 * (j))
#define XB_XSUB(j)  (1280 + 64 * (j))
#define XB_XGEN(j)  (2304 + 64 * (j))
#define XB_TOP      3328
#define XB_TOPGEN   3392
#define XCD_BAR_WORDS 3456
#define XB_SPIN_CAP (1u << 24)
#define LAS __attribute__((address_space(3)))
DI unsigned xb_ld(unsigned* p)              { return __hip_atomic_load(p, __ATOMIC_RELAXED, __HIP_MEMORY_SCOPE_AGENT); }
DI unsigned xb_add(unsigned* p, unsigned v) { return __hip_atomic_fetch_add(p, v, __ATOMIC_RELAXED, __HIP_MEMORY_SCOPE_AGENT); }
DI unsigned xb_xcc_id() { return (unsigned)__builtin_amdgcn_s_getreg((3 << 11) | 20) & 0xFu; }
#define XB_SPIN(cond, bar) do { unsigned _sp = 0; while (cond) { __builtin_amdgcn_s_sleep(1); \
    if ((++_sp & 255u) == 0u) { if (xb_ld(&(bar)[XB_TMO])) break; if (_sp > XB_SPIN_CAP) { atomicAdd(&(bar)[XB_TMO], 1u); break; } } } } while (0)
struct XcdBarrier { unsigned* bar; unsigned x; volatile LAS unsigned* st; };
DI XcdBarrier xcd_barrier_post(unsigned* bar, volatile LAS unsigned* st) {
  XcdBarrier b; b.bar = bar; b.x = xb_xcc_id(); b.st = st;
  if (__builtin_amdgcn_workitem_id_x() == 0) (void)xb_add(&bar[XB_XCNT(b.x)], 1u);
  return b;
}
DI void xcd_barrier_complete(unsigned* bar, unsigned x, unsigned& nloc, unsigned& nx) {
  const unsigned G = gridDim.x * gridDim.y * gridDim.z;
  unsigned sum, cnt, mine, sp = 0u;
  for (;;) {
    sum = 0u; cnt = 0u; mine = 0u;
#pragma unroll
    for (unsigned j = 0; j < 16; ++j) { const unsigned c = xb_ld(&bar[XB_XCNT(j)]); sum += c; cnt += (c > 0u) ? 1u : 0u; mine = (j == x) ? c : mine; }
    if (sum == G) break;
    __builtin_amdgcn_s_sleep(1);
    if ((++sp & 255u) == 0u) { if (xb_ld(&bar[XB_TMO])) break; if (sp > XB_SPIN_CAP) { atomicAdd(&bar[XB_TMO], 1u); break; } }
  }
  nloc = mine > 0u ? mine : 1u; nx = cnt > 0u ? cnt : 1u;
}
DI void xcd_barrier(const XcdBarrier& b) {
  asm volatile("s_waitcnt vmcnt(0)" ::: "memory");
  __syncthreads();
  if (__builtin_amdgcn_workitem_id_x() == 0) {
    unsigned* bar = b.bar;
    __builtin_amdgcn_s_waitcnt(0);
    unsigned nloc = b.st[0], nx = b.st[1];
    if (nloc == 0u) { xcd_barrier_complete(bar, b.x, nloc, nx); b.st[0] = nloc; b.st[1] = nx; }
    const unsigned old = xb_add(&bar[XB_XSUB(b.x)], 1u);
    const unsigned gen = old / nloc;
    if (old + 1u == (gen + 1u) * nloc) {
      __builtin_amdgcn_fence(__ATOMIC_RELEASE, "agent");
      asm volatile("s_waitcnt vmcnt(0)" ::: "memory");
      const unsigned og = xb_add(&bar[XB_TOP], 1u);
      const unsigned tg = og / nx;
      if (og + 1u == (tg + 1u) * nx) xb_add(&bar[XB_TOPGEN], 1u);
      else XB_SPIN(xb_ld(&bar[XB_TOPGEN]) == tg, bar);
      __builtin_amdgcn_fence(__ATOMIC_ACQUIRE, "agent");
      xb_add(&bar[XB_XGEN(b.x)], 1u);
      asm volatile("s_waitcnt vmcnt(0)" ::: "memory");
    } else {
      XB_SPIN(xb_ld(&bar[XB_XGEN(b.x)]) == gen, bar);
      __builtin_amdgcn_fence(__ATOMIC_ACQUIRE, "agent");
      asm volatile("s_waitcnt vmcnt(0)" ::: "memory");
    }
  }
  __syncthreads();
}

DI bool xcd_tile(int bid, int round, int G, int MT, int NT, int& tm, int& tn) {
  const int mx = MT >> 3, q = (bid >> 3) + (G >> 3) * round;
  if (q >= mx * NT) return false;
  tm = (bid & 7) * mx + q % mx; tn = q / mx;
  return true;
}
DI int snake(int r, int G, int j) { return r * G + ((r & 1) ? (G - 1 - j) : j); }

DI void run_step(const Params& pk, const Step st, char* smem) {
  const int G = gridDim.x, bid = get_bid(), tid = get_tid(), lane = tid & 63, wave = tid >> 6;
  const int L = st.layer;
  size_t z = 0;
  asm volatile("" : "+s"(z));
  Params p;
#pragma unroll
  for (int i = 0; i < 20; ++i) p.in[i] = pk.in[i] + z;
  p.out = pk.out + z;
  p.ws = pk.ws + z;
  char* ws = p.ws;
  float* xcur = p.out;
  switch (st.op) {
  case OP_PREP: {
    const int n_rope = 256, n_cb = 32, n_norm = 4096;
    const int total = N_TR_TILES + n_rope + n_cb + n_norm;
    int tj = 0, tbase = 0;
    for (int w = bid; w < total; w += G) {
      if (w < N_TR_TILES) { transpose_tile(pk, z, w, smem, tj, tbase); continue; }
      int k = w - N_TR_TILES;
      if (k < n_rope) {
        int idx = k * 256 + tid; int t = idx >> 3, i = idx & 7;
        float inv = powf(500000.f, -(float)i / 8.f);
        float ang = (float)t * inv;
        float* rp = (float*)(ws + OFF_ROPE) + (size_t)t * 16;
        rp[i] = cosf(ang); rp[8 + i] = sinf(ang);
        continue;
      }
      k -= n_rope;
      if (k < n_cb) {
        int lkv = k >> 3, j0 = (k & 7) * 32;
        int jj = tid & 31, kg = tid >> 5;
        const float* pe = p.in[5] + lkv * 2048;
        const float* w1 = p.in[6] + (size_t)lkv * 2048 * 256;
        float s = 0.f;
        for (int kk = kg * 256; kk < kg * 256 + 256; ++kk) s += pe[kk] * w1[(size_t)kk * 256 + j0 + jj];
        float* part = (float*)smem;
        __syncthreads();
        part[tid] = s;
        __syncthreads();
        if (tid < 32) { float a = p.in[7][lkv * 256 + j0 + tid]; for (int q = 0; q < 8; ++q) a += part[q * 32 + tid]; ((float*)(ws + OFF_CB))[lkv * 256 + j0 + tid] = a; }
        continue;
      }
      k -= n_cb;
      { int row = k * 4 + wave; prep_row_x(p.in[0] + (size_t)row * D_, (u16*)(ws + OFF_XB) + (size_t)row * D_, (float*)(ws + OFF_SSQ) + (size_t)row * 8, lane); }
    }
  } break;
  case OP_NORM: {
    const float* g = (st.aux ? p.in[2] : p.in[1]) + L * D_;
    for (int k = bid; k < 4096; k += G) { int row = k * 4 + wave; norm_row_bf16(xcur + (size_t)row * D_, g, (u16*)(ws + OFF_H) + (size_t)row * D_, lane); }
  } break;
  case OP_FINAL: {
    const u16* xbp = (const u16*)(ws + OFF_XB);
    for (int k = bid; k < 4096; k += 2 * G) {
      const int k2 = k + G;
      const size_t ra_ = (size_t)(k * 4 + wave) * D_, rc_ = (size_t)((k2 < 4096 ? k2 : k) * 4 + wave) * D_;
      v4u ua[2], uc[2];
#pragma unroll
      for (int q = 0; q < 2; ++q) { ua[q] = ((const v4u*)(xbp + ra_))[q * 64 + lane]; uc[q] = ((const v4u*)(xbp + rc_))[q * 64 + lane]; }
      float fa[16], fc[16];
      unpack8(ua[0], fa); unpack8(ua[1], fa + 8); unpack8(uc[0], fc); unpack8(uc[1], fc + 8);
      float sa = 0.f, sc = 0.f;
#pragma unroll
      for (int e2 = 0; e2 < 16; ++e2) { sa += fa[e2] * fa[e2]; sc += fc[e2] * fc[e2]; }
      sa = wave_sum(sa); sc = wave_sum(sc);
      const float ra = rsqrtf(sa * (1.f / 1024.f) + 1e-6f), rc = rsqrtf(sc * (1.f / 1024.f) + 1e-6f);
#pragma unroll
      for (int q = 0; q < 2; ++q) {
        const int c2 = (q * 64 + lane) * 2;
        const float4 g0 = ((const float4*)p.in[19])[c2], g1 = ((const float4*)p.in[19])[c2 + 1];
        ((float4*)(xcur + ra_))[c2] = make_float4(fa[q * 8] * ra * g0.x, fa[q * 8 + 1] * ra * g0.y, fa[q * 8 + 2] * ra * g0.z, fa[q * 8 + 3] * ra * g0.w);
        ((float4*)(xcur + ra_))[c2 + 1] = make_float4(fa[q * 8 + 4] * ra * g1.x, fa[q * 8 + 5] * ra * g1.y, fa[q * 8 + 6] * ra * g1.z, fa[q * 8 + 7] * ra * g1.w);
        if (k2 < 4096) {
          ((float4*)(xcur + rc_))[c2] = make_float4(fc[q * 8] * rc * g0.x, fc[q * 8 + 1] * rc * g0.y, fc[q * 8 + 2] * rc * g0.z, fc[q * 8 + 3] * rc * g0.w);
          ((float4*)(xcur + rc_))[c2 + 1] = make_float4(fc[q * 8 + 4] * rc * g1.x, fc[q * 8 + 5] * rc * g1.y, fc[q * 8 + 6] * rc * g1.z, fc[q * 8 + 7] * rc * g1.w);
        }
      }
    }
  } break;
  case OP_NSA_IN: {
    ARow af{(const u16*)(ws + OFF_XB), D_};
    EpiStoreT ep{(u16*)(ws + OFF_PROJ), LDP, (const float*)(ws + OFF_SSQ)};
    const u16* Bt = (const u16*)(ws + OFF_WNI) + (size_t)L * LDP * 1024;
    for (int r = 0, tm, tn; xcd_tile(bid, r, G, 128, 11, tm, tn); ++r) gemm_tile(af, Bt, LDP, 1024, tm * 128, tn * 256, ep, smem);
  } break;
  case OP_NSA_PACK: {
    const u16* proj = (const u16*)(ws + OFF_PROJ);
    const float* rope = (const float*)(ws + OFF_ROPE);
    const int n_g = 64, n_k = 2 * 256, n_v = 2 * 2048;
    for (int w = bid; w < n_g + n_k + n_v; w += G) {
      if (w < n_g) {
        int kv = w >> 5, lt = w & 31;
        ACmp af{proj, 1024 + kv * 256};
        EpiCmpFused ep{(const float*)(ws + OFF_CB) + (L * 2 + kv) * 256, (const u16*)(ws + OFF_WP2) + (size_t)(L * 2 + kv) * 64 * 256, (u16*)(ws + OFF_KCF), (u16*)(ws + OFF_VCF), kv};
        gemm_tile(af, (const u16*)(ws + OFF_WP1) + (size_t)(L * 2 + kv) * 256 * 2048, 256, 2048, lt * 128, 0, ep, smem);
        continue;
      }
      int k = w - n_g;
      if (k < n_k) {
        int str = k >> 8, task = (k & 255) * 256 + tid;
        pack_k_task(proj, LDP, 1024 + (str ? 1024 : 512), 4, (u16*)(ws + (str ? OFF_KWF : OFF_KSF)), rope, task);
        continue;
      }
      k -= n_k;
      { int str = k >> 11, task = (k & 2047) * 256 + tid;
        pack_v_task<2>(proj, LDP, 1024 + (str ? 1280 : 768), 4, (u16*)(ws + (str ? OFF_VWF : OFF_VSF)), task); }
    }
  } break;
  case OP_NSA_CMP2: {
    for (int w = bid; w < 64; w += G) {
      int kv = w >> 5, lt = w & 31;
      ARow af{(const u16*)(ws + OFF_HID) + (size_t)kv * 4096 * 256, 256};
      EpiCmpOut ep{(u16*)(ws + OFF_KCF), (u16*)(ws + OFF_VCF), kv};
      gemm_tile(af, (const u16*)(ws + OFF_WP2) + (size_t)(L * 2 + kv) * 64 * 256, 64, 256, lt * 128, 0, ep, smem);
    }
  } break;
  case OP_NSA_ATTN: {
    for (int r = 0;; ++r) { int it = snake(r, G, bid); if (r * G >= 2048) break; if (it < 2048) nsa_attn_item(p, it, smem); }
  } break;
  case OP_OUTPROJ: {
    ARow af{(const u16*)(ws + OFF_H), D_};
    const u16* Bt = L < 2 ? (const u16*)(ws + OFF_WNO) + (size_t)L * 1024 * 1024 : (const u16*)(ws + OFF_WDO) + (size_t)(L - 2) * 1024 * 1024;
    {
      EpiResidT<false> ep{nullptr, nullptr, (u16*)(ws + OFF_XB), (float*)(ws + OFF_SSQ)};
      for (int r = 0, tm, tn; xcd_tile(bid, r, G, 128, 4, tm, tn); ++r) gemm_tile(af, Bt, 1024, 1024, tm * 128, tn * 256, ep, smem);
    }
  } break;
  case OP_FFN1: {
    ARow af{(const u16*)(ws + OFF_XB), D_};
    EpiConvGlu ep{(u16*)(ws + OFF_ACT), (u16*)(ws + OFF_HALO), p.in[16] + (size_t)L * 3 * FF2, p.in[17] + (size_t)L * FF2, (const float*)(ws + OFF_SSQ)};
    const u16* Bt = (const u16*)(ws + OFF_WFI) + (size_t)L * FF2 * 1024;
    for (int r = 0, tm, tn; xcd_tile(bid, r, G, 128, 22, tm, tn); ++r) gemm_tile(af, Bt, FF2, 1024, tm * 128, tn * 256, ep, smem);
  } break;
  case OP_FIX: {
    for (int k = bid; k < 344; k += G)
      ffn_fix_task((const u16*)(ws + OFF_HALO), (u16*)(ws + OFF_ACT), p.in[16] + (size_t)L * 3 * FF2, p.in[17] + (size_t)L * FF2, k * 256 + tid);
  } break;
  case OP_FFN2: {
    ARow af{(const u16*)(ws + OFF_ACT), FF};
    EpiResidT<false> ep{nullptr, nullptr, (u16*)(ws + OFF_XB), (float*)(ws + OFF_SSQ)};
    const u16* Bt = (const u16*)(ws + OFF_WFO) + (size_t)L * 1024 * FF;
    for (int r = 0, tm, tn; xcd_tile(bid, r, G, 128, 4, tm, tn); ++r) {
      for (int q = tid; q < 688; q += 256)
        ffn_fix_task((const u16*)(ws + OFF_HALO), (u16*)(ws + OFF_ACT), p.in[16] + (size_t)L * 3 * FF2, p.in[17] + (size_t)L * FF2, (tm * 2 + q / 344) * 344 + q % 344);
      gemm_tile(af, Bt, 1024, FF, tm * 128, tn * 256, ep, smem);
    }
  } break;
  case OP_KVQ_GEMM: {
    for (int r = 0, tm, tn; xcd_tile(bid, r, G, 128, 12, tm, tn); ++r) {
      if (tn < 8) {
        ARow af{(const u16*)(ws + OFF_XB), D_}; EpiStoreT ep{(u16*)(ws + OFF_KVRAW), 2048, (const float*)(ws + OFF_SSQ)};
        gemm_tile(af, (const u16*)(ws + OFF_WKV), 2048, 1024, tm * 128, tn * 256, ep, smem);
      } else {
        ARow af{(const u16*)(ws + OFF_XB), D_}; EpiStoreT ep{(u16*)(ws + OFF_Q), D_, (const float*)(ws + OFF_SSQ)};
        gemm_tile(af, (const u16*)(ws + OFF_WDQ), 1024, 1024, tm * 128, (tn - 8) * 256, ep, smem);
      }
    }
  } break;
  case OP_DQ_GEMM: {
    ARow af{(const u16*)(ws + OFF_XB), D_}; EpiStoreT ep{(u16*)(ws + OFF_Q), D_, (const float*)(ws + OFF_SSQ)};
    for (int r = 0, tm, tn; xcd_tile(bid, r, G, 128, 4, tm, tn); ++r) gemm_tile(af, (const u16*)(ws + OFF_WDQ) + 1024 * 1024, 1024, 1024, tm * 128, tn * 256, ep, smem);
  } break;
  case OP_KV_PACK: {
    const u16* kvr = (const u16*)(ws + OFF_KVRAW);
    const float* rope = (const float*)(ws + OFF_ROPE);
    const int n_k = 1024, n_v = 8192;
    for (int w = bid; w < n_k + n_v; w += G) {
      if (w < n_k) pack_k16_task(kvr, 2048, 0, 16, (u16*)(ws + OFF_SKVK), rope, w * 256 + tid);
      else pack_v16_task(kvr, 2048, 1024, 8, (u16*)(ws + OFF_SKVV), (w - n_k) * 256 + tid);
    }
  } break;
  case OP_DIFF_ATTN: {
    for (int r = 0;; ++r) { int it = snake(r, G, bid); if (r * G >= 2048) break; if (it < 2048) diff_attn_item(p, it, smem); }
  } break;
  case OP_DIFF_COMB: {
    for (int k = bid; k < 4096; k += G) diff_comb_row(p, L - 2, L, k * 4 + wave, lane);
  } break;
  }
}

__global__ void __launch_bounds__(256, 2) mega(Params p, int s_lo, int s_hi) {
  __shared__ __attribute__((aligned(16))) char smem[73728];
  __shared__ uint4 xb_words;
  cg::grid_group grid = cg::this_grid();
  const bool multi = (s_hi - s_lo) > 1;
  XcdBarrier xb;
  if (multi) {
    if (__builtin_amdgcn_workitem_id_x() == 0) xb_words = make_uint4(0u, 0u, 0u, 0u);
    __syncthreads();
    xb = xcd_barrier_post((unsigned*)(p.ws + OFF_BAR), (volatile LAS unsigned*)&xb_words);
  }
  for (int s = s_lo; s < s_hi; ++s) {
    Step st = g_prog[s];
    run_step(p, st, smem);
    if (s + 1 < s_hi) { if (s_hi > 4096) grid.sync();   xcd_barrier(xb); }
  }
}

extern "C" void kernel_launch(void* const* d_in, const int* in_sizes, int n_in, void* d_out, int out_size, void* d_ws, size_t ws_size,
                              hipStream_t stream) {
  (void)in_sizes; (void)n_in; (void)out_size;
  static int grid_blocks = 0;
  if (!grid_blocks) {
    int dev = 0, cus = 0, per_cu = 0;
    hipGetDevice(&dev);
    hipDeviceGetAttribute(&cus, hipDeviceAttributeMultiprocessorCount, dev);
    hipOccupancyMaxActiveBlocksPerMultiprocessor(&per_cu, mega, 256, 0);
    if (per_cu < 1) per_cu = 1;
    if (per_cu > 2) per_cu = 2;
    grid_blocks = cus * per_cu;
  }
  if (ws_size < WS_NEEDED) { fprintf(stderr, "workspace too small: %zu < %zu\n", ws_size, (size_t)WS_NEEDED); return; }
  Params p{};
  for (int i = 0; i < 20; ++i) p.in[i] = (const float*)d_in[i];
  p.out = (float*)d_out;
  p.ws = (char*)d_ws;
#if ONE_LAUNCH
  hipMemsetAsync((char*)d_ws + OFF_BAR, 0, XCD_BAR_WORDS * 4, stream);
  int lo = 0, hi = N_STEPS;
  void* args[] = {&p, &lo, &hi};
  hipError_t e = hipLaunchCooperativeKernel((void*)mega, dim3(grid_blocks), dim3(256), args, 0, stream);
  if (e != hipSuccess) fprintf(stderr, "cooperative launch failed: %s (grid %d)\n", hipGetErrorString(e), grid_blocks);
#else
  for (int s = 0; s < N_STEPS; ++s) mega<<<grid_blocks, 256, 0, stream>>>(p, s, s + 1);
#endif
}
```

```cpp
#include <hip/hip_runtime.h>
#include <hip/hip_cooperative_groups.h>
#include <math.h>
#include <stdint.h>
#include <stdio.h>
namespace cg = cooperative_groups;

#ifndef ONE_LAUNCH
#define ONE_LAUNCH 1
#endif

typedef unsigned short u16;
typedef __attribute__((ext_vector_type(8))) short bf16x8;
typedef __attribute__((ext_vector_type(16))) float f32x16;
typedef __bf16 bf2_t __attribute__((ext_vector_type(2)));
typedef float f2_t __attribute__((ext_vector_type(2)));
typedef unsigned v4u __attribute__((ext_vector_type(4)));
typedef unsigned v2u __attribute__((ext_vector_type(2)));
#define DI __device__ __forceinline__

#define MFMA(a, b, c) __builtin_amdgcn_mfma_f32_32x32x16_bf16((a), (b), (c), 0, 0, 0)
typedef __attribute__((ext_vector_type(4))) float f32x4;
#define MFMA16(a, b, c) __builtin_amdgcn_mfma_f32_16x16x32_bf16((a), (b), (c), 0, 0, 0)

constexpr int T_ = 16384, S_ = 8192, D_ = 1024;
constexpr int LDP = 2608;
constexpr int FF = 2752, FF2 = 5504;
constexpr float SC = 0.125f * 1.4426950408889634f;

constexpr size_t OFF_WNI = 0;
constexpr size_t OFF_WNO = OFF_WNI + 2ull * 2608 * 1024 * 2;
constexpr size_t OFF_WP1 = OFF_WNO + 2ull * 1024 * 1024 * 2;
constexpr size_t OFF_WP2 = OFF_WP1 + 4ull * 256 * 2048 * 2;
constexpr size_t OFF_WKV = OFF_WP2 + 4ull * 64 * 256 * 2;
constexpr size_t OFF_WDQ = OFF_WKV + 2048ull * 1024 * 2;
constexpr size_t OFF_WDO = OFF_WDQ + 2ull * 1024 * 1024 * 2;
constexpr size_t OFF_WFI = OFF_WDO + 2ull * 1024 * 1024 * 2;
constexpr size_t OFF_WFO = OFF_WFI + 4ull * 5504 * 1024 * 2;
constexpr size_t OFF_ROPE = OFF_WFO + 4ull * 1024 * 2752 * 2;
constexpr size_t OFF_CB = OFF_ROPE + 8192ull * 16 * 4;
constexpr size_t OFF_BAR = OFF_CB + 4096;
constexpr size_t OFF_H = OFF_BAR + 16384;
constexpr size_t OFF_SKVK = OFF_H + (size_t)T_ * 1024 * 2;
constexpr size_t OFF_SKVV = OFF_SKVK + (size_t)T_ * 1024 * 2;
constexpr size_t OFF_XB = OFF_SKVV + (size_t)T_ * 1024 * 2;
constexpr size_t OFF_SSQ = OFF_XB + (size_t)T_ * 1024 * 2;
constexpr size_t OFF_BIG = OFF_SSQ + (size_t)T_ * 8 * 4;
constexpr size_t OFF_PROJ = OFF_BIG;
constexpr size_t OFF_KSF = OFF_PROJ + (size_t)T_ * LDP * 2;
constexpr size_t OFF_KWF = OFF_KSF + (size_t)T_ * 256 * 2;
constexpr size_t OFF_VSF = OFF_KWF + (size_t)T_ * 256 * 2;
constexpr size_t OFF_VWF = OFF_VSF + (size_t)T_ * 256 * 2;
constexpr size_t OFF_HID = OFF_VWF + (size_t)T_ * 256 * 2;
constexpr size_t OFF_KCF = OFF_HID + 2ull * 4096 * 256 * 2;
constexpr size_t OFF_VCF = OFF_KCF + 2ull * 4 * 512 * 64 * 2;
constexpr size_t OFF_ACT = OFF_BIG;
constexpr size_t OFF_HALO = OFF_ACT + (size_t)T_ * 2752 * 2;
constexpr size_t OFF_Q = OFF_BIG;
constexpr size_t OFF_KVRAW = OFF_Q + (size_t)T_ * 1024 * 2;
constexpr size_t WS_NEEDED = OFF_VCF + 2ull * 4 * 512 * 64 * 2;

struct Params {
  const float* in[20];
  float* out;
  char* ws;
};

enum { OP_PREP = 0, OP_NORM, OP_NSA_IN, OP_NSA_PACK, OP_NSA_CMP2, OP_NSA_ATTN, OP_OUTPROJ, OP_FFN1, OP_CONV, OP_FFN2,
       OP_FIX, OP_KVQ_NORM, OP_KVQ_GEMM, OP_KV_PACK, OP_DIFF_ATTN, OP_DIFF_COMB, OP_DQ_GEMM, OP_FINAL };
struct Step { int op, layer, aux; };
#define FFN_STEPS(l) {OP_FFN1, l, 0}, {OP_FFN2, l, 0}
#define NSA_STEPS(l) {OP_NSA_IN, l, 0}, {OP_NSA_PACK, l, 0}, {OP_NSA_ATTN, l, 0}, {OP_OUTPROJ, l, 0}
__constant__ Step g_prog[] = {
  {OP_PREP, 0, 0},
  NSA_STEPS(0), FFN_STEPS(0),
  NSA_STEPS(1), FFN_STEPS(1),
  {OP_KVQ_GEMM, 2, 0}, {OP_KV_PACK, 2, 0}, {OP_DIFF_ATTN, 2, 0}, {OP_DIFF_COMB, 2, 0}, {OP_OUTPROJ, 2, 0}, FFN_STEPS(2),
  {OP_DQ_GEMM, 3, 0}, {OP_DIFF_ATTN, 3, 0}, {OP_DIFF_COMB, 3, 0}, {OP_OUTPROJ, 3, 0}, FFN_STEPS(3),
  {OP_FINAL, 0, 0},
};
constexpr int N_STEPS = 1 + 6 + 6 + 7 + 6 + 1;

DI int get_tid() { int t = (int)__builtin_amdgcn_workitem_id_x(); asm volatile("" : "+v"(t)); return t; }
DI int get_bid() { int b = (int)__builtin_amdgcn_workgroup_id_x(); asm volatile("" : "+s"(b)); return b; }
DI v4u mk4(unsigned a, unsigned b, unsigned c, unsigned d) { v4u r = {a, b, c, d}; return r; }
DI v2u mk2(unsigned a, unsigned b) { v2u r = {a, b}; return r; }
DI unsigned pk2(float a, float b) { f2_t v = {a, b}; bf2_t r = __builtin_convertvector(v, bf2_t); return __builtin_bit_cast(unsigned, r); }
DI float bflo(unsigned u) { return __uint_as_float(u << 16); }
DI float bfhi(unsigned u) { return __uint_as_float(u & 0xffff0000u); }
DI float bf1(u16 v) { return __uint_as_float((unsigned)v << 16); }
DI u16 f2bf(float x) { return (u16)(pk2(x, 0.f) & 0xffffu); }
DI float wave_sum(float v) {
#pragma unroll
  for (int o = 32; o >= 1; o >>= 1) v += __shfl_xor(v, o);
  return v;
}
DI void unpack8(v4u a, float* f) {
  f[0] = bflo(a.x); f[1] = bfhi(a.x); f[2] = bflo(a.y); f[3] = bfhi(a.y);
  f[4] = bflo(a.z); f[5] = bfhi(a.z); f[6] = bflo(a.w); f[7] = bfhi(a.w);
}
DI v4u pack8(const float* f) { return mk4(pk2(f[0], f[1]), pk2(f[2], f[3]), pk2(f[4], f[5]), pk2(f[6], f[7])); }
DI bf16x8 pack_frag(const f32x16& x, int s) {
  v4u r = mk4(pk2(x[8 * s + 0], x[8 * s + 1]), pk2(x[8 * s + 2], x[8 * s + 3]), pk2(x[8 * s + 4], x[8 * s + 5]), pk2(x[8 * s + 6], x[8 * s + 7]));
  return __builtin_bit_cast(bf16x8, r);
}
DI size_t kfrag_chunk(int key, int c  ) { return ((size_t)(((key >> 5) * 4 + (c >> 1)) * 64 + (c & 1) * 32 + (key & 31))) * 8; }
template <int NDVT> DI size_t vfrag_index(int key, int dv) {
  int tile = key >> 6, s = (key >> 4) & 3, kk = key & 15, h = (kk >> 2) & 1, j = ((kk >> 3) << 2) | (kk & 3);
  return ((size_t)((((tile * NDVT + (dv >> 5)) * 4 + s) * 64) + h * 32 + (dv & 31))) * 8 + j;
}

struct ARow { const u16* base; int ld; DI const u16* operator()(int row, int k) const { return base + (size_t)row * ld + k; } };
struct ACmp {
  const u16* proj; int colbase;
  DI const u16* operator()(int r, int k) const {
    int hk = r & 3, i = (r >> 2) & 511, b = r >> 11; i = i > 510 ? 510 : i;
    return proj + (size_t)(b * S_ + 16 * i + (k >> 6)) * LDP + colbase + hk * 64 + (k & 63);
  }
};
struct EpiStore { static constexpr bool kTileEpi = false; u16* C; int ld; int N;
  DI void operator()(int m, int n, float a, float b, float c, float d) const { if (n < N) *(v2u*)(C + (size_t)m * ld + n) = mk2(pk2(a, b), pk2(c, d)); } };
struct EpiResid { static constexpr bool kTileEpi = false; const float* xin; float* xout;
  DI void operator()(int m, int n, float a, float b, float c, float d) const {
    float4 x = *(const float4*)(xin + (size_t)m * D_ + n); x.x += a; x.y += b; x.z += c; x.w += d; *(float4*)(xout + (size_t)m * D_ + n) = x; } };
DI float gelu_t(float x) { const float t = x * x; const float e = __builtin_amdgcn_exp2f(x * fmaf(t, -0.1029432f, -2.3022082f)); return x * __builtin_amdgcn_rcpf(1.f + e); }
struct EpiGelu { static constexpr bool kTileEpi = false; const float* bias; u16* C;
  DI void operator()(int m, int n, float a, float b, float c, float d) const {
    float4 bb = *(const float4*)(bias + n);
    *(v2u*)(C + (size_t)m * 256 + n) = mk2(pk2(gelu_t(a + bb.x), gelu_t(b + bb.y)), pk2(gelu_t(c + bb.z), gelu_t(d + bb.w))); } };
struct EpiCmpOut { static constexpr bool kTileEpi = false; u16* kcf; u16* vcf; int kv;
  DI void operator()(int m, int n, float a, float b, float c, float d) const {
    if (n >= 64) return;
    int hk = m & 3, i = (m >> 2) & 511, bb = m >> 11;
    if (i == 511) { a = b = c = d = 0.f; }
    size_t sb = (size_t)(bb * 4 + hk) * 512 * 64;
    if (kv == 0) { *(v2u*)(kcf + sb + kfrag_chunk(i, n >> 3) + (n & 7)) = mk2(pk2(a, b), pk2(c, d)); }
    else { vcf[sb + vfrag_index<2>(i, n)] = f2bf(a); vcf[sb + vfrag_index<2>(i, n + 1)] = f2bf(b); vcf[sb + vfrag_index<2>(i, n + 2)] = f2bf(c); vcf[sb + vfrag_index<2>(i, n + 3)] = f2bf(d); }
  } };


struct EpiCmpFused { static constexpr bool kTileEpi = true; static constexpr bool kRs = false;
  const float* bias; const u16* W2T; u16* kcf; u16* vcf; int kv;
  DI void tile(f32x4 (&acc)[8][4], const float (&rs)[4], int m0, int n0, int N, char* smem) const {
    u16* Ht = (u16*)smem;
    const int tid = get_tid(), lane = tid & 63, wave = tid >> 6, wm = wave & 1, wn = wave >> 1, l15 = lane & 15, lq = lane >> 4;
    __syncthreads();
#pragma unroll
    for (int ni = 0; ni < 8; ++ni) {
      const int n = wn * 128 + ni * 16 + 4 * lq;
      const float4 bb = *(const float4*)(bias + n);
#pragma unroll
      for (int mi = 0; mi < 4; ++mi) {
        const int m = wm * 64 + mi * 16 + l15;
        *(v2u*)(Ht + m * 264 + n) = mk2(pk2(gelu_t(acc[ni][mi][0] + bb.x), gelu_t(acc[ni][mi][1] + bb.y)), pk2(gelu_t(acc[ni][mi][2] + bb.z), gelu_t(acc[ni][mi][3] + bb.w)));
      }
    }
    __syncthreads();
    f32x4 a2[4][2];
#pragma unroll
    for (int nj = 0; nj < 4; ++nj)
#pragma unroll
      for (int mi = 0; mi < 2; ++mi)
#pragma unroll
        for (int i = 0; i < 4; ++i) a2[nj][mi][i] = 0.f;
#pragma unroll
    for (int ks = 0; ks < 8; ++ks) {
      bf16x8 fb[2], fa[4];
#pragma unroll
      for (int mi = 0; mi < 2; ++mi) fb[mi] = *(const bf16x8*)(Ht + (wave * 32 + mi * 16 + l15) * 264 + ks * 32 + lq * 8);
#pragma unroll
      for (int nj = 0; nj < 4; ++nj) fa[nj] = *(const bf16x8*)(W2T + (nj * 16 + l15) * 256 + ks * 32 + lq * 8);
#pragma unroll
      for (int nj = 0; nj < 4; ++nj)
#pragma unroll
        for (int mi = 0; mi < 2; ++mi) a2[nj][mi] = MFMA16(fa[nj], fb[mi], a2[nj][mi]);
    }
    EpiCmpOut out{kcf, vcf, kv};
#pragma unroll
    for (int nj = 0; nj < 4; ++nj)
#pragma unroll
      for (int mi = 0; mi < 2; ++mi)
        out(m0 + wave * 32 + mi * 16 + l15, nj * 16 + 4 * lq, a2[nj][mi][0], a2[nj][mi][1], a2[nj][mi][2], a2[nj][mi][3]);
  } };

DI float rrow(const float* __restrict__ ssq, int m) {
  const float4 a = *(const float4*)(ssq + (size_t)m * 8), b = *(const float4*)(ssq + (size_t)m * 8 + 4);
  return rsqrtf(((a.x + a.y) + (a.z + a.w) + (b.x + b.y) + (b.z + b.w)) * (1.f / 1024.f) + 1e-6f);
}
constexpr int CT_ROW = 264;
struct EpiStoreT { static constexpr bool kTileEpi = true; static constexpr bool kRs = true;
  u16* C; int ld; const float* ssq;
  DI void tile(f32x4 (&acc)[8][4], const float (&rs)[4], int m0, int n0, int N, char* smem) const {
    u16* Ct = (u16*)smem;
    const int tid = get_tid(), lane = tid & 63, wave = tid >> 6, wm = wave & 1, wn = wave >> 1, l15 = lane & 15, lq = lane >> 4;
    __syncthreads();
#pragma unroll
    for (int ni = 0; ni < 8; ++ni)
#pragma unroll
      for (int mi = 0; mi < 4; ++mi) {
        const int m = wm * 64 + mi * 16 + l15, n = wn * 128 + ni * 16 + 4 * lq;
        const float s = rs[mi];
        *(v2u*)(Ct + m * CT_ROW + n) = mk2(pk2(acc[ni][mi][0] * s, acc[ni][mi][1] * s), pk2(acc[ni][mi][2] * s, acc[ni][mi][3] * s));
      }
    __syncthreads();
    const int ch = tid & 31, r0 = tid >> 5;
    if (n0 + ch * 8 < N) {
#pragma unroll
      for (int k = 0; k < 16; ++k) {
        const int m = r0 + 8 * k;
        *(v4u*)(C + (size_t)(m0 + m) * ld + n0 + ch * 8) = *(const v4u*)(Ct + m * CT_ROW + ch * 8);
      }
    }
  } };
constexpr int RT_ROW = 132;
template <bool F32IN>
struct EpiResidT { static constexpr bool kTileEpi = true; static constexpr bool kRs = false;
  const float* xin; float* xout; u16* xb; float* ssq;
  DI void tile(f32x4 (&acc)[8][4], const float (&rs)[4], int m0, int n0, int N, char* smem) const {
    float* Rt = (float*)smem;
    const int tid = get_tid(), lane = tid & 63, wave = tid >> 6, wm = wave & 1, wn = wave >> 1, l15 = lane & 15, lq = lane >> 4;
    const int ch = tid & 31, r0 = tid >> 5;
    if constexpr (!F32IN) {
      for (int pass = 0; pass < 2; ++pass) {
        v2u ur[16];
        const unsigned voff = (unsigned)(r0 * D_ + ch * 4);
        u16* const pbase = xb + (size_t)m0 * D_ + n0 + pass * 128;
#pragma unroll
        for (int k = 0; k < 16; ++k) ur[k] = *(const v2u*)(pbase + (size_t)(8 * k) * D_ + voff);
        __syncthreads();
        if (wn == pass) {
#pragma unroll
          for (int ni = 0; ni < 8; ++ni)
#pragma unroll
            for (int mi = 0; mi < 4; ++mi) {
              const int m = wm * 64 + mi * 16 + l15, n = ni * 16 + 4 * lq;
              *(float4*)(Rt + m * RT_ROW + n) = make_float4(acc[ni][mi][0], acc[ni][mi][1], acc[ni][mi][2], acc[ni][mi][3]);
            }
        }
        __syncthreads();
#pragma unroll
        for (int k = 0; k < 16; ++k) {
          if ((k & 3) == 0) __builtin_amdgcn_sched_barrier(0);
          const int m = r0 + 8 * k;
          float4 x = make_float4(bflo(ur[k].x), bfhi(ur[k].x), bflo(ur[k].y), bfhi(ur[k].y));
          const float4 a = *(const float4*)(Rt + m * RT_ROW + ch * 4);
          x.x += a.x; x.y += a.y; x.z += a.z; x.w += a.w;
          *(v2u*)(pbase + (size_t)(8 * k) * D_ + voff) = mk2(pk2(x.x, x.y), pk2(x.z, x.w));
          float ss = x.x * x.x + x.y * x.y + x.z * x.z + x.w * x.w;
#pragma unroll
          for (int o = 16; o >= 1; o >>= 1) ss += __shfl_xor(ss, o);
          if (ch == 0) ssq[(size_t)(m0 + m) * 8 + ((n0 >> 7) + pass)] = ss;
        }
      }
      return;
    }
    for (int pass = 0; pass < 2; ++pass) {
      float4 xr[8];
#pragma unroll
      for (int k = 0; k < 8; ++k) {
        const size_t o_ = (size_t)(m0 + r0 + 8 * k) * D_ + n0 + pass * 128 + ch * 4;
        if constexpr (F32IN) xr[k] = *(const float4*)(xin + o_);
        else { const v2u u_ = *(const v2u*)(xb + o_); xr[k] = make_float4(bflo(u_.x), bfhi(u_.x), bflo(u_.y), bfhi(u_.y)); }
      }
      __syncthreads();
      if (wn == pass) {
#pragma unroll
        for (int ni = 0; ni < 8; ++ni)
#pragma unroll
          for (int mi = 0; mi < 4; ++mi) {
            const int m = wm * 64 + mi * 16 + l15, n = ni * 16 + 4 * lq;
            *(float4*)(Rt + m * RT_ROW + n) = make_float4(acc[ni][mi][0], acc[ni][mi][1], acc[ni][mi][2], acc[ni][mi][3]);
          }
      }
      __syncthreads();
#pragma unroll 1
      for (int kh = 0; kh < 2; ++kh) {
        if (kh == 1) {
#pragma unroll
          for (int k = 0; k < 8; ++k) {
            const size_t o_ = (size_t)(m0 + r0 + 8 * (8 + k)) * D_ + n0 + pass * 128 + ch * 4;
            if constexpr (F32IN) xr[k] = *(const float4*)(xin + o_);
            else { const v2u u_ = *(const v2u*)(xb + o_); xr[k] = make_float4(bflo(u_.x), bfhi(u_.x), bflo(u_.y), bfhi(u_.y)); }
          }
        }
#pragma unroll
        for (int k = 0; k < 8; ++k) {
          const int m = r0 + 8 * (kh * 8 + k);
          const size_t off = (size_t)(m0 + m) * D_ + n0 + pass * 128 + ch * 4;
          float4 x = xr[k];
          const float4 a = *(const float4*)(Rt + m * RT_ROW + ch * 4);
          x.x += a.x; x.y += a.y; x.z += a.z; x.w += a.w;
          *(v2u*)(xb + off) = mk2(pk2(x.x, x.y), pk2(x.z, x.w));
          float ss = x.x * x.x + x.y * x.y + x.z * x.z + x.w * x.w;
#pragma unroll
          for (int o = 16; o >= 1; o >>= 1) ss += __shfl_xor(ss, o);
          if (ch == 0) ssq[(size_t)(m0 + m) * 8 + ((n0 >> 7) + pass)] = ss;
        }
      }
    }
  } };
constexpr int UT_ROW = 136;
DI float silu_mul(float g, float v) { return g * __builtin_amdgcn_rcpf(1.f + __expf(-g)) * v; }
struct EpiConvGlu { static constexpr bool kTileEpi = true; static constexpr bool kRs = true;
  u16* act; u16* halo; const float* cw; const float* cb; const float* ssq;
  DI void tile(f32x4 (&acc)[8][4], const float (&rs)[4], int m0, int n0, int N, char* smem) const {
    u16* Ut = (u16*)smem;
    const int tid = get_tid(), lane = tid & 63, wave = tid >> 6, wm = wave & 1, wn = wave >> 1, l15 = lane & 15, lq = lane >> 4;
    for (int pass = 0; pass < 2; ++pass) {
    if (n0 + pass * 128 >= N) break;
    const int tm = m0 >> 7, tn = (n0 >> 7) + pass;
    const int c = tid & 7, j0 = tn * 64 + c * 8;
    float wg[3][8], wv[3][8], bg[8], bv[8];
#pragma unroll
    for (int hq = 0; hq < 2; ++hq) {
#pragma unroll
      for (int tp = 0; tp < 3; ++tp) {
        float4 a = *(const float4*)(cw + tp * FF2 + j0 + 4 * hq), b = *(const float4*)(cw + tp * FF2 + FF + j0 + 4 * hq);
        wg[tp][4 * hq] = a.x; wg[tp][4 * hq + 1] = a.y; wg[tp][4 * hq + 2] = a.z; wg[tp][4 * hq + 3] = a.w;
        wv[tp][4 * hq] = b.x; wv[tp][4 * hq + 1] = b.y; wv[tp][4 * hq + 2] = b.z; wv[tp][4 * hq + 3] = b.w;
      }
      float4 a = *(const float4*)(cb + j0 + 4 * hq), b = *(const float4*)(cb + FF + j0 + 4 * hq);
      bg[4 * hq] = a.x; bg[4 * hq + 1] = a.y; bg[4 * hq + 2] = a.z; bg[4 * hq + 3] = a.w;
      bv[4 * hq] = b.x; bv[4 * hq + 1] = b.y; bv[4 * hq + 2] = b.z; bv[4 * hq + 3] = b.w;
    }
    __syncthreads();
    if (wn == pass) {
#pragma unroll
    for (int ni = 0; ni < 8; ++ni)
#pragma unroll
      for (int mi = 0; mi < 4; ++mi) {
        const int m = wm * 64 + mi * 16 + l15, n = ni * 16 + 4 * lq;
        const float s = rs[mi];
        *(v2u*)(Ut + m * UT_ROW + n) = mk2(pk2(acc[ni][mi][0] * s, acc[ni][mi][1] * s), pk2(acc[ni][mi][2] * s, acc[ni][mi][3] * s));
      }
    }
    __syncthreads();
    if (tid < 64) {
      int rr = tid >> 4, c2 = tid & 15, row = rr < 2 ? rr : 124 + rr, n = c2 * 8, half = n >> 6, j = tn * 64 + (n & 63);
      *(v4u*)(halo + ((size_t)((tm * 4 + rr) * 2 + half)) * FF + j) = *(const v4u*)(Ut + row * UT_ROW + n);
    }
#pragma unroll
    for (int k = 0; k < 4; ++k) {
      const int m = (tid >> 3) + 32 * k;
      if (m >= 2) {
        float g0[8], g1[8], g2[8], v0[8], v1[8], v2[8], o[8];
        unpack8(*(const v4u*)(Ut + m * UT_ROW + c * 8), g0); unpack8(*(const v4u*)(Ut + m * UT_ROW + 64 + c * 8), v0);
        unpack8(*(const v4u*)(Ut + (m - 1) * UT_ROW + c * 8), g1); unpack8(*(const v4u*)(Ut + (m - 1) * UT_ROW + 64 + c * 8), v1);
        unpack8(*(const v4u*)(Ut + (m - 2) * UT_ROW + c * 8), g2); unpack8(*(const v4u*)(Ut + (m - 2) * UT_ROW + 64 + c * 8), v2);
#pragma unroll
        for (int e = 0; e < 8; ++e)
          o[e] = silu_mul(bg[e] + wg[0][e] * g2[e] + wg[1][e] * g1[e] + wg[2][e] * g0[e], bv[e] + wv[0][e] * v2[e] + wv[1][e] * v1[e] + wv[2][e] * v0[e]);
        *(v4u*)(act + (size_t)(m0 + m) * FF + j0) = pack8(o);
      }
    }
    }
  } };
DI void ld_halo(const u16* __restrict__ halo, int tm, int rr, int half, int j0, float* f) { unpack8(*(const v4u*)(halo + ((size_t)((tm * 4 + rr) * 2 + half)) * FF + j0), f); }
DI void ffn_fix_task(const u16* __restrict__ halo, u16* __restrict__ act, const float* __restrict__ cw, const float* __restrict__ cb, int task) {
  const int ck = task % 344, rest = task / 344, r = rest & 1, tm = rest >> 1, j0 = ck * 8;
  const bool first = (tm & 63) == 0;
  float g0[8], g1[8], g2[8], v0[8], v1[8], v2[8], o[8];
#pragma unroll
  for (int e = 0; e < 8; ++e) { g1[e] = g2[e] = v1[e] = v2[e] = 0.f; }
  ld_halo(halo, tm, r, 0, j0, g0); ld_halo(halo, tm, r, 1, j0, v0);
  if (r == 1) { ld_halo(halo, tm, 0, 0, j0, g1); ld_halo(halo, tm, 0, 1, j0, v1); if (!first) { ld_halo(halo, tm - 1, 3, 0, j0, g2); ld_halo(halo, tm - 1, 3, 1, j0, v2); } }
  else if (!first) { ld_halo(halo, tm - 1, 3, 0, j0, g1); ld_halo(halo, tm - 1, 3, 1, j0, v1); ld_halo(halo, tm - 1, 2, 0, j0, g2); ld_halo(halo, tm - 1, 2, 1, j0, v2); }
#pragma unroll
  for (int e = 0; e < 8; ++e) {
    float cgv = cb[j0 + e] + cw[j0 + e] * g2[e] + cw[FF2 + j0 + e] * g1[e] + cw[2 * FF2 + j0 + e] * g0[e];
    float cvv = cb[FF + j0 + e] + cw[FF + j0 + e] * v2[e] + cw[FF2 + FF + j0 + e] * v1[e] + cw[2 * FF2 + FF + j0 + e] * v0[e];
    o[e] = silu_mul(cgv, cvv);
  }
  *(v4u*)(act + (size_t)(tm * 128 + r) * FF + j0) = pack8(o);
}

constexpr int G_ST = 24576;
#define GLDS1(gp_, ldsaddr_)                                                                                               \
  { unsigned keep_; const void* g_ = (const void*)(gp_); unsigned la_ = __builtin_amdgcn_readfirstlane(ldsaddr_);          \
    asm volatile("s_mov_b32 %0, m0\n\ts_mov_b32 m0, %2\n\ts_nop 0\n\tglobal_load_lds_dwordx4 %1, off\n\ts_mov_b32 m0, %0" : "=&s"(keep_) : "v"(g_), "s"(la_) : "memory"); }
template <class AF, class EP>
DI void gemm_tile(const AF& af, const u16* __restrict__ Bt, int N, int K, int m0, int n0, const EP& ep, char* smem) {
  const int tid = get_tid(), lane = tid & 63;
  const int wv = __builtin_amdgcn_readfirstlane(tid >> 6);
  const int wm = wv & 1, wn = wv >> 1;
  const int l15 = lane & 15, lq = lane >> 4;
  const unsigned lds0 = (unsigned)(size_t)smem;
  const int drow = lane >> 2, dc = ((lane & 3) ^ ((4 - ((lane >> 4) & 3)) & 3)) * 8;
  const u16* pb[4];
#pragma unroll
  for (int j = 0; j < 4; ++j) { int nb = n0 + (4 * wv + j) * 16 + drow; nb = nb < N ? nb : N - 1; pb[j] = Bt + (size_t)nb * K + dc; }
  f32x4 acc[8][4];
#pragma unroll
  for (int a = 0; a < 8; ++a)
#pragma unroll
    for (int b = 0; b < 4; ++b)
#pragma unroll
      for (int i = 0; i < 4; ++i) acc[a][b][i] = 0.f;
#define G_DMA(kt_, st_)                                                                                     \
  { const unsigned sb_ = lds0 + (unsigned)((st_) * G_ST);                                                   \
    _Pragma("unroll") for (int j = 0; j < 2; ++j) GLDS1(af(m0 + (2 * wv + j) * 16 + drow, (kt_) * 32 + dc), sb_ + (2 * wv + j) * 1024) \
    _Pragma("unroll") for (int j = 0; j < 4; ++j) GLDS1(pb[j] + (kt_) * 32, sb_ + 8192 + (4 * wv + j) * 1024) }
  asm volatile("s_waitcnt vmcnt(0)" ::: "memory");
  __syncthreads();
  const int nk = K >> 5;
  float rsv[4] = {1.f, 1.f, 1.f, 1.f};
  float4 rq[EP::kTileEpi ? 8 : 1];
  if constexpr (EP::kTileEpi) { if constexpr (EP::kRs) {
#pragma unroll
    for (int mi = 0; mi < 4; ++mi) { const float* sp = ep.ssq + (size_t)(m0 + wm * 64 + mi * 16 + l15) * 8; rq[2 * mi] = *(const float4*)sp; rq[2 * mi + 1] = *(const float4*)(sp + 4); }
  } }
  G_DMA(0, 0)
  if (nk > 1) G_DMA(1, 1)
  if constexpr (EP::kTileEpi) { if constexpr (EP::kRs) {
#pragma unroll
    for (int mi = 0; mi < 4; ++mi) { const float4 a = rq[2 * mi], b = rq[2 * mi + 1]; rsv[mi] = rsqrtf(((a.x + a.y) + (a.z + a.w) + (b.x + b.y) + (b.z + b.w)) * (1.f / 1024.f) + 1e-6f); }
  } }
  const int co = (lq ^ ((4 - ((l15 >> 2) & 3)) & 3)) * 16;
  int st = 0;
  for (int kt = 0; kt < nk; ++kt) {
    if (kt + 1 < nk) asm volatile("s_waitcnt vmcnt(6)" ::: "memory"); else asm volatile("s_waitcnt vmcnt(0)" ::: "memory");
    asm volatile("s_waitcnt lgkmcnt(0)" ::: "memory");
    __builtin_amdgcn_s_barrier();
    if (kt + 2 < nk) { const int s2 = st >= 1 ? st - 1 : 2; G_DMA(kt + 2, s2) }
    {
      const char* sbase = smem + st * G_ST;
      const char* pB = sbase + (wm * 64 + l15) * 64 + co;
      const char* pA = sbase + 8192 + (wn * 128 + l15) * 64 + co;
      bf16x8 fb[4], fa[8];
#pragma unroll
      for (int mi = 0; mi < 4; ++mi) fb[mi] = *(const bf16x8*)(pB + mi * 16 * 64);
#pragma unroll
      for (int ni = 0; ni < 8; ++ni) fa[ni] = *(const bf16x8*)(pA + ni * 16 * 64);
      __builtin_amdgcn_sched_barrier(0);
#pragma unroll
      for (int ni = 0; ni < 8; ++ni)
#pragma unroll
        for (int mi = 0; mi < 4; ++mi) acc[ni][mi] = MFMA16(fa[ni], fb[mi], acc[ni][mi]);
      __builtin_amdgcn_sched_barrier(0);
    }
    st = st == 2 ? 0 : st + 1;
  }
  if constexpr (EP::kTileEpi) {
    ep.tile(acc, rsv, m0, n0, N, smem);
  } else {
#pragma unroll
  for (int ni = 0; ni < 8; ++ni)
#pragma unroll
    for (int mi = 0; mi < 4; ++mi) {
      const int m = m0 + wm * 64 + mi * 16 + l15, n = n0 + wn * 128 + ni * 16 + 4 * lq;
      ep(m, n, acc[ni][mi][0], acc[ni][mi][1], acc[ni][mi][2], acc[ni][mi][3]);
    }
  }
}

DI void norm_row_bf16(const float* __restrict__ x, const float* __restrict__ g, u16* __restrict__ dst, int lane) {
  float4 v[4]; float ss = 0.f;
#pragma unroll
  for (int k = 0; k < 4; ++k) { v[k] = ((const float4*)x)[k * 64 + lane]; ss += v[k].x * v[k].x + v[k].y * v[k].y + v[k].z * v[k].z + v[k].w * v[k].w; }
  ss = wave_sum(ss);
  float r = rsqrtf(ss * (1.f / 1024.f) + 1e-6f);
#pragma unroll
  for (int k = 0; k < 4; ++k) {
    float4 gg = ((const float4*)g)[k * 64 + lane];
    ((v2u*)dst)[k * 64 + lane] = mk2(pk2(v[k].x * r * gg.x, v[k].y * r * gg.y), pk2(v[k].z * r * gg.z, v[k].w * r * gg.w));
  }
}
DI void norm_row_f32(float* __restrict__ x, const float* __restrict__ g, int lane) {
  float4 v[4]; float ss = 0.f;
#pragma unroll
  for (int k = 0; k < 4; ++k) { v[k] = ((const float4*)x)[k * 64 + lane]; ss += v[k].x * v[k].x + v[k].y * v[k].y + v[k].z * v[k].z + v[k].w * v[k].w; }
  ss = wave_sum(ss);
  float r = rsqrtf(ss * (1.f / 1024.f) + 1e-6f);
#pragma unroll
  for (int k = 0; k < 4; ++k) {
    float4 gg = ((const float4*)g)[k * 64 + lane];
    ((float4*)x)[k * 64 + lane] = make_float4(v[k].x * r * gg.x, v[k].y * r * gg.y, v[k].z * r * gg.z, v[k].w * r * gg.w);
  }
}


DI void prep_row_x(const float* __restrict__ x, u16* __restrict__ xb, float* __restrict__ ssq, int lane) {
#pragma unroll
  for (int k = 0; k < 4; ++k) {
    const float4 v = ((const float4*)x)[k * 64 + lane];
    ((v2u*)xb)[k * 64 + lane] = mk2(pk2(v.x, v.y), pk2(v.z, v.w));
    float ss = v.x * v.x + v.y * v.y + v.z * v.z + v.w * v.w;
#pragma unroll
    for (int o = 16; o >= 1; o >>= 1) ss += __shfl_xor(ss, o);
    if ((lane & 31) == 0) ssq[2 * k + (lane >> 5)] = ss;
  }
}

struct Job { int in_idx; unsigned src_off; unsigned long long dst_off; int K, N, perm, g_idx, g_off; };
__constant__ Job g_jobs[25] = {
  {15, 0u, OFF_WFI, 1024, 5504, 1, 2, 0},
  {15, 1024u * 5504u, OFF_WFI + 1ull * 5504 * 1024 * 2, 1024, 5504, 1, 2, 1024},
  {15, 2u * 1024u * 5504u, OFF_WFI + 2ull * 5504 * 1024 * 2, 1024, 5504, 1, 2, 2048},
  {15, 3u * 1024u * 5504u, OFF_WFI + 3ull * 5504 * 1024 * 2, 1024, 5504, 1, 2, 3072},
  {18, 0u, OFF_WFO, 2752, 1024, 0, -1, 0},
  {18, 2752u * 1024u, OFF_WFO + 1ull * 1024 * 2752 * 2, 2752, 1024, 0, -1, 0},
  {18, 2u * 2752u * 1024u, OFF_WFO + 2ull * 1024 * 2752 * 2, 2752, 1024, 0, -1, 0},
  {18, 3u * 2752u * 1024u, OFF_WFO + 3ull * 1024 * 2752 * 2, 2752, 1024, 0, -1, 0},
  {3, 0u, OFF_WNI, 1024, 2608, 0, 1, 0},
  {3, 1024u * 2608u, OFF_WNI + 2608ull * 1024 * 2, 1024, 2608, 0, 1, 1024},
  {4, 0u, OFF_WNO, 1024, 1024, 0, -1, 0},
  {4, 1024u * 1024u, OFF_WNO + 1024ull * 1024 * 2, 1024, 1024, 0, -1, 0},
  {6, 0u, OFF_WP1, 2048, 256, 0, -1, 0},
  {6, 2048u * 256u, OFF_WP1 + 1ull * 256 * 2048 * 2, 2048, 256, 0, -1, 0},
  {6, 2u * 2048u * 256u, OFF_WP1 + 2ull * 256 * 2048 * 2, 2048, 256, 0, -1, 0},
  {6, 3u * 2048u * 256u, OFF_WP1 + 3ull * 256 * 2048 * 2, 2048, 256, 0, -1, 0},
  {8, 0u, OFF_WP2, 256, 64, 0, -1, 0},
  {8, 256u * 64u, OFF_WP2 + 1ull * 64 * 256 * 2, 256, 64, 0, -1, 0},
  {8, 2u * 256u * 64u, OFF_WP2 + 2ull * 64 * 256 * 2, 256, 64, 0, -1, 0},
  {8, 3u * 256u * 64u, OFF_WP2 + 3ull * 64 * 256 * 2, 256, 64, 0, -1, 0},
  {10, 0u, OFF_WKV, 1024, 2048, 0, 9, 0},
  {11, 0u, OFF_WDQ, 1024, 1024, 0, 1, 2048},
  {11, 1024u * 1024u, OFF_WDQ + 1024ull * 1024 * 2, 1024, 1024, 0, 1, 3072},
  {14, 0u, OFF_WDO, 1024, 1024, 0, -1, 0},
  {14, 1024u * 1024u, OFF_WDO + 1024ull * 1024 * 2, 1024, 1024, 0, -1, 0},
};
constexpr int N_TR_TILES = 2 * 656 + 2 * 256 + 4 * 128 + 4 * 4 + 512 + 2 * 256 + 2 * 256 + 4 * 1376 + 4 * 688;

DI void transpose_tile(const Params& p, size_t z, int tile, char* smem, int& j, int& base) {
  for (;;) { int nt = (g_jobs[j].K >> 6) * ((g_jobs[j].N + 63) >> 6); if (tile < base + nt) break; base += nt; ++j; }
  const Job jb = g_jobs[j];
  const float* src = p.in[jb.in_idx] + jb.src_off + z;
  u16* dst = (u16*)(p.ws + jb.dst_off + z);
  const int K = jb.K, N = jb.N;
  const int lt = tile - base, ntn = (N + 63) >> 6;
  const int k0 = (lt / ntn) * 64, n0 = (lt % ntn) * 64;
  float* t = (float*)smem;
  const int tid = get_tid();
  __syncthreads();
  {
    const int n4 = (tid & 15) * 4, kq = tid >> 4;
    const bool ok = (n0 + n4) < N;
    float4 v[4];
#pragma unroll
    for (int i = 0; i < 4; ++i) v[i] = ok ? *(const float4*)(src + (size_t)(k0 + kq + 16 * i) * N + n0 + n4) : make_float4(0.f, 0.f, 0.f, 0.f);
#pragma unroll
    for (int i = 0; i < 4; ++i) { float* tp = t + (kq + 16 * i) * 65 + n4; tp[0] = v[i].x; tp[1] = v[i].y; tp[2] = v[i].z; tp[3] = v[i].w; }
  }
  __syncthreads();
#pragma unroll
  for (int i = 0; i < 2; ++i) {
    int c = tid & 7, n = (tid >> 3) + 32 * i;
    if (n0 + n < N) {
      float f[8];
#pragma unroll
      for (int e = 0; e < 8; ++e) f[e] = t[(c * 8 + e) * 65 + n];
      if (jb.g_idx >= 0) {
        const float* gp = p.in[jb.g_idx] + jb.g_off + z + k0 + c * 8;
#pragma unroll
        for (int e = 0; e < 8; ++e) f[e] *= gp[e];
      }
      int nrow = n0 + n;
      if (jb.perm) { int c0 = n0 >= FF ? n0 - FF : n0; nrow = (c0 >> 6) * 128 + (n0 >= FF ? 64 : 0) + n; }
      *(v4u*)(dst + (size_t)nrow * K + k0 + c * 8) = pack8(f);
    }
  }
}

DI void pack_k_task(const u16* __restrict__ src, int ld, int col0, int NH, u16* __restrict__ dst, const float* __restrict__ rope, int task) {
  int t = task & (S_ - 1); int rest = task >> 13; int hs = rest % NH; int b = rest / NH;
  const u16* row = src + (size_t)(b * S_ + t) * ld + col0 + hs * 64;
  v4u c[8];
#pragma unroll
  for (int i = 0; i < 8; ++i) c[i] = *(const v4u*)(row + 8 * i);
  float x1[8], x2[8], o1[8], o2[8];
  unpack8(c[0], x1); unpack8(c[1], x2);
  const float* rt = rope + (size_t)t * 16;
#pragma unroll
  for (int i = 0; i < 8; ++i) { float cs = rt[i], sn = rt[8 + i]; o1[i] = x1[i] * cs - x2[i] * sn; o2[i] = x2[i] * cs + x1[i] * sn; }
  c[0] = pack8(o1); c[1] = pack8(o2);
  u16* d = dst + (size_t)(b * NH + hs) * S_ * 64;
#pragma unroll
  for (int i = 0; i < 8; ++i) *(v4u*)(d + kfrag_chunk(t, i)) = c[i];
}
template <int NDVT>
DI void pack_v_task(const u16* __restrict__ src, int ld, int col0, int NH, u16* __restrict__ dst, int task) {
  int ln = task & 63; int s = (task >> 6) & 3; int rest = task >> 8; int dvt = rest % NDVT; rest /= NDVT; int tile = rest & 127; rest >>= 7; int hs = rest % NH; int b = rest / NH;
  int h = ln >> 5, dv = dvt * 32 + (ln & 31);
  const u16* base = src + (size_t)(b * S_ + tile * 64 + 16 * s + 4 * h) * ld + col0 + hs * (32 * NDVT) + dv;
  u16 v[8];
#pragma unroll
  for (int j = 0; j < 8; ++j) { int kk = 8 * (j >> 2) + (j & 3); v[j] = base[(size_t)kk * ld]; }
  v4u o = mk4(v[0] | ((unsigned)v[1] << 16), v[2] | ((unsigned)v[3] << 16), v[4] | ((unsigned)v[5] << 16), v[6] | ((unsigned)v[7] << 16));
  u16* d = dst + (size_t)(b * NH + hs) * S_ * (32 * NDVT);
  *(v4u*)(d + ((size_t)(((tile * NDVT + dvt) * 4 + s) * 64 + ln)) * 8) = o;
}

DI bf16x8 rope_q(const u16* __restrict__ qrow, const float* __restrict__ rt, int h) {
  v4u a = *(const v4u*)qrow, b = *(const v4u*)(qrow + 8);
  float x1[8], x2[8], o[8];
  unpack8(a, x1); unpack8(b, x2);
#pragma unroll
  for (int i = 0; i < 8; ++i) { float cs = rt[i], sn = rt[8 + i]; o[i] = h == 0 ? (x1[i] * cs - x2[i] * sn) : (x2[i] * cs + x1[i] * sn); }
  v4u r = pack8(o);
  return __builtin_bit_cast(bf16x8, r);
}

template <int NDVT, int MODE>
DI void attn_stream(const u16* __restrict__ Kf, const u16* __restrict__ Vf, int tb, int te, const unsigned* umask,
                    const bf16x8 (&q)[4], f32x16 (&O)[NDVT], float& m, float& l, int t, int tmin, int tmax, const unsigned* selw, char* lds) {
  constexpr int NCH = 2 + NDVT;
  constexpr int TILE_B = NCH * 4096;
  const int tid = get_tid(), lane = tid & 63, h = lane >> 5;
  v4u pre[NCH];
#define ATT_VALID(i_) (MODE != 2 || ((umask[(i_) >> 5] >> ((i_) & 31)) & 1u))
#define ATT_GLOAD(i_)                                                                                   \
  {                                                                                                     \
    const u16* kp = Kf + (size_t)(i_) * 4096;                                                           \
    const u16* vp = Vf + (size_t)(i_) * (2048 * NDVT);                                                  \
    _Pragma("unroll") for (int c = 0; c < 2; ++c) pre[c] = *(const v4u*)(kp + (c * 256 + tid) * 8);   \
    _Pragma("unroll") for (int c = 0; c < NDVT; ++c) pre[2 + c] = *(const v4u*)(vp + (c * 256 + tid) * 8); \
  }
  int i = tb;
  while (i < te && !ATT_VALID(i)) ++i;
  __syncthreads();
  if (i < te) ATT_GLOAD(i)
  int buf = 0;
  while (i < te) {
    char* tl = lds + buf * TILE_B;
#pragma unroll
    for (int c = 0; c < NCH; ++c) *(v4u*)(tl + (c * 256 + tid) * 16) = pre[c];
    __syncthreads();
    int nx = i + 1;
    while (nx < te && !ATT_VALID(nx)) ++nx;
    if (nx < te) ATT_GLOAD(nx)
    bool tok_ok = true;
    if (MODE == 2) tok_ok = (selw[i >> 5] >> (i & 31)) & 1u;
    if (MODE != 2 || __any(tok_ok)) {
    f32x16 S0, S1;
#pragma unroll
    for (int e = 0; e < 16; ++e) { S0[e] = 0.f; S1[e] = 0.f; }
    bf16x8 kf[8];
#pragma unroll
    for (int j = 0; j < 8; ++j) kf[j] = *(const bf16x8*)(tl + (j * 64 + lane) * 16);
    __builtin_amdgcn_sched_barrier(0);
#pragma unroll
    for (int s = 0; s < 4; ++s) { S0 = MFMA(kf[s], q[s], S0); S1 = MFMA(kf[4 + s], q[s], S1); }
    __builtin_amdgcn_sched_barrier(0);
    bf16x8 vf[8];
#pragma unroll
    for (int j = 0; j < 8; ++j) vf[j] = *(const bf16x8*)(tl + 8192 + (j * 64 + lane) * 16);
    __builtin_amdgcn_sched_barrier(0);
    bool full = (i * 64 + 63 <= tmin);
    if (MODE == 1) full = full && (i * 64 > tmax - 512);
    if (!full) {
      const int kb = i * 64 + 4 * h;
#pragma unroll
      for (int e = 0; e < 16; ++e) {
        int k0 = kb + 8 * (e >> 2) + (e & 3), k1 = k0 + 32;
        bool v0 = (k0 <= t), v1 = (k1 <= t);
        if (MODE == 1) { v0 = v0 && (k0 > t - 512); v1 = v1 && (k1 > t - 512); }
        S0[e] = v0 ? S0[e] : -INFINITY; S1[e] = v1 ? S1[e] : -INFINITY;
      }
    }
    float mx = fmaxf(S0[0], S1[0]);
#pragma unroll
    for (int e = 1; e < 16; ++e) mx = fmaxf(mx, fmaxf(S0[e], S1[e]));
    if (MODE == 2) mx = tok_ok ? mx : -INFINITY;
    mx = fmaxf(mx, __shfl_xor(mx, 32));
    float mnew = fmaxf(m, mx);
    if (__any(mnew > m)) {
      float f = __builtin_amdgcn_exp2f((m - mnew) * SC);
      l *= f;
#pragma unroll
      for (int d = 0; d < NDVT; ++d)
#pragma unroll
        for (int e = 0; e < 16; ++e) O[d][e] *= f;
    }
    m = mnew;
    const float nb = (MODE == 2 && !tok_ok) ? -INFINITY : -(m * SC);
    float ls = 0.f;
#pragma unroll
    for (int e = 0; e < 16; ++e) {
      S0[e] = __builtin_amdgcn_exp2f(fmaf(S0[e], SC, nb));
      S1[e] = __builtin_amdgcn_exp2f(fmaf(S1[e], SC, nb));
      ls += S0[e] + S1[e];
    }
    l += ls;
    bf16x8 pf[4];
    pf[0] = pack_frag(S0, 0); pf[1] = pack_frag(S0, 1); pf[2] = pack_frag(S1, 0); pf[3] = pack_frag(S1, 1);
    if constexpr (NDVT == 4) {
      bf16x8 vg[8];
#pragma unroll
      for (int j = 0; j < 8; ++j) vg[j] = *(const bf16x8*)(tl + 8192 + ((8 + j) * 64 + lane) * 16);
      __builtin_amdgcn_sched_barrier(0);
#pragma unroll
      for (int d = 0; d < 2; ++d)
#pragma unroll
        for (int s = 0; s < 4; ++s) O[d] = MFMA(vf[d * 4 + s], pf[s], O[d]);
#pragma unroll
      for (int d = 0; d < 2; ++d)
#pragma unroll
        for (int s = 0; s < 4; ++s) O[2 + d] = MFMA(vg[d * 4 + s], pf[s], O[2 + d]);
    } else {
#pragma unroll
      for (int d = 0; d < 2; ++d)
#pragma unroll
        for (int s = 0; s < 4; ++s) O[d] = MFMA(vf[d * 4 + s], pf[s], O[d]);
    }
    __builtin_amdgcn_sched_barrier(0);
    }
    i = nx; buf ^= 1;
  }
}

constexpr int LDS_IMP = 32768, LDS_SELW = 49152, LDS_UMASK = 49152 + 512;
DI void nsa_attn_item(const Params& p, int item, char* smem) {
  const int tid = get_tid(), lane = tid & 63, w = tid >> 6, n = lane & 31, h = lane >> 5;
  const int bh = item & 7, qt = 255 - (item >> 3), b = bh >> 2, hk = bh & 3, t0 = qt * 32, cur = t0 >> 6;
  const int tokl = w * 8 + (n >> 2), g = n & 3, t = t0 + tokl, head = hk * 4 + g;
  const int twmin = t0 + __builtin_amdgcn_readfirstlane(w) * 8;
  const size_t R = (size_t)b * S_ + t;
  const u16* proj = (const u16*)(p.ws + OFF_PROJ);
  const float* rope = (const float*)(p.ws + OFF_ROPE);
  const u16* qrow = proj + R * LDP + head * 64;
  bf16x8 q[4], qr0;
#pragma unroll
  for (int s = 0; s < 4; ++s) q[s] = *(const bf16x8*)(qrow + 16 * s + 8 * h);
  qr0 = rope_q(qrow, rope + (size_t)t * 16, h);
  float gate[3];
#pragma unroll
  for (int j = 0; j < 3; ++j) { float x = bf1(proj[R * LDP + 2560 + head * 3 + j]); gate[j] = 1.f / (1.f + __expf(-x)); }
  float* imp = (float*)(smem + LDS_IMP) + w * 1024;
  unsigned* selw_all = (unsigned*)(smem + LDS_SELW);
  unsigned* umask = (unsigned*)(smem + LDS_UMASK);
  __syncthreads();
#pragma unroll
  for (int i = 0; i < 16; ++i) imp[i * 64 + lane] = 0.f;
  if (tid < 4) umask[tid] = 0u;
  __syncthreads();

  f32x16 Ot[2], Ob[2];
  {
    const int ncmax = (t0 >> 4) + 1;
    const int ntile = (ncmax + 63) >> 6;
    const u16* Kc = (const u16*)(p.ws + OFF_KCF) + (size_t)(b * 4 + hk) * 512 * 64;
    const u16* Vc = (const u16*)(p.ws + OFF_VCF) + (size_t)(b * 4 + hk) * 512 * 64;
    float m = -1e30f, l = 0.f;
    bf16x8 kc[8], kn[8];
#pragma unroll
    for (int j = 0; j < 8; ++j) kc[j] = *(const bf16x8*)(Kc + (j * 64 + lane) * 8);
    for (int i = 0; i < ntile; ++i) {
      const int inx = i + 1 < ntile ? i + 1 : i;
#pragma unroll
      for (int j = 0; j < 8; ++j) kn[j] = *(const bf16x8*)(Kc + (size_t)inx * 4096 + (j * 64 + lane) * 8);
      f32x16 S0, S1;
#pragma unroll
      for (int e = 0; e < 16; ++e) { S0[e] = 0.f; S1[e] = 0.f; }
#pragma unroll
      for (int s = 0; s < 4; ++s) { S0 = MFMA(kc[s], q[s], S0); S1 = MFMA(kc[4 + s], q[s], S1); }
#pragma unroll
      for (int j = 0; j < 8; ++j) kc[j] = kn[j];
      const int cb = i * 64 + 4 * h;
      float mx = -INFINITY;
#pragma unroll
      for (int e = 0; e < 16; ++e) {
        int c0 = cb + 8 * (e >> 2) + (e & 3), c1 = c0 + 32;
        S0[e] = (16 * c0 + 31 <= t) ? S0[e] : -INFINITY; S1[e] = (16 * c1 + 31 <= t) ? S1[e] : -INFINITY;
        mx = fmaxf(mx, fmaxf(S0[e], S1[e]));
      }
      mx = fmaxf(mx, __shfl_xor(mx, 32));
      float mnew = fmaxf(m, mx);
      l *= __builtin_amdgcn_exp2f((m - mnew) * SC);
      m = mnew;
      const float msc = m * SC;
      float ls = 0.f;
#pragma unroll
      for (int e = 0; e < 16; ++e) ls += __builtin_amdgcn_exp2f(fmaf(S0[e], SC, -msc)) + __builtin_amdgcn_exp2f(fmaf(S1[e], SC, -msc));
      l += ls;
    }
    l += __shfl_xor(l, 32);
    const float invl = l > 0.f ? 1.f / l : 0.f;
    const float msc = m * SC;
#pragma unroll
    for (int d = 0; d < 2; ++d)
#pragma unroll
      for (int e = 0; e < 16; ++e) Ob[d][e] = 0.f;
    float* impt = imp + (n >> 2) * 128;
#pragma unroll
    for (int j = 0; j < 8; ++j) kc[j] = *(const bf16x8*)(Kc + (j * 64 + lane) * 8);
    for (int i = 0; i < ntile; ++i) {
      const int inx = i + 1 < ntile ? i + 1 : i;
      bf16x8 vc[8];
#pragma unroll
      for (int j = 0; j < 8; ++j) vc[j] = *(const bf16x8*)(Vc + (size_t)i * 4096 + (j * 64 + lane) * 8);
#pragma unroll
      for (int j = 0; j < 8; ++j) kn[j] = *(const bf16x8*)(Kc + (size_t)inx * 4096 + (j * 64 + lane) * 8);
      f32x16 S0, S1;
#pragma unroll
      for (int e = 0; e < 16; ++e) { S0[e] = 0.f; S1[e] = 0.f; }
#pragma unroll
      for (int s = 0; s < 4; ++s) { S0 = MFMA(kc[s], q[s], S0); S1 = MFMA(kc[4 + s], q[s], S1); }
#pragma unroll
      for (int j = 0; j < 8; ++j) kc[j] = kn[j];
      const int cb = i * 64 + 4 * h;
#pragma unroll
      for (int e = 0; e < 16; ++e) {
        int c0 = cb + 8 * (e >> 2) + (e & 3), c1 = c0 + 32;
        S0[e] = (16 * c0 + 31 <= t) ? __builtin_amdgcn_exp2f(fmaf(S0[e], SC, -msc)) * invl : 0.f;
        S1[e] = (16 * c1 + 31 <= t) ? __builtin_amdgcn_exp2f(fmaf(S1[e], SC, -msc)) * invl : 0.f;
      }
#pragma unroll
      for (int rt = 0; rt < 2; ++rt)
#pragma unroll
        for (int r = 0; r < 4; ++r) {
          float a0 = rt == 0 ? S0[4 * r] : S1[4 * r], a1 = rt == 0 ? S0[4 * r + 1] : S1[4 * r + 1];
          float a2 = rt == 0 ? S0[4 * r + 2] : S1[4 * r + 2], a3 = rt == 0 ? S0[4 * r + 3] : S1[4 * r + 3];
          float A = (a0 + a1) + (a2 + a3), L = a3;
          A += __shfl_xor(A, 1); L += __shfl_xor(L, 1);
          A += __shfl_xor(A, 2); L += __shfl_xor(L, 2);
          int nb = i * 16 + rt * 8 + 2 * r + h;
          if (g == 0) { atomicAdd(&impt[nb], A); if (nb + 1 < 128) atomicAdd(&impt[nb + 1], L); }
        }
      bf16x8 pf[4];
      pf[0] = pack_frag(S0, 0); pf[1] = pack_frag(S0, 1); pf[2] = pack_frag(S1, 0); pf[3] = pack_frag(S1, 1);
#pragma unroll
      for (int d = 0; d < 2; ++d)
#pragma unroll
        for (int s = 0; s < 4; ++s) Ob[d] = MFMA(vc[d * 4 + s], pf[s], Ob[d]);
    }
#pragma unroll
    for (int d = 0; d < 2; ++d)
#pragma unroll
      for (int e = 0; e < 16; ++e) Ot[d][e] = gate[0] * Ob[d][e];
  }
  {
    const int hi = cur - 2;
    for (int tk = 0; tk < 8; ++tk) {
      const float* ip = imp + tk * 128;
      const int n0 = lane, n1 = lane + 64;
      bool s0, s1;
      if (hi > 13) {
        const unsigned k0 = (n0 >= 1 && n0 <= hi) ? (__float_as_uint(ip[n0]) + 1u) : 0u;
        const unsigned k1 = (n1 <= hi) ? (__float_as_uint(ip[n1]) + 1u) : 0u;
        unsigned prefix = 0u;
        for (int bit = 31; bit >= 0; --bit) {
          const unsigned trial = prefix | (1u << bit);
          const int cnt = __popcll(__ballot(k0 >= trial)) + __popcll(__ballot(k1 >= trial));
          if (cnt >= 13) prefix = trial;
        }
        const unsigned long long g0 = __ballot(k0 > prefix), g1 = __ballot(k1 > prefix);
        const unsigned long long e0 = __ballot(k0 == prefix), e1 = __ballot(k1 == prefix);
        const int extra = 13 - (__popcll(g0) + __popcll(g1));
        const unsigned long long below = (1ull << lane) - 1ull;
        const int r0 = __popcll(e0 & below), r1 = __popcll(e0) + __popcll(e1 & below);
        const bool t0 = (k0 > prefix) || (k0 == prefix && r0 < extra);
        const bool t1 = (k1 > prefix) || (k1 == prefix && r1 < extra);
        s0 = (n0 == 0) || (n0 <= cur && n0 >= cur - 1) || t0;
        s1 = (n1 <= cur && n1 >= cur - 1) || t1;
      } else { s0 = n0 <= cur; s1 = n1 <= cur; }
      unsigned long long b0 = __ballot(s0), b1 = __ballot(s1);
      if (lane == 0) {
        unsigned* sw = selw_all + (w * 8 + tk) * 4;
        sw[0] = (unsigned)b0; sw[1] = (unsigned)(b0 >> 32); sw[2] = (unsigned)b1; sw[3] = (unsigned)(b1 >> 32);
        atomicOr(&umask[0], (unsigned)b0); atomicOr(&umask[1], (unsigned)(b0 >> 32));
        atomicOr(&umask[2], (unsigned)b1); atomicOr(&umask[3], (unsigned)(b1 >> 32));
      }
    }
  }
  __syncthreads();
  bf16x8 qr[4] = {qr0, q[1], q[2], q[3]};
  {
    float m = -1e30f, l = 0.f;
#pragma unroll
    for (int d = 0; d < 2; ++d)
#pragma unroll
      for (int e = 0; e < 16; ++e) Ob[d][e] = 0.f;
    const u16* Kf = (const u16*)(p.ws + OFF_KSF) + (size_t)(b * 4 + hk) * S_ * 64;
    const u16* Vf = (const u16*)(p.ws + OFF_VSF) + (size_t)(b * 4 + hk) * S_ * 64;
    attn_stream<2, 2>(Kf, Vf, 0, cur + 1, umask, qr, Ob, m, l, t, twmin, twmin + 7, selw_all + tokl * 4, smem);
    l += __shfl_xor(l, 32);
    const float f = gate[1] / l;
#pragma unroll
    for (int d = 0; d < 2; ++d)
#pragma unroll
      for (int e = 0; e < 16; ++e) Ot[d][e] += f * Ob[d][e];
  }
  {
    float m = -1e30f, l = 0.f;
#pragma unroll
    for (int d = 0; d < 2; ++d)
#pragma unroll
      for (int e = 0; e < 16; ++e) Ob[d][e] = 0.f;
    const u16* Kf = (const u16*)(p.ws + OFF_KWF) + (size_t)(b * 4 + hk) * S_ * 64;
    const u16* Vf = (const u16*)(p.ws + OFF_VWF) + (size_t)(b * 4 + hk) * S_ * 64;
    int lo = t0 - 511; lo = lo < 0 ? 0 : lo;
    attn_stream<2, 1>(Kf, Vf, lo >> 6, ((t0 + 31) >> 6) + 1, nullptr, qr, Ob, m, l, t, twmin, twmin + 7, nullptr, smem);
    l += __shfl_xor(l, 32);
    const float f = gate[2] / l;
#pragma unroll
    for (int d = 0; d < 2; ++d)
#pragma unroll
      for (int e = 0; e < 16; ++e) Ot[d][e] += f * Ob[d][e];
  }
  u16* ao = (u16*)(p.ws + OFF_H) + R * D_ + head * 64;
#pragma unroll
  for (int d = 0; d < 2; ++d)
#pragma unroll
    for (int r = 0; r < 4; ++r)
      *(v2u*)(ao + d * 32 + 8 * r + 4 * h) = mk2(pk2(Ot[d][4 * r], Ot[d][4 * r + 1]), pk2(Ot[d][4 * r + 2], Ot[d][4 * r + 3]));
}

DI size_t kfrag16_chunk(int key, int c  ) { return ((size_t)((((key >> 6) * 8 + ((key >> 4) & 3) * 2 + (c >> 2)) * 64) + (c & 3) * 16 + (key & 15))) * 8; }
DI void pack_k16_task(const u16* __restrict__ src, int ld, int col0, int NH, u16* __restrict__ dst, const float* __restrict__ rope, int task) {
  int t = task & (S_ - 1); int rest = task >> 13; int hs = rest % NH; int b = rest / NH;
  const u16* row = src + (size_t)(b * S_ + t) * ld + col0 + hs * 64;
  v4u c[8];
#pragma unroll
  for (int i = 0; i < 8; ++i) c[i] = *(const v4u*)(row + 8 * i);
  float x1[8], x2[8], o1[8], o2[8];
  unpack8(c[0], x1); unpack8(c[1], x2);
  const float* rt = rope + (size_t)t * 16;
#pragma unroll
  for (int i = 0; i < 8; ++i) { float cs = rt[i], sn = rt[8 + i]; o1[i] = x1[i] * cs - x2[i] * sn; o2[i] = x2[i] * cs + x1[i] * sn; }
  c[0] = pack8(o1); c[1] = pack8(o2);
  u16* d = dst + (size_t)(b * NH + hs) * S_ * 64;
#pragma unroll
  for (int i = 0; i < 8; ++i) *(v4u*)(d + kfrag16_chunk(t, i)) = c[i];
}
DI void pack_v16_task(const u16* __restrict__ src, int ld, int col0, int NH, u16* __restrict__ dst, int task) {
  int ln = task & 63; int s = (task >> 6) & 1; int dvt = (task >> 7) & 7; int rest = task >> 10; int tile = rest & 127; rest >>= 7; int hs = rest % NH; int b = rest / NH;
  const int lq = ln >> 4, dv = dvt * 16 + (ln & 15);
  const u16* base = src + (size_t)(b * S_ + tile * 64 + 32 * s + 4 * lq) * ld + col0 + hs * 128 + dv;
  u16 v[8];
#pragma unroll
  for (int j = 0; j < 8; ++j) { int kk = 16 * (j >> 2) + (j & 3); v[j] = base[(size_t)kk * ld]; }
  v4u o = mk4(v[0] | ((unsigned)v[1] << 16), v[2] | ((unsigned)v[3] << 16), v[4] | ((unsigned)v[5] << 16), v[6] | ((unsigned)v[7] << 16));
  u16* d = dst + (size_t)(b * NH + hs) * S_ * 128;
  *(v4u*)(d + ((size_t)(((tile * 8 + dvt) * 2 + s) * 64 + ln)) * 8) = o;
}
DI bf16x8 pack2x4(const f32x4& a, const f32x4& b) {
  v4u r = mk4(pk2(a[0], a[1]), pk2(a[2], a[3]), pk2(b[0], b[1]), pk2(b[2], b[3]));
  return __builtin_bit_cast(bf16x8, r);
}
DI void diff_attn_item(const Params& p, int item, char* smem) {
  const int tid = get_tid(), lane = tid & 63, l15 = lane & 15, lq = lane >> 4;
  const int wv = __builtin_amdgcn_readfirstlane(tid >> 6);
  const int bhc = item & 31, qt = 63 - (item >> 5), b = bhc >> 4, hc = bhc & 15, t0 = qt * 128;
  const int twmin = t0 + wv * 32;
  const float* rope = (const float*)(p.ws + OFF_ROPE);
  int tq[2]; bf16x8 qf[2][2];
#pragma unroll
  for (int ct = 0; ct < 2; ++ct) {
    tq[ct] = twmin + ct * 16 + l15;
    const u16* qrow = (const u16*)(p.ws + OFF_Q) + ((size_t)b * S_ + tq[ct]) * D_ + hc * 64;
    qf[ct][1] = *(const bf16x8*)(qrow + 32 + lq * 8);
    bf16x8 raw = *(const bf16x8*)(qrow + lq * 8);
    bf16x8 rp = rope_q(qrow, rope + (size_t)tq[ct] * 16, lq & 1);
    qf[ct][0] = lq < 2 ? rp : raw;
  }
  f32x4 O[8][2];
#pragma unroll
  for (int d = 0; d < 8; ++d)
#pragma unroll
    for (int ct = 0; ct < 2; ++ct)
#pragma unroll
      for (int e = 0; e < 4; ++e) O[d][ct][e] = 0.f;
  float m[2] = {-1e30f, -1e30f}, l[2] = {0.f, 0.f};
  const u16* Kf = (const u16*)(p.ws + OFF_SKVK) + (size_t)(b * 16 + hc) * S_ * 64;
  const u16* Vf = (const u16*)(p.ws + OFF_SKVV) + (size_t)(b * 8 + (hc >> 1)) * S_ * 128;
  const int te = 2 * qt + 2;
  constexpr int TILE_B = 24576;
  v4u pre[6];
#define D16_GLOAD(i_)                                                                                  \
  { const u16* kp = Kf + (size_t)(i_) * 4096; const u16* vp = Vf + (size_t)(i_) * 8192;                 \
    _Pragma("unroll") for (int c = 0; c < 2; ++c) pre[c] = *(const v4u*)(kp + (c * 256 + tid) * 8);    \
    _Pragma("unroll") for (int c = 0; c < 4; ++c) pre[2 + c] = *(const v4u*)(vp + (c * 256 + tid) * 8); }
  __syncthreads();
  D16_GLOAD(0)
  int buf = 0;
  for (int i = 0; i < te; ++i) {
    char* tl = smem + buf * TILE_B;
#pragma unroll
    for (int c = 0; c < 6; ++c) *(v4u*)(tl + (c * 256 + tid) * 16) = pre[c];
    __syncthreads();
    if (i + 1 < te) D16_GLOAD(i + 1)
    f32x4 S[4][2];
#pragma unroll
    for (int rt = 0; rt < 4; ++rt)
#pragma unroll
      for (int ct = 0; ct < 2; ++ct)
#pragma unroll
        for (int e = 0; e < 4; ++e) S[rt][ct][e] = 0.f;
    bf16x8 kf[8];
#pragma unroll
    for (int f = 0; f < 8; ++f) kf[f] = *(const bf16x8*)(tl + (f * 64 + lane) * 16);
    __builtin_amdgcn_sched_barrier(0);
#pragma unroll
    for (int rt = 0; rt < 4; ++rt)
#pragma unroll
      for (int ks = 0; ks < 2; ++ks)
#pragma unroll
        for (int ct = 0; ct < 2; ++ct) S[rt][ct] = MFMA16(kf[rt * 2 + ks], qf[ct][ks], S[rt][ct]);
    __builtin_amdgcn_sched_barrier(0);
    bf16x8 vf[8];
#pragma unroll
    for (int f = 0; f < 8; ++f) vf[f] = *(const bf16x8*)(tl + 8192 + (f * 64 + lane) * 16);
    __builtin_amdgcn_sched_barrier(0);
    if (!(i * 64 + 63 <= twmin)) {
#pragma unroll
      for (int rt = 0; rt < 4; ++rt)
#pragma unroll
        for (int ct = 0; ct < 2; ++ct)
#pragma unroll
          for (int e = 0; e < 4; ++e) { const int key = i * 64 + rt * 16 + 4 * lq + e; S[rt][ct][e] = key <= tq[ct] ? S[rt][ct][e] : -INFINITY; }
    }
    float mn[2]; bool grow = false;
#pragma unroll
    for (int ct = 0; ct < 2; ++ct) {
      float mx = fmaxf(fmaxf(S[0][ct][0], S[0][ct][1]), fmaxf(S[0][ct][2], S[0][ct][3]));
#pragma unroll
      for (int rt = 1; rt < 4; ++rt) mx = fmaxf(mx, fmaxf(fmaxf(S[rt][ct][0], S[rt][ct][1]), fmaxf(S[rt][ct][2], S[rt][ct][3])));
      mx = fmaxf(mx, __shfl_xor(mx, 16));
      mx = fmaxf(mx, __shfl_xor(mx, 32));
      mn[ct] = fmaxf(m[ct], mx);
      grow = grow || (mn[ct] > m[ct]);
    }
    if (__any(grow)) {
#pragma unroll
      for (int ct = 0; ct < 2; ++ct) {
        const float f = __builtin_amdgcn_exp2f((m[ct] - mn[ct]) * SC);
        l[ct] *= f;
#pragma unroll
        for (int d = 0; d < 8; ++d)
#pragma unroll
          for (int e = 0; e < 4; ++e) O[d][ct][e] *= f;
      }
    }
    bf16x8 pf[2][2];
#pragma unroll
    for (int ct = 0; ct < 2; ++ct) {
      m[ct] = mn[ct];
      const float nb = -(m[ct] * SC);
      float ls = 0.f;
#pragma unroll
      for (int rt = 0; rt < 4; ++rt)
#pragma unroll
        for (int e = 0; e < 4; ++e) { S[rt][ct][e] = __builtin_amdgcn_exp2f(fmaf(S[rt][ct][e], SC, nb)); ls += S[rt][ct][e]; }
      l[ct] += ls;
      pf[0][ct] = pack2x4(S[0][ct], S[1][ct]);
      pf[1][ct] = pack2x4(S[2][ct], S[3][ct]);
    }
    bf16x8 vg[8];
#pragma unroll
    for (int f = 0; f < 8; ++f) vg[f] = *(const bf16x8*)(tl + 8192 + ((8 + f) * 64 + lane) * 16);
    __builtin_amdgcn_sched_barrier(0);
#pragma unroll
    for (int d = 0; d < 4; ++d)
#pragma unroll
      for (int s = 0; s < 2; ++s)
#pragma unroll
        for (int ct = 0; ct < 2; ++ct) O[d][ct] = MFMA16(vf[d * 2 + s], pf[s][ct], O[d][ct]);
#pragma unroll
    for (int d = 0; d < 4; ++d)
#pragma unroll
      for (int s = 0; s < 2; ++s)
#pragma unroll
        for (int ct = 0; ct < 2; ++ct) O[4 + d][ct] = MFMA16(vg[d * 2 + s], pf[s][ct], O[4 + d][ct]);
    __builtin_amdgcn_sched_barrier(0);
    buf ^= 1;
  }
#pragma unroll
  for (int ct = 0; ct < 2; ++ct) {
    float lt = l[ct];
    lt += __shfl_xor(lt, 16);
    lt += __shfl_xor(lt, 32);
    const float f = 1.f / lt;
    u16* op = (u16*)(p.ws + OFF_KVRAW) + (((size_t)b * S_ + tq[ct]) * 16 + hc) * 128;
#pragma unroll
    for (int d = 0; d < 8; ++d)
      *(v2u*)(op + d * 16 + 4 * lq) = mk2(pk2(O[d][ct][0] * f, O[d][ct][1] * f), pk2(O[d][ct][2] * f, O[d][ct][3] * f));
  }
}

DI void conv_task(const u16* __restrict__ u, u16* __restrict__ act, const float* __restrict__ cw, const float* __restrict__ cbias, int task) {
  const int ck = task % 344, rr = task / 344;
  const int j0 = ck * 8, ts = rr * 16;
  float wg[3][8], wv[3][8], bg[8], bv[8], g1[8], g2[8], v1[8], v2[8];
#pragma unroll
  for (int e = 0; e < 8; ++e) {
#pragma unroll
    for (int tp = 0; tp < 3; ++tp) { wg[tp][e] = cw[tp * FF2 + j0 + e]; wv[tp][e] = cw[tp * FF2 + FF + j0 + e]; }
    bg[e] = cbias[j0 + e]; bv[e] = cbias[FF + j0 + e];
    g1[e] = g2[e] = v1[e] = v2[e] = 0.f;
  }
  if (ts > 0) {
    unpack8(*(const v4u*)(u + (size_t)(ts - 1) * FF2 + j0), g1); unpack8(*(const v4u*)(u + (size_t)(ts - 1) * FF2 + FF + j0), v1);
    unpack8(*(const v4u*)(u + (size_t)(ts - 2) * FF2 + j0), g2); unpack8(*(const v4u*)(u + (size_t)(ts - 2) * FF2 + FF + j0), v2);
  }
#pragma unroll 4
  for (int r = 0; r < 16; ++r) {
    const int t = ts + r;
    float gc[8], vc[8], o[8];
    unpack8(*(const v4u*)(u + (size_t)t * FF2 + j0), gc); unpack8(*(const v4u*)(u + (size_t)t * FF2 + FF + j0), vc);
#pragma unroll
    for (int e = 0; e < 8; ++e) {
      float cgv = bg[e] + wg[0][e] * g2[e] + wg[1][e] * g1[e] + wg[2][e] * gc[e];
      float cvv = bv[e] + wv[0][e] * v2[e] + wv[1][e] * v1[e] + wv[2][e] * vc[e];
      o[e] = cgv / (1.f + __expf(-cgv)) * cvv;
      g2[e] = g1[e]; g1[e] = gc[e]; v2[e] = v1[e]; v1[e] = vc[e];
    }
    *(v4u*)(act + (size_t)t * FF + j0) = pack8(o);
  }
}

DI void diff_comb_row(const Params& p, int j, int layer, int row, int lane) {
  const float* lv = p.in[12] + j * 256;
  float sa = wave_sum(lv[lane] * lv[64 + lane]), sb = wave_sum(lv[128 + lane] * lv[192 + lane]);
  const float lam_init = 0.8f - 0.6f * expf(-0.3f * (float)layer);
  const float lam = expf(sa) - expf(sb) + lam_init;
  const int head = lane >> 3, part = lane & 7;
  const u16* o0 = (const u16*)(p.ws + OFF_KVRAW) + ((size_t)row * 16 + head * 2) * 128 + part * 16;
  const u16* o1 = o0 + 128;
  float a[16], bb[16];
  unpack8(*(const v4u*)o0, a); unpack8(*(const v4u*)(o0 + 8), a + 8);
  unpack8(*(const v4u*)o1, bb); unpack8(*(const v4u*)(o1 + 8), bb + 8);
  float ss = 0.f;
#pragma unroll
  for (int e = 0; e < 16; ++e) { a[e] = a[e] - lam * bb[e]; ss += a[e] * a[e]; }
  ss += __shfl_xor(ss, 1); ss += __shfl_xor(ss, 2); ss += __shfl_xor(ss, 4);
  const float r = rsqrtf(ss * (1.f / 128.f) + 1e-6f) * (1.f - lam_init);
  const float* sg = p.in[13] + j * 128 + part * 16;
#pragma unroll
  for (int e = 0; e < 16; ++e) a[e] = a[e] * r * sg[e];
  u16* dst = (u16*)(p.ws + OFF_H) + (size_t)row * D_ + head * 128 + part * 16;
  *(v4u*)dst = pack8(a); *(v4u*)(dst + 8) = pack8(a + 8);
}


#define XB_TMO      128
#define XB_XCNT(j)  (256  + 64 * (j))
#define XB_XSUB(j)  (1280 + 64 * (j))
#define XB_XGEN(j)  (2304 + 64 * (j))
#define XB_TOP      3328
#define XB_TOPGEN   3392
#define XCD_BAR_WORDS 3456
#define XB_SPIN_CAP (1u << 24)
#define LAS __attribute__((address_space(3)))
DI unsigned xb_ld(unsigned* p)              { return __hip_atomic_load(p, __ATOMIC_RELAXED, __HIP_MEMORY_SCOPE_AGENT); }
DI unsigned xb_add(unsigned* p, unsigned v) { return __hip_atomic_fetch_add(p, v, __ATOMIC_RELAXED, __HIP_MEMORY_SCOPE_AGENT); }
DI unsigned xb_xcc_id() { return (unsigned)__builtin_amdgcn_s_getreg((3 << 11) | 20) & 0xFu; }
#define XB_SPIN(cond, bar) do { unsigned _sp = 0; while (cond) { __builtin_amdgcn_s_sleep(1); \
    if ((++_sp & 255u) == 0u) { if (xb_ld(&(bar)[XB_TMO])) break; if (_sp > XB_SPIN_CAP) { atomicAdd(&(bar)[XB_TMO], 1u); break; } } } } while (0)
struct XcdBarrier { unsigned* bar; unsigned x; volatile LAS unsigned* st; };
DI XcdBarrier xcd_barrier_post(unsigned* bar, volatile LAS unsigned* st) {
  XcdBarrier b; b.bar = bar; b.x = xb_xcc_id(); b.st = st;
  if (__builtin_amdgcn_workitem_id_x() == 0) (void)xb_add(&bar[XB_XCNT(b.x)], 1u);
  return b;
}
DI void xcd_barrier_complete(unsigned* bar, unsigned x, unsigned& nloc, unsigned& nx) {
  const unsigned G = gridDim.x * gridDim.y * gridDim.z;
  unsigned sum, cnt, mine, sp = 0u;
  for (;;) {
    sum = 0u; cnt = 0u; mine = 0u;
#pragma unroll
    for (unsigned j = 0; j < 16; ++j) { const unsigned c = xb_ld(&bar[XB_XCNT(j)]); sum += c; cnt += (c > 0u) ? 1u : 0u; mine = (j == x) ? c : mine; }
    if (sum == G) break;
    __builtin_amdgcn_s_sleep(1);
    if ((++sp & 255u) == 0u) { if (xb_ld(&bar[XB_TMO])) break; if (sp > XB_SPIN_CAP) { atomicAdd(&bar[XB_TMO], 1u); break; } }
  }
  nloc = mine > 0u ? mine : 1u; nx = cnt > 0u ? cnt : 1u;
}
DI void xcd_barrier(const XcdBarrier& b) {
  asm volatile("s_waitcnt vmcnt(0)" ::: "memory");
  __syncthreads();
  if (__builtin_amdgcn_workitem_id_x() == 0) {
    unsigned* bar = b.bar;
    __builtin_amdgcn_s_waitcnt(0);
    unsigned nloc = b.st[0], nx = b.st[1];
    if (nloc == 0u) { xcd_barrier_complete(bar, b.x, nloc, nx); b.st[0] = nloc; b.st[1] = nx; }
    const unsigned old = xb_add(&bar[XB_XSUB(b.x)], 1u);
    const unsigned gen = old / nloc;
    if (old + 1u == (gen + 1u) * nloc) {
      __builtin_amdgcn_fence(__ATOMIC_RELEASE, "agent");
      asm volatile("s_waitcnt vmcnt(0)" ::: "memory");
      const unsigned og = xb_add(&bar[XB_TOP], 1u);
      const unsigned tg = og / nx;
      if (og + 1u == (tg + 1u) * nx) xb_add(&bar[XB_TOPGEN], 1u);
      else XB_SPIN(xb_ld(&bar[XB_TOPGEN]) == tg, bar);
      __builtin_amdgcn_fence(__ATOMIC_ACQUIRE, "agent");
      xb_add(&bar[XB_XGEN(b.x)], 1u);
      asm volatile("s_waitcnt vmcnt(0)" ::: "memory");
    } else {
      XB_SPIN(xb_ld(&bar[XB_XGEN(b.x)]) == gen, bar);
      __builtin_amdgcn_fence(__ATOMIC_ACQUIRE, "agent");
      asm volatile("s_waitcnt vmcnt(0)" ::: "memory");
    }
  }
  __syncthreads();
}

DI bool xcd_tile(int bid, int round, int G, int MT, int NT, int& tm, int& tn) {
  const int mx = MT >> 3, q = (bid >> 3) + (G >> 3) * round;
  if (q >= mx * NT) return false;
  tm = (bid & 7) * mx + q % mx; tn = q / mx;
  return true;
}
DI int snake(int r, int G, int j) { return r * G + ((r & 1) ? (G - 1 - j) : j); }

DI void run_step(const Params& pk, const Step st, char* smem) {
  const int G = gridDim.x, bid = get_bid(), tid = get_tid(), lane = tid & 63, wave = tid >> 6;
  const int L = st.layer;
  size_t z = 0;
  asm volatile("" : "+s"(z));
  Params p;
#pragma unroll
  for (int i = 0; i < 20; ++i) p.in[i] = pk.in[i] + z;
  p.out = pk.out + z;
  p.ws = pk.ws + z;
  char* ws = p.ws;
  float* xcur = p.out;
  switch (st.op) {
  case OP_PREP: {
    const int n_rope = 256, n_cb = 32, n_norm = 4096;
    const int total = N_TR_TILES + n_rope + n_cb + n_norm;
    int tj = 0, tbase = 0;
    for (int w = bid; w < total; w += G) {
      if (w < N_TR_TILES) { transpose_tile(pk, z, w, smem, tj, tbase); continue; }
      int k = w - N_TR_TILES;
      if (k < n_rope) {
        int idx = k * 256 + tid; int t = idx >> 3, i = idx & 7;
        float inv = powf(500000.f, -(float)i / 8.f);
        float ang = (float)t * inv;
        float* rp = (float*)(ws + OFF_ROPE) + (size_t)t * 16;
        rp[i] = cosf(ang); rp[8 + i] = sinf(ang);
        continue;
      }
      k -= n_rope;
      if (k < n_cb) {
        int lkv = k >> 3, j0 = (k & 7) * 32;
        int jj = tid & 31, kg = tid >> 5;
        const float* pe = p.in[5] + lkv * 2048;
        const float* w1 = p.in[6] + (size_t)lkv * 2048 * 256;
        float s = 0.f;
        {
          float s0 = 0.f, s1 = 0.f, s2 = 0.f, s3 = 0.f;
          const float* wp = w1 + (size_t)(kg * 256) * 256 + j0 + jj;
          const float* pp = pe + kg * 256;
#pragma unroll 8
          for (int kk = 0; kk < 256; kk += 4) {
            s0 += pp[kk] * wp[(size_t)kk * 256]; s1 += pp[kk + 1] * wp[(size_t)(kk + 1) * 256];
            s2 += pp[kk + 2] * wp[(size_t)(kk + 2) * 256]; s3 += pp[kk + 3] * wp[(size_t)(kk + 3) * 256];
          }
          s = (s0 + s1) + (s2 + s3);
        }
        float* part = (float*)smem;
        __syncthreads();
        part[tid] = s;
        __syncthreads();
        if (tid < 32) { float a = p.in[7][lkv * 256 + j0 + tid]; for (int q = 0; q < 8; ++q) a += part[q * 32 + tid]; ((float*)(ws + OFF_CB))[lkv * 256 + j0 + tid] = a; }
        continue;
      }
      k -= n_cb;
      { int row = k * 4 + wave; prep_row_x(p.in[0] + (size_t)row * D_, (u16*)(ws + OFF_XB) + (size_t)row * D_, (float*)(ws + OFF_SSQ) + (size_t)row * 8, lane); }
    }
  } break;
  case OP_NORM: {
    const float* g = (st.aux ? p.in[2] : p.in[1]) + L * D_;
    for (int k = bid; k < 4096; k += G) { int row = k * 4 + wave; norm_row_bf16(xcur + (size_t)row * D_, g, (u16*)(ws + OFF_H) + (size_t)row * D_, lane); }
  } break;
  case OP_FINAL: {
    const u16* xbp = (const u16*)(ws + OFF_XB);
    for (int k = bid; k < 4096; k += 2 * G) {
      const int k2 = k + G;
      const size_t ra_ = (size_t)(k * 4 + wave) * D_, rc_ = (size_t)((k2 < 4096 ? k2 : k) * 4 + wave) * D_;
      v4u ua[2], uc[2];
#pragma unroll
      for (int q = 0; q < 2; ++q) { ua[q] = ((const v4u*)(xbp + ra_))[q * 64 + lane]; uc[q] = ((const v4u*)(xbp + rc_))[q * 64 + lane]; }
      float fa[16], fc[16];
      unpack8(ua[0], fa); unpack8(ua[1], fa + 8); unpack8(uc[0], fc); unpack8(uc[1], fc + 8);
      float sa = 0.f, sc = 0.f;
#pragma unroll
      for (int e2 = 0; e2 < 16; ++e2) { sa += fa[e2] * fa[e2]; sc += fc[e2] * fc[e2]; }
      sa = wave_sum(sa); sc = wave_sum(sc);
      const float ra = rsqrtf(sa * (1.f / 1024.f) + 1e-6f), rc = rsqrtf(sc * (1.f / 1024.f) + 1e-6f);
#pragma unroll
      for (int q = 0; q < 2; ++q) {
        const int c2 = (q * 64 + lane) * 2;
        const float4 g0 = ((const float4*)p.in[19])[c2], g1 = ((const float4*)p.in[19])[c2 + 1];
        ((float4*)(xcur + ra_))[c2] = make_float4(fa[q * 8] * ra * g0.x, fa[q * 8 + 1] * ra * g0.y, fa[q * 8 + 2] * ra * g0.z, fa[q * 8 + 3] * ra * g0.w);
        ((float4*)(xcur + ra_))[c2 + 1] = make_float4(fa[q * 8 + 4] * ra * g1.x, fa[q * 8 + 5] * ra * g1.y, fa[q * 8 + 6] * ra * g1.z, fa[q * 8 + 7] * ra * g1.w);
        if (k2 < 4096) {
          ((float4*)(xcur + rc_))[c2] = make_float4(fc[q * 8] * rc * g0.x, fc[q * 8 + 1] * rc * g0.y, fc[q * 8 + 2] * rc * g0.z, fc[q * 8 + 3] * rc * g0.w);
          ((float4*)(xcur + rc_))[c2 + 1] = make_float4(fc[q * 8 + 4] * rc * g1.x, fc[q * 8 + 5] * rc * g1.y, fc[q * 8 + 6] * rc * g1.z, fc[q * 8 + 7] * rc * g1.w);
        }
      }
    }
  } break;
  case OP_NSA_IN: {
    ARow af{(const u16*)(ws + OFF_XB), D_};
    EpiStoreT ep{(u16*)(ws + OFF_PROJ), LDP, (const float*)(ws + OFF_SSQ)};
    const u16* Bt = (const u16*)(ws + OFF_WNI) + (size_t)L * LDP * 1024;
    for (int r = 0, tm, tn; xcd_tile(bid, r, G, 128, 11, tm, tn); ++r) gemm_tile(af, Bt, LDP, 1024, tm * 128, tn * 256, ep, smem);
  } break;
  case OP_NSA_PACK: {
    const u16* proj = (const u16*)(ws + OFF_PROJ);
    const float* rope = (const float*)(ws + OFF_ROPE);
    const int n_g = 64, n_k = 2 * 256, n_v = 2 * 2048;
    for (int w = bid; w < n_g + n_k + n_v; w += G) {
      if (w < n_g) {
        int kv = w >> 5, lt = w & 31;
        ACmp af{proj, 1024 + kv * 256};
        EpiCmpFused ep{(const float*)(ws + OFF_CB) + (L * 2 + kv) * 256, (const u16*)(ws + OFF_WP2) + (size_t)(L * 2 + kv) * 64 * 256, (u16*)(ws + OFF_KCF), (u16*)(ws + OFF_VCF), kv};
        gemm_tile(af, (const u16*)(ws + OFF_WP1) + (size_t)(L * 2 + kv) * 256 * 2048, 256, 2048, lt * 128, 0, ep, smem);
        continue;
      }
      int k = w - n_g;
      if (k < n_k) {
        int str = k >> 8, task = (k & 255) * 256 + tid;
        pack_k_task(proj, LDP, 1024 + (str ? 1024 : 512), 4, (u16*)(ws + (str ? OFF_KWF : OFF_KSF)), rope, task);
        continue;
      }
      k -= n_k;
      { int str = k >> 11, task = (k & 2047) * 256 + tid;
        pack_v_task<2>(proj, LDP, 1024 + (str ? 1280 : 768), 4, (u16*)(ws + (str ? OFF_VWF : OFF_VSF)), task); }
    }
  } break;
  case OP_NSA_CMP2: {
    for (int w = bid; w < 64; w += G) {
      int kv = w >> 5, lt = w & 31;
      ARow af{(const u16*)(ws + OFF_HID) + (size_t)kv * 4096 * 256, 256};
      EpiCmpOut ep{(u16*)(ws + OFF_KCF), (u16*)(ws + OFF_VCF), kv};
      gemm_tile(af, (const u16*)(ws + OFF_WP2) + (size_t)(L * 2 + kv) * 64 * 256, 64, 256, lt * 128, 0, ep, smem);
    }
  } break;
  case OP_NSA_ATTN: {
    for (int r = 0;; ++r) { int it = snake(r, G, bid); if (r * G >= 2048) break; if (it < 2048) nsa_attn_item(p, it, smem); }
  } break;
  case OP_OUTPROJ: {
    ARow af{(const u16*)(ws + OFF_H), D_};
    const u16* Bt = L < 2 ? (const u16*)(ws + OFF_WNO) + (size_t)L * 1024 * 1024 : (const u16*)(ws + OFF_WDO) + (size_t)(L - 2) * 1024 * 1024;
    {
      EpiResidT<false> ep{nullptr, nullptr, (u16*)(ws + OFF_XB), (float*)(ws + OFF_SSQ)};
      for (int r = 0, tm, tn; xcd_tile(bid, r, G, 128, 4, tm, tn); ++r) gemm_tile(af, Bt, 1024, 1024, tm * 128, tn * 256, ep, smem);
    }
  } break;
  case OP_FFN1: {
    ARow af{(const u16*)(ws + OFF_XB), D_};
    EpiConvGlu ep{(u16*)(ws + OFF_ACT), (u16*)(ws + OFF_HALO), p.in[16] + (size_t)L * 3 * FF2, p.in[17] + (size_t)L * FF2, (const float*)(ws + OFF_SSQ)};
    const u16* Bt = (const u16*)(ws + OFF_WFI) + (size_t)L * FF2 * 1024;
    for (int r = 0, tm, tn; xcd_tile(bid, r, G, 128, 22, tm, tn); ++r) gemm_tile(af, Bt, FF2, 1024, tm * 128, tn * 256, ep, smem);
  } break;
  case OP_FIX: {
    for (int k = bid; k < 344; k += G)
      ffn_fix_task((const u16*)(ws + OFF_HALO), (u16*)(ws + OFF_ACT), p.in[16] + (size_t)L * 3 * FF2, p.in[17] + (size_t)L * FF2, k * 256 + tid);
  } break;
  case OP_FFN2: {
    ARow af{(const u16*)(ws + OFF_ACT), FF};
    EpiResidT<false> ep{nullptr, nullptr, (u16*)(ws + OFF_XB), (float*)(ws + OFF_SSQ)};
    const u16* Bt = (const u16*)(ws + OFF_WFO) + (size_t)L * 1024 * FF;
    for (int r = 0, tm, tn; xcd_tile(bid, r, G, 128, 4, tm, tn); ++r) {
      for (int q = tid; q < 688; q += 256)
        ffn_fix_task((const u16*)(ws + OFF_HALO), (u16*)(ws + OFF_ACT), p.in[16] + (size_t)L * 3 * FF2, p.in[17] + (size_t)L * FF2, (tm * 2 + q / 344) * 344 + q % 344);
      gemm_tile(af, Bt, 1024, FF, tm * 128, tn * 256, ep, smem);
    }
  } break;
  case OP_KVQ_GEMM: {
    for (int r = 0, tm, tn; xcd_tile(bid, r, G, 128, 12, tm, tn); ++r) {
      if (tn < 8) {
        ARow af{(const u16*)(ws + OFF_XB), D_}; EpiStoreT ep{(u16*)(ws + OFF_KVRAW), 2048, (const float*)(ws + OFF_SSQ)};
        gemm_tile(af, (const u16*)(ws + OFF_WKV), 2048, 1024, tm * 128, tn * 256, ep, smem);
      } else {
        ARow af{(const u16*)(ws + OFF_XB), D_}; EpiStoreT ep{(u16*)(ws + OFF_Q), D_, (const float*)(ws + OFF_SSQ)};
        gemm_tile(af, (const u16*)(ws + OFF_WDQ), 1024, 1024, tm * 128, (tn - 8) * 256, ep, smem);
      }
    }
  } break;
  case OP_DQ_GEMM: {
    ARow af{(const u16*)(ws + OFF_XB), D_}; EpiStoreT ep{(u16*)(ws + OFF_Q), D_, (const float*)(ws + OFF_SSQ)};
    for (int r = 0, tm, tn; xcd_tile(bid, r, G, 128, 4, tm, tn); ++r) gemm_tile(af, (const u16*)(ws + OFF_WDQ) + 1024 * 1024, 1024, 1024, tm * 128, tn * 256, ep, smem);
  } break;
  case OP_KV_PACK: {
    const u16* kvr = (const u16*)(ws + OFF_KVRAW);
    const float* rope = (const float*)(ws + OFF_ROPE);
    const int n_k = 1024, n_v = 8192;
    for (int w = bid; w < n_k + n_v; w += G) {
      if (w < n_k) pack_k16_task(kvr, 2048, 0, 16, (u16*)(ws + OFF_SKVK), rope, w * 256 + tid);
      else pack_v16_task(kvr, 2048, 1024, 8, (u16*)(ws + OFF_SKVV), (w - n_k) * 256 + tid);
    }
  } break;
  case OP_DIFF_ATTN: {
    for (int r = 0;; ++r) { int it = snake(r, G, bid); if (r * G >= 2048) break; if (it < 2048) diff_attn_item(p, it, smem); }
  } break;
  case OP_DIFF_COMB: {
    for (int k = bid; k < 4096; k += G) diff_comb_row(p, L - 2, L, k * 4 + wave, lane);
  } break;
  }
}

__global__ void __launch_bounds__(256, 2) mega(Params p, int s_lo, int s_hi) {
  __shared__ __attribute__((aligned(16))) char smem[73728];
  __shared__ uint4 xb_words;
  cg::grid_group grid = cg::this_grid();
  const bool multi = (s_hi - s_lo) > 1;
  XcdBarrier xb;
  if (multi) {
    if (__builtin_amdgcn_workitem_id_x() == 0) xb_words = make_uint4(0u, 0u, 0u, 0u);
    __syncthreads();
    xb = xcd_barrier_post((unsigned*)(p.ws + OFF_BAR), (volatile LAS unsigned*)&xb_words);
  }
  for (int s = s_lo; s < s_hi; ++s) {
    Step st = g_prog[s];
    run_step(p, st, smem);
    if (s + 1 < s_hi) { if (s_hi > 4096) grid.sync();   xcd_barrier(xb); }
  }
}

extern "C" void kernel_launch(void* const* d_in, const int* in_sizes, int n_in, void* d_out, int out_size, void* d_ws, size_t ws_size,
                              hipStream_t stream) {
  (void)in_sizes; (void)n_in; (void)out_size;
  static int grid_blocks = 0;
  if (!grid_blocks) {
    int dev = 0, cus = 0, per_cu = 0;
    hipGetDevice(&dev);
    hipDeviceGetAttribute(&cus, hipDeviceAttributeMultiprocessorCount, dev);
    hipOccupancyMaxActiveBlocksPerMultiprocessor(&per_cu, mega, 256, 0);
    if (per_cu < 1) per_cu = 1;
    if (per_cu > 2) per_cu = 2;
    grid_blocks = cus * per_cu;
  }
  if (ws_size < WS_NEEDED) { fprintf(stderr, "workspace too small: %zu < %zu\n", ws_size, (size_t)WS_NEEDED); return; }
  Params p{};
  for (int i = 0; i < 20; ++i) p.in[i] = (const float*)d_in[i];
  p.out = (float*)d_out;
  p.ws = (char*)d_ws;
#if ONE_LAUNCH
  hipMemsetAsync((char*)d_ws + OFF_BAR, 0, XCD_BAR_WORDS * 4, stream);
  int lo = 0, hi = N_STEPS;
  void* args[] = {&p, &lo, &hi};
  hipError_t e = hipLaunchCooperativeKernel((void*)mega, dim3(grid_blocks), dim3(256), args, 0, stream);
  if (e != hipSuccess) fprintf(stderr, "cooperative launch failed: %s (grid %d)\n", hipGetErrorString(e), grid_blocks);
#else
  for (int s = 0; s < N_STEPS; ++s) mega<<<grid_blocks, 256, 0, stream>>>(p, s, s + 1);
#endif
}
```
